# Optimizing an MI355X kernel written in HIP

```python
import jax, jax.numpy as jnp
from jax import lax
import numpy as np

D_MODEL = 2048
BATCH = 1
SEQ = 8192
DEPTH = 1

CTX_LEN = 256
GRID_W = 64
RET_HEADS = 8
RET_DK = 64
RET_DV = 128
RET_CHUNK = 128
ATT_HEADS = 16
ATT_KV_HEADS = 4
ATT_DH = 64
ATT_GROUP = ATT_HEADS // ATT_KV_HEADS
WINDOW = 128
ATT_BLOCK = 128
D_FF = -(-(8 * D_MODEL) // (3 * 256)) * 256
ROPE_BASE = 10000.0
NORM_EPS = 1e-6
PROJ_SIZES = (RET_HEADS * RET_DK, RET_HEADS * RET_DK, RET_HEADS * RET_DV, RET_HEADS * RET_DV,
              ATT_HEADS * ATT_DH, ATT_KV_HEADS * ATT_DH, ATT_KV_HEADS * ATT_DH)
D_PROJ = sum(PROJ_SIZES)
D_MIX_OUT = RET_HEADS * RET_DV + ATT_HEADS * ATT_DH

kernel_name = "hybrid_retention_window_gqa_dit_layer"


def _rmsnorm(x, g):
    xf = x.astype(jnp.float32)
    y = xf * lax.rsqrt(jnp.mean(xf * xf, axis=-1, keepdims=True) + NORM_EPS)
    return (y * g.astype(jnp.float32)).astype(x.dtype)


def _modulate(x, g, shift, scale):
    return _rmsnorm(x, g) * (1.0 + scale) + shift


def _split_proj(p):
    idx = [int(v) for v in np.cumsum(PROJ_SIZES)[:-1]]
    return jnp.split(p, idx, axis=-1)


def _heads(p, h, d):
    return p.reshape(p.shape[0], p.shape[1], h, d)


def _rope(x, pos):
    half = x.shape[-1] // 2
    inv = ROPE_BASE ** (-jnp.arange(half, dtype=jnp.float32) / half)
    ang = pos.astype(jnp.float32)[:, None] * inv[None, :]
    cos = jnp.cos(ang)[:, None, :]
    sin = jnp.sin(ang)[:, None, :]
    x1 = x[..., :half].astype(jnp.float32)
    x2 = x[..., half:].astype(jnp.float32)
    return jnp.concatenate([x1 * cos - x2 * sin, x1 * sin + x2 * cos], axis=-1).astype(x.dtype)


def _axial_rope(x, rows, cols):
    half = x.shape[-1] // 2
    return jnp.concatenate([_rope(x[..., :half], rows), _rope(x[..., half:], cols)], axis=-1)


def _ret_state(k, v, log_g):
    L = k.shape[1]
    w = jnp.exp(log_g[None, :] * (L - 1 - jnp.arange(L, dtype=jnp.float32))[:, None])
    return jnp.einsum('blhd,blhv->bhdv', k * w[None, :, :, None], v).astype(jnp.float32)


def _retention_chunkwise(q, k, v, log_g, s0, include_diag):
    b, L, h, dk = q.shape
    dv = v.shape[-1]
    C = RET_CHUNK
    n = L // C
    qc = q.reshape(b, n, C, h, dk)
    kc = k.reshape(b, n, C, h, dk)
    vc = v.reshape(b, n, C, h, dv)
    pos = jnp.arange(C, dtype=jnp.float32)
    rel = pos[:, None] - pos[None, :]
    mask = (rel >= 0) if include_diag else (rel > 0)
    decay_in = jnp.where(mask[None], jnp.exp(log_g[:, None, None] * jnp.maximum(rel, 0.0)[None]), 0.0)
    scores = jnp.einsum('bnihd,bnjhd->bnhij', qc, kc) * decay_in[None, None]
    o_in = jnp.einsum('bnhij,bnjhv->bnihv', scores, vc)
    k_w = jnp.exp(log_g[None, :] * (C - 1 - pos)[:, None])
    kv_chunk = jnp.einsum('bnjhd,bnjhv->nbhdv', kc * k_w[:, :, None], vc).astype(jnp.float32)
    g_chunk = jnp.exp(log_g * C)[None, :, None, None]

    def step(s, kv):
        return g_chunk * s + kv, s

    _, s_prev = lax.scan(step, s0.astype(jnp.float32), kv_chunk)
    q_w = jnp.exp(log_g[None, :] * (pos + 1.0)[:, None])
    o_x = jnp.einsum('bnihd,nbhdv->bnihv', qc * q_w[:, :, None], s_prev)
    return (o_in + o_x).reshape(b, L, h, dv)


def _bidir_retention(q, k, v, gate, lg_f, lg_b, s_f, s_b):
    o_f = _retention_chunkwise(q, k, v, lg_f, s_f, True)
    o_b = _retention_chunkwise(q[:, ::-1], k[:, ::-1], v[:, ::-1], lg_b, s_b, False)[:, ::-1]
    o = (o_f + o_b).astype(jnp.float32)
    o = o * lax.rsqrt(jnp.mean(o * o, axis=-1, keepdims=True) + NORM_EPS)
    o = o.reshape(o.shape[0], o.shape[1], RET_HEADS * RET_DV)
    return (o * jax.nn.silu(gate.astype(jnp.float32))).astype(gate.dtype)


def _window_attention(q, k, v, k_ctx, v_ctx, sink):
    b, L = q.shape[0], q.shape[1]
    Lc = k_ctx.shape[1]
    Bk = ATT_BLOCK
    n = L // Bk
    qb = q.reshape(b, n, Bk, ATT_KV_HEADS, ATT_GROUP, ATT_DH)
    pad = ((0, 0), (Bk, Bk), (0, 0), (0, 0))
    kp = jnp.pad(k, pad)
    vp = jnp.pad(v, pad)
    kb = jnp.concatenate([kp[:, j * Bk:j * Bk + L].reshape(b, n, Bk, ATT_KV_HEADS, ATT_DH) for j in range(3)], axis=2)
    vb = jnp.concatenate([vp[:, j * Bk:j * Bk + L].reshape(b, n, Bk, ATT_KV_HEADS, ATT_DH) for j in range(3)], axis=2)
    scale = ATT_DH ** -0.5
    s_loc = jnp.einsum('bnqkgd,bnskd->bnkgqs', qb, kb).astype(jnp.float32) * scale
    s_ctx = jnp.einsum('bnqkgd,bckd->bnkgqc', qb, k_ctx).astype(jnp.float32) * scale
    blk = jnp.arange(n)[:, None]
    qpos = (blk * Bk + jnp.arange(Bk)[None, :])[:, :, None]
    kpos = ((blk - 1) * Bk + jnp.arange(3 * Bk)[None, :])[:, None, :]
    valid = (jnp.abs(qpos - kpos) <= WINDOW) & (kpos >= 0) & (kpos < L)
    s_loc = jnp.where(valid[None, :, None, None], s_loc, -jnp.inf)
    sink_b = jnp.broadcast_to(sink.astype(jnp.float32).reshape(ATT_KV_HEADS, ATT_GROUP)[None, None, :, :, None, None],
                              s_loc.shape[:-1] + (1,))
    p = jax.nn.softmax(jnp.concatenate([s_loc, s_ctx, sink_b], axis=-1), axis=-1)
    p_loc = p[..., :3 * Bk].astype(v.dtype)
    p_ctx = p[..., 3 * Bk:3 * Bk + Lc].astype(v.dtype)
    o = jnp.einsum('bnkgqs,bnskd->bnqkgd', p_loc, vb) + jnp.einsum('bnkgqc,bckd->bnqkgd', p_ctx, v_ctx)
    return o.reshape(b, L, ATT_HEADS * ATT_DH)


def _context_attention(q, k, v, sink):
    b, Lc = q.shape[0], q.shape[1]
    qg = q.reshape(b, Lc, ATT_KV_HEADS, ATT_GROUP, ATT_DH)
    s = jnp.einsum('bqkgd,bckd->bkgqc', qg, k).astype(jnp.float32) * (ATT_DH ** -0.5)
    sink_b = jnp.broadcast_to(sink.astype(jnp.float32).reshape(ATT_KV_HEADS, ATT_GROUP)[None, :, :, None, None],
                              s.shape[:-1] + (1,))
    p = jax.nn.softmax(jnp.concatenate([s, sink_b], axis=-1), axis=-1)[..., :Lc].astype(v.dtype)
    o = jnp.einsum('bkgqc,bckd->bqkgd', p, v)
    return o.reshape(b, Lc, ATT_HEADS * ATT_DH)


def _swiglu(h, w_gate, w_up, w_down):
    return (jax.nn.silu(h @ w_gate) * (h @ w_up)) @ w_down


def setup_inputs(seed: int = 0) -> dict:
    key = jax.random.key(seed)
    ks = jax.random.split(key, 18)

    def nrm(k, shape, scale):
        return jax.random.normal(k, shape, jnp.float32) * scale

    base_decay = np.log(-np.log1p(-2.0 ** (-5.0 - np.arange(RET_HEADS)))).astype(np.float32)
    return {
        "x": nrm(ks[0], (BATCH, SEQ, D_MODEL), 1.0),
        "c": nrm(ks[1], (BATCH, D_MODEL), 1.0),
        "ctx": nrm(ks[2], (BATCH, CTX_LEN, D_MODEL), 1.0),
        "c_ctx": nrm(ks[3], (D_MODEL,), 1.0),
        "w_mod": nrm(ks[4], (DEPTH, D_MODEL, 6 * D_MODEL), 0.5 * D_MODEL ** -0.5),
        "b_mod": nrm(ks[5], (DEPTH, 6 * D_MODEL), 0.02),
        "norm_mix": 1.0 + nrm(ks[6], (DEPTH, D_MODEL), 0.02),
        "norm_ffn": 1.0 + nrm(ks[7], (DEPTH, D_MODEL), 0.02),
        "w_in": nrm(ks[8], (DEPTH, D_MODEL, D_PROJ), D_MODEL ** -0.5),
        "ret_decay": jnp.asarray(base_decay)[None, None, :] + nrm(ks[9], (DEPTH, 2, RET_HEADS), 0.05),
        "attn_sink": nrm(ks[10], (DEPTH, ATT_HEADS), 0.5),
        "w_out": nrm(ks[11], (DEPTH, D_MIX_OUT, D_MODEL), D_MIX_OUT ** -0.5),
        "w_gate": nrm(ks[12], (DEPTH, D_MODEL, D_FF), D_MODEL ** -0.5),
        "w_up": nrm(ks[13], (DEPTH, D_MODEL, D_FF), D_MODEL ** -0.5),
        "w_down": nrm(ks[14], (DEPTH, D_FF, D_MODEL), D_FF ** -0.5),
        "norm_final": 1.0 + nrm(ks[15], (D_MODEL,), 0.02),
    }


def reference(x, c, ctx, c_ctx, w_mod, b_mod, norm_mix, norm_ffn, w_in, ret_decay, attn_sink,
              w_out, w_gate, w_up, w_down, norm_final):
    L = x.shape[1]
    ROWS = L // GRID_W
    t = jnp.arange(L)
    rows = jnp.repeat(jnp.arange(ROWS), GRID_W)
    cols = jnp.tile(jnp.arange(GRID_W), ROWS)
    k_scale = RET_DK ** -0.5
    xc = ctx
    for l in range(DEPTH):
        last = l == DEPTH - 1
        mod = (jax.nn.silu(c) @ w_mod[l] + b_mod[l])[:, None, :]
        mod_c = (jax.nn.silu(c_ctx) @ w_mod[l] + b_mod[l])[None, None, :]
        sh_m, sc_m, gt_m, sh_f, sc_f, gt_f = jnp.split(mod, 6, axis=-1)
        sh_mc, sc_mc, gt_mc, sh_fc, sc_fc, gt_fc = jnp.split(mod_c, 6, axis=-1)
        lg_f = -jnp.exp(ret_decay[l, 0].astype(jnp.float32))
        lg_b = -jnp.exp(ret_decay[l, 1].astype(jnp.float32))

        hx = _modulate(x, norm_mix[l], sh_m, sc_m)
        hc = _modulate(xc, norm_mix[l], sh_mc, sc_mc)
        rq, rk, rv, rg, aq, ak, av = _split_proj(hx @ w_in[l])
        crq, crk, crv, crg, caq, cak, cav = _split_proj(hc @ w_in[l])

        crk = _heads(crk, RET_HEADS, RET_DK) * k_scale
        crv = _heads(crv, RET_HEADS, RET_DV)
        s_f = _ret_state(crk, crv, lg_f)
        s_b = _ret_state(crk[:, ::-1], crv[:, ::-1], lg_b)
        q_r = _rope(_heads(rq, RET_HEADS, RET_DK), t)
        k_r = _rope(_heads(rk, RET_HEADS, RET_DK), t) * k_scale
        v_r = _heads(rv, RET_HEADS, RET_DV)
        y_ret = _bidir_retention(q_r, k_r, v_r, rg, lg_f, lg_b, s_f, s_b)

        cak = _heads(cak, ATT_KV_HEADS, ATT_DH)
        cav = _heads(cav, ATT_KV_HEADS, ATT_DH)
        q_a = _axial_rope(_heads(aq, ATT_HEADS, ATT_DH), rows, cols)
        k_a = _axial_rope(_heads(ak, ATT_KV_HEADS, ATT_DH), rows, cols)
        v_a = _heads(av, ATT_KV_HEADS, ATT_DH)
        y_att = _window_attention(q_a, k_a, v_a, cak, cav, attn_sink[l])

        x = x + gt_m * (jnp.concatenate([y_ret, y_att], axis=-1) @ w_out[l])

        if not last:
            zero = jnp.zeros((xc.shape[0], RET_HEADS, RET_DK, RET_DV), jnp.float32)
            y_ret_c = _bidir_retention(_heads(crq, RET_HEADS, RET_DK), crk, crv, crg, lg_f, lg_b, zero, zero)
            y_att_c = _context_attention(_heads(caq, ATT_HEADS, ATT_DH), cak, cav, attn_sink[l])
            xc = xc + gt_mc * (jnp.concatenate([y_ret_c, y_att_c], axis=-1) @ w_out[l])
            xc = xc + gt_fc * _swiglu(_modulate(xc, norm_ffn[l], sh_fc, sc_fc), w_gate[l], w_up[l], w_down[l])

        x = x + gt_f * _swiglu(_modulate(x, norm_ffn[l], sh_f, sc_f), w_gate[l], w_up[l], w_down[l])
    return _rmsnorm(x, norm_final)
```

```cpp
#include <hip/hip_runtime.h>
#include <cstdio>
#include <cstdint>
#include <cmath>

typedef unsigned short bf16;
typedef unsigned u32x4 __attribute__((ext_vector_type(4)));
typedef float f32x4 __attribute__((ext_vector_type(4)));

constexpr int D = 2048, L = 8192, LC = 256, MROWS = L + LC;
constexpr int NPROJ = 4608, DFF = 5632;
constexpr int RH = 8, RDK = 64, RDV = 128, CH = 128, NCH = L / CH;
constexpr int AH = 16, AKV = 4, ADH = 64, WIN = 128;
constexpr float EPS = 1e-6f;
constexpr float LOG2E = 1.4426950408889634f;
constexpr int C_RQ = 0, C_RK = 512, C_RV = 1024, C_RG = 2048, C_AQ = 3072, C_AK = 4096, C_AV = 4352;

constexpr size_t MiB = 1u << 20;
constexpr size_t WS_CTL = 0, CTL_BYTES = 1 * MiB;
constexpr size_t WS_MOD = 1 * MiB;
constexpr size_t WS_HX = 100 * MiB;
constexpr size_t WS_PROJ = 134 * MiB;
constexpr size_t WS_Y = 209 * MiB;
constexpr size_t WS_ACT = 290 * MiB;
constexpr size_t WS_TMP = 209 * MiB;
constexpr size_t WS_OFB = 290 * MiB;
constexpr size_t WS_END = 384 * MiB;

__device__ __forceinline__ float bf2f(bf16 v) { return __uint_as_float((unsigned)v << 16); }
__device__ __forceinline__ bf16 f2bf(float f) { unsigned u = __float_as_uint(f); return (bf16)((u + 0x7fffu + ((u >> 16) & 1u)) >> 16); }
__device__ __forceinline__ float silu_f(float x) { return x / (1.f + __expf(-x)); }

__global__ __launch_bounds__(256) void nv_mod(const float* c, const float* cctx, const float* w_mod, const float* b_mod, float* mod) {
    __shared__ float s[2][D];
    for (int i = threadIdx.x; i < D; i += 256) { s[0][i] = silu_f(c[i]); s[1][i] = silu_f(cctx[i]); }
    __syncthreads();
    const int n = blockIdx.x * 256 + threadIdx.x;
    float a0 = 0.f, a1 = 0.f;
    for (int k = 0; k < D; ++k) { const float w = w_mod[(size_t)k * (6 * D) + n]; a0 += s[0][k] * w; a1 += s[1][k] * w; }
    mod[n] = a0 + b_mod[n]; mod[6 * D + n] = a1 + b_mod[n];
}
__global__ __launch_bounds__(256) void nv_modulate(const float* src, const float* g, const float* shift, const float* scale, bf16* out) {
    __shared__ float red[4];
    const int row = blockIdx.x; const float* x = src + (size_t)row * D;
    float v[8]; float ss = 0.f;
#pragma unroll
    for (int i = 0; i < 8; ++i) { v[i] = x[threadIdx.x + 256 * i]; ss += v[i] * v[i]; }
#pragma unroll
    for (int o = 1; o < 64; o <<= 1) ss += __shfl_xor(ss, o);
    if ((threadIdx.x & 63) == 0) red[threadIdx.x >> 6] = ss;
    __syncthreads();
    const float r = rsqrtf((red[0] + red[1] + red[2] + red[3]) * (1.f / D) + EPS);
#pragma unroll
    for (int i = 0; i < 8; ++i) { const int cidx = threadIdx.x + 256 * i; out[(size_t)row * D + cidx] = f2bf(v[i] * r * g[cidx] * (1.f + scale[cidx]) + shift[cidx]); }
}
template <int MODE> __global__ __launch_bounds__(256) void nv_gemm(const bf16* A, int lda, const float* B, const float* B2, int ldb, int K,
                                                                     float* Cf, bf16* Cb, int ldc, const float* R, const float* gate) {
    __shared__ float As[16][132]; __shared__ float Bs[16][64]; __shared__ float Bs2[16][64];
    const int tid = threadIdx.x, tx = tid & 15, ty = tid >> 4;
    const int m0 = blockIdx.y * 128, n0 = blockIdx.x * 64;
    float acc[8][4], acc2[8][4];
#pragma unroll
    for (int i = 0; i < 8; ++i)
#pragma unroll
        for (int j = 0; j < 4; ++j) { acc[i][j] = 0.f; acc2[i][j] = 0.f; }
    const int arow = tid >> 1, akh = (tid & 1) * 8, bk = tid >> 4, bn4 = (tid & 15) * 4;
    for (int k0 = 0; k0 < K; k0 += 16) {
        const u32x4 av = *(const u32x4*)(A + (size_t)(m0 + arow) * lda + k0 + akh);
        const f32x4 bv = *(const f32x4*)(B + (size_t)(k0 + bk) * ldb + n0 + bn4);
        f32x4 bv2 = bv; if (MODE == 1) bv2 = *(const f32x4*)(B2 + (size_t)(k0 + bk) * ldb + n0 + bn4);
#pragma unroll
        for (int i = 0; i < 4; ++i) { As[akh + 2 * i][arow] = __uint_as_float(av[i] << 16); As[akh + 2 * i + 1][arow] = __uint_as_float(av[i] & 0xffff0000u); }
        *(f32x4*)&Bs[bk][bn4] = bv; if (MODE == 1) *(f32x4*)&Bs2[bk][bn4] = bv2;
        __syncthreads();
#pragma unroll
        for (int k = 0; k < 16; ++k) {
            float a[8], b[4], b2[4];
#pragma unroll
            for (int i = 0; i < 8; ++i) a[i] = As[k][ty * 8 + i];
#pragma unroll
            for (int j = 0; j < 4; ++j) { b[j] = Bs[k][tx * 4 + j]; b2[j] = (MODE == 1) ? Bs2[k][tx * 4 + j] : 0.f; }
#pragma unroll
            for (int i = 0; i < 8; ++i)
#pragma unroll
                for (int j = 0; j < 4; ++j) { acc[i][j] += a[i] * b[j]; if (MODE == 1) acc2[i][j] += a[i] * b2[j]; }
        }
        __syncthreads();
    }
#pragma unroll
    for (int i = 0; i < 8; ++i)
#pragma unroll
        for (int j = 0; j < 4; ++j) {
            const size_t r = m0 + ty * 8 + i; const int cidx = n0 + tx * 4 + j;
            if (MODE == 0) Cf[r * ldc + cidx] = acc[i][j];
            if (MODE == 1) Cb[r * ldc + cidx] = f2bf(silu_f(acc[i][j]) * acc2[i][j]);
            if (MODE == 2) Cf[r * ldc + cidx] = R[r * ldc + cidx] + gate[cidx] * acc[i][j];
        }
}
__global__ __launch_bounds__(256) void nv_proj_epi(const float* tmp, bf16* proj) {
    const size_t idx = (size_t)blockIdx.x * 256 + threadIdx.x;
    const int row = (int)(idx / NPROJ), col = (int)(idx % NPROJ);
    const bool isctx = row >= L; const int t = row;
    const float* tr = tmp + (size_t)row * NPROJ;
    const float v = tr[col]; float o = v;
    if (col < C_RV) {
        if (!isctx) {
            const int d = col & 63, j = d & 31;
            const float inv = powf(10000.f, -(float)j / 32.f), ang = (float)t * inv; float sn, cs; sincosf(ang, &sn, &cs);
            if (d < 32) o = v * cs - tr[col + 32] * sn; else o = tr[col - 32] * sn + v * cs;
        }
        if (col >= C_RK) o *= 0.125f;
    } else if (col < C_RG) {
    } else if (col < C_AQ) { o = silu_f(v);
    } else if (col < C_AV) {
        if (!isctx) {
            const int d = (col - C_AQ) & 63, hf = d >> 5, dd = d & 31, j = dd & 15;
            const int pos = hf == 0 ? (t >> 6) : (t & 63);
            const float inv = powf(10000.f, -(float)j / 16.f), ang = (float)pos * inv; float sn, cs; sincosf(ang, &sn, &cs);
            if (dd < 16) o = v * cs - tr[col + 16] * sn; else o = tr[col - 16] * sn + v * cs;
        }
        if (col < C_AK) o *= 0.125f * LOG2E;
    }
    proj[idx] = f2bf(o);
}
__global__ __launch_bounds__(128) void nv_ret_scan(const bf16* proj, const float* ret_decay, float* ofb) {
    const int h = blockIdx.x & 7, dir = blockIdx.x >> 3, v = threadIdx.x;
    const float gam = __expf(-__expf(ret_decay[dir * RH + h]));
    float S[64];
#pragma unroll
    for (int d = 0; d < 64; ++d) S[d] = 0.f;
    float* out = ofb + (size_t)dir * L * 1024 + h * 128 + v;
    for (int step = 0; step < LC + L; ++step) {
        int row; bool lat;
        if (dir == 0) { lat = step >= LC; row = lat ? step - LC : L + step; }
        else { lat = step >= LC; row = lat ? (L - 1 - (step - LC)) : (L + LC - 1 - step); }
        const bf16* pr = proj + (size_t)row * NPROJ;
        const float vv = bf2f(pr[C_RV + h * 128 + v]);
        float kf[64], qf[64];
#pragma unroll
        for (int i = 0; i < 8; ++i) { const u32x4 kk = *(const u32x4*)(pr + C_RK + h * 64 + i * 8); const u32x4 qq = *(const u32x4*)(pr + C_RQ + h * 64 + i * 8);
#pragma unroll
            for (int e = 0; e < 4; ++e) { kf[i * 8 + 2 * e] = __uint_as_float(kk[e] << 16); kf[i * 8 + 2 * e + 1] = __uint_as_float(kk[e] & 0xffff0000u);
                                          qf[i * 8 + 2 * e] = __uint_as_float(qq[e] << 16); qf[i * 8 + 2 * e + 1] = __uint_as_float(qq[e] & 0xffff0000u); } }
        if (dir == 0) {
            float o = 0.f;
#pragma unroll
            for (int d = 0; d < 64; ++d) { S[d] = gam * S[d] + kf[d] * vv; o += qf[d] * S[d]; }
            if (lat) out[(size_t)row * 1024] = o;
        } else {
            float o = 0.f;
#pragma unroll
            for (int d = 0; d < 64; ++d) { o += qf[d] * S[d]; S[d] = gam * S[d] + kf[d] * vv; }
            if (lat) out[(size_t)row * 1024] = gam * o;
        }
    }
}
__global__ __launch_bounds__(128) void nv_ret_out(const float* ofb, const bf16* proj, bf16* Y) {
    __shared__ float red[2];
    const int t = blockIdx.x >> 3, h = blockIdx.x & 7, v = threadIdx.x;
    const size_t i = (size_t)t * 1024 + h * 128 + v;
    const float o = ofb[i] + ofb[(size_t)L * 1024 + i];
    float ss = o * o;
#pragma unroll
    for (int k = 1; k < 64; k <<= 1) ss += __shfl_xor(ss, k);
    if ((v & 63) == 0) red[v >> 6] = ss;
    __syncthreads();
    const float r = rsqrtf((red[0] + red[1]) * (1.f / 128.f) + EPS);
    Y[(size_t)t * D + h * 128 + v] = f2bf(o * r * bf2f(proj[(size_t)t * NPROJ + C_RG + h * 128 + v]));
}
__global__ __launch_bounds__(64) void nv_attn(const bf16* proj, const float* sink, bf16* Y) {
    const int idx = blockIdx.x * 64 + threadIdx.x; const int hq = idx / L, t = idx % L, kvh = hq >> 2;
    float q[64], acc[64];
    const bf16* qp = proj + (size_t)t * NPROJ + C_AQ + hq * 64;
#pragma unroll
    for (int d = 0; d < 64; ++d) { q[d] = bf2f(qp[d]); acc[d] = 0.f; }
    float m = sink[hq] * LOG2E, l = 1.f;
    const int lo = t - WIN < 0 ? 0 : t - WIN, hi = t + WIN > L - 1 ? L - 1 : t + WIN;
    const int nloc = hi - lo + 1;
    for (int s = 0; s < nloc + LC; ++s) {
        const int row = s < nloc ? lo + s : L + (s - nloc);
        const bf16* kp = proj + (size_t)row * NPROJ + C_AK + kvh * 64; const bf16* vp = proj + (size_t)row * NPROJ + C_AV + kvh * 64;
        float sc = 0.f;
#pragma unroll
        for (int d = 0; d < 64; ++d) sc += q[d] * bf2f(kp[d]);
        float p;
        if (sc > m) { const float f = exp2f(m - sc); l *= f;
#pragma unroll
            for (int d = 0; d < 64; ++d) acc[d] *= f;
            m = sc; p = 1.f; }
        else p = exp2f(sc - m);
        l += p;
#pragma unroll
        for (int d = 0; d < 64; ++d) acc[d] += p * bf2f(vp[d]);
    }
    const float rl = 1.f / l;
    bf16* yp = Y + (size_t)t * D + 1024 + hq * 64;
#pragma unroll
    for (int d = 0; d < 64; ++d) yp[d] = f2bf(acc[d] * rl);
}
__global__ __launch_bounds__(256) void nv_final_norm(float* xio, const float* g) {
    __shared__ float red[4];
    float* x = xio + (size_t)blockIdx.x * D;
    float v[8]; float ss = 0.f;
#pragma unroll
    for (int i = 0; i < 8; ++i) { v[i] = x[threadIdx.x + 256 * i]; ss += v[i] * v[i]; }
#pragma unroll
    for (int o = 1; o < 64; o <<= 1) ss += __shfl_xor(ss, o);
    if ((threadIdx.x & 63) == 0) red[threadIdx.x >> 6] = ss;
    __syncthreads();
    const float r = rsqrtf((red[0] + red[1] + red[2] + red[3]) * (1.f / D) + EPS);
#pragma unroll
    for (int i = 0; i < 8; ++i) { const int c = threadIdx.x + 256 * i; x[c] = v[i] * r * g[c]; }
}

extern "C" void kernel_launch(void* const* d_in, const int* in_sizes, int n_in, void* d_out, int out_size, void* d_ws, size_t ws_size, hipStream_t stream) {
    if (n_in != 16 || in_sizes[0] != L * D || out_size != L * D || ws_size < WS_END) { fprintf(stderr, "kernel_launch: unexpected shapes (n_in %d, in0 %d, out %d, ws %zu)\n", n_in, n_in > 0 ? in_sizes[0] : -1, out_size, ws_size); return; }
    const float* x = (const float*)d_in[0]; const float* c = (const float*)d_in[1]; const float* ctx = (const float*)d_in[2]; const float* cctx = (const float*)d_in[3];
    const float* w_mod = (const float*)d_in[4]; const float* b_mod = (const float*)d_in[5]; const float* norm_mix = (const float*)d_in[6]; const float* norm_ffn = (const float*)d_in[7];
    const float* w_in = (const float*)d_in[8]; const float* ret_decay = (const float*)d_in[9]; const float* sink = (const float*)d_in[10]; const float* w_out = (const float*)d_in[11];
    const float* w_gate = (const float*)d_in[12]; const float* w_up = (const float*)d_in[13]; const float* w_down = (const float*)d_in[14]; const float* norm_final = (const float*)d_in[15];
    unsigned char* ws = (unsigned char*)d_ws; float* out = (float*)d_out;
    float* mod = (float*)(ws + WS_MOD); bf16* HX = (bf16*)(ws + WS_HX); bf16* PROJ = (bf16*)(ws + WS_PROJ); bf16* Y = (bf16*)(ws + WS_Y); bf16* ACT = (bf16*)(ws + WS_ACT);
    float* TMP = (float*)(ws + WS_TMP); float* OFB = (float*)(ws + WS_OFB);
    const float* sh_m = mod, *sc_m = mod + D, *gt_m = mod + 2 * D, *sh_f = mod + 3 * D, *sc_f = mod + 4 * D, *gt_f = mod + 5 * D;
    const float* modc = mod + 6 * D;

    nv_mod<<<6 * D / 256, 256, 0, stream>>>(c, cctx, w_mod, b_mod, mod);
    nv_modulate<<<L, 256, 0, stream>>>(x, norm_mix, sh_m, sc_m, HX);
    nv_modulate<<<LC, 256, 0, stream>>>(ctx, norm_mix, modc, modc + D, HX + (size_t)L * D);
    nv_gemm<0><<<dim3(NPROJ / 64, MROWS / 128), 256, 0, stream>>>(HX, D, w_in, nullptr, NPROJ, D, TMP, nullptr, NPROJ, nullptr, nullptr);
    nv_proj_epi<<<(unsigned)((size_t)MROWS * NPROJ / 256), 256, 0, stream>>>(TMP, PROJ);
    nv_ret_scan<<<16, 128, 0, stream>>>(PROJ, ret_decay, OFB);
    nv_ret_out<<<L * RH, 128, 0, stream>>>(OFB, PROJ, Y);
    nv_attn<<<L * AH / 64, 64, 0, stream>>>(PROJ, sink, Y);
    nv_gemm<2><<<dim3(D / 64, L / 128), 256, 0, stream>>>(Y, D, w_out, nullptr, D, D, out, nullptr, D, x, gt_m);
    nv_modulate<<<L, 256, 0, stream>>>(out, norm_ffn, sh_f, sc_f, HX);
    nv_gemm<1><<<dim3(DFF / 64, L / 128), 256, 0, stream>>>(HX, D, w_gate, w_up, DFF, D, nullptr, ACT, DFF, nullptr, nullptr);
    nv_gemm<2><<<dim3(D / 64, L / 128), 256, 0, stream>>>(ACT, DFF, w_down, nullptr, D, DFF, out, nullptr, D, out, gt_f);
    nv_final_norm<<<L, 256, 0, stream>>>(out, norm_final);
}
```

```cpp
#include <hip/hip_runtime.h>
#include <cstdio>
#include <cstdint>
#include <cmath>

typedef unsigned short bf16;
typedef unsigned u32x4 __attribute__((ext_vector_type(4)));
typedef float f32x4 __attribute__((ext_vector_type(4)));

constexpr int D = 2048, L = 8192, LC = 256, MROWS = L + LC;
constexpr int NPROJ = 4608, DFF = 5632;
constexpr int RH = 8, RDK = 64, RDV = 128, CH = 128, NCH = L / CH;
constexpr int AH = 16, AKV = 4, ADH = 64, WIN = 128;
constexpr float EPS = 1e-6f;
constexpr float LOG2E = 1.4426950408889634f;
constexpr int C_RQ = 0, C_RK = 512, C_RV = 1024, C_RG = 2048, C_AQ = 3072, C_AK = 4096, C_AV = 4352;

constexpr size_t MiB = 1u << 20;
constexpr size_t WS_CTL = 0, CTL_BYTES = 1 * MiB;
constexpr size_t WS_MOD = 1 * MiB;
constexpr size_t WS_HX = 100 * MiB;
constexpr size_t WS_PROJ = 134 * MiB;
constexpr size_t WS_Y = 209 * MiB;
constexpr size_t WS_ACT = 290 * MiB;
constexpr size_t WS_TMP = 209 * MiB;
constexpr size_t WS_OFB = 290 * MiB;
constexpr size_t WS_END = 384 * MiB;

__device__ __forceinline__ float bf2f(bf16 v) { return __uint_as_float((unsigned)v << 16); }
__device__ __forceinline__ bf16 f2bf_n(float f) { unsigned u = __float_as_uint(f); return (bf16)((u + 0x7fffu + ((u >> 16) & 1u)) >> 16); }
__device__ __forceinline__ float silu_f(float x) { return x / (1.f + __expf(-x)); }

__global__ __launch_bounds__(256) void nv_mod(const float* c, const float* cctx, const float* w_mod, const float* b_mod, float* mod) {
    __shared__ float s[2][D];
    for (int i = threadIdx.x; i < D; i += 256) { s[0][i] = silu_f(c[i]); s[1][i] = silu_f(cctx[i]); }
    __syncthreads();
    const int n = blockIdx.x * 256 + threadIdx.x;
    float a0 = 0.f, a1 = 0.f;
    for (int k = 0; k < D; ++k) { const float w = w_mod[(size_t)k * (6 * D) + n]; a0 += s[0][k] * w; a1 += s[1][k] * w; }
    mod[n] = a0 + b_mod[n]; mod[6 * D + n] = a1 + b_mod[n];
}
__global__ __launch_bounds__(256) void nv_modulate(const float* src, const float* g, const float* shift, const float* scale, bf16* out) {
    __shared__ float red[4];
    const int row = blockIdx.x; const float* x = src + (size_t)row * D;
    float v[8]; float ss = 0.f;
#pragma unroll
    for (int i = 0; i < 8; ++i) { v[i] = x[threadIdx.x + 256 * i]; ss += v[i] * v[i]; }
#pragma unroll
    for (int o = 1; o < 64; o <<= 1) ss += __shfl_xor(ss, o);
    if ((threadIdx.x & 63) == 0) red[threadIdx.x >> 6] = ss;
    __syncthreads();
    const float r = rsqrtf((red[0] + red[1] + red[2] + red[3]) * (1.f / D) + EPS);
#pragma unroll
    for (int i = 0; i < 8; ++i) { const int cidx = threadIdx.x + 256 * i; out[(size_t)row * D + cidx] = f2bf_n(v[i] * r * g[cidx] * (1.f + scale[cidx]) + shift[cidx]); }
}
template <int MODE> __global__ __launch_bounds__(256) void nv_gemm(const bf16* A, int lda, const float* B, const float* B2, int ldb, int K,
                                                                     float* Cf, bf16* Cb, int ldc, const float* R, const float* gate) {
    __shared__ float As[16][132]; __shared__ float Bs[16][64]; __shared__ float Bs2[16][64];
    const int tid = threadIdx.x, tx = tid & 15, ty = tid >> 4;
    const int m0 = blockIdx.y * 128, n0 = blockIdx.x * 64;
    float acc[8][4], acc2[8][4];
#pragma unroll
    for (int i = 0; i < 8; ++i)
#pragma unroll
        for (int j = 0; j < 4; ++j) { acc[i][j] = 0.f; acc2[i][j] = 0.f; }
    const int arow = tid >> 1, akh = (tid & 1) * 8, bk = tid >> 4, bn4 = (tid & 15) * 4;
    for (int k0 = 0; k0 < K; k0 += 16) {
        const u32x4 av = *(const u32x4*)(A + (size_t)(m0 + arow) * lda + k0 + akh);
        const f32x4 bv = *(const f32x4*)(B + (size_t)(k0 + bk) * ldb + n0 + bn4);
        f32x4 bv2 = bv; if (MODE == 1) bv2 = *(const f32x4*)(B2 + (size_t)(k0 + bk) * ldb + n0 + bn4);
#pragma unroll
        for (int i = 0; i < 4; ++i) { As[akh + 2 * i][arow] = __uint_as_float(av[i] << 16); As[akh + 2 * i + 1][arow] = __uint_as_float(av[i] & 0xffff0000u); }
        *(f32x4*)&Bs[bk][bn4] = bv; if (MODE == 1) *(f32x4*)&Bs2[bk][bn4] = bv2;
        __syncthreads();
#pragma unroll
        for (int k = 0; k < 16; ++k) {
            float a[8], b[4], b2[4];
#pragma unroll
            for (int i = 0; i < 8; ++i) a[i] = As[k][ty * 8 + i];
#pragma unroll
            for (int j = 0; j < 4; ++j) { b[j] = Bs[k][tx * 4 + j]; b2[j] = (MODE == 1) ? Bs2[k][tx * 4 + j] : 0.f; }
#pragma unroll
            for (int i = 0; i < 8; ++i)
#pragma unroll
                for (int j = 0; j < 4; ++j) { acc[i][j] += a[i] * b[j]; if (MODE == 1) acc2[i][j] += a[i] * b2[j]; }
        }
        __syncthreads();
    }
#pragma unroll
    for (int i = 0; i < 8; ++i)
#pragma unroll
        for (int j = 0; j < 4; ++j) {
            const size_t r = m0 + ty * 8 + i; const int cidx = n0 + tx * 4 + j;
            if (MODE == 0) Cf[r * ldc + cidx] = acc[i][j];
            if (MODE == 1) Cb[r * ldc + cidx] = f2bf_n(silu_f(acc[i][j]) * acc2[i][j]);
            if (MODE == 2) Cf[r * ldc + cidx] = R[r * ldc + cidx] + gate[cidx] * acc[i][j];
        }
}
__global__ __launch_bounds__(256) void nv_proj_epi(const float* tmp, bf16* proj) {
    const size_t idx = (size_t)blockIdx.x * 256 + threadIdx.x;
    const int row = (int)(idx / NPROJ), col = (int)(idx % NPROJ);
    const bool isctx = row >= L; const int t = row;
    const float* tr = tmp + (size_t)row * NPROJ;
    const float v = tr[col]; float o = v;
    if (col < C_RV) {
        if (!isctx) {
            const int d = col & 63, j = d & 31;
            const float inv = powf(10000.f, -(float)j / 32.f), ang = (float)t * inv; float sn, cs; sincosf(ang, &sn, &cs);
            if (d < 32) o = v * cs - tr[col + 32] * sn; else o = tr[col - 32] * sn + v * cs;
        }
        if (col >= C_RK) o *= 0.125f;
    } else if (col < C_RG) {
    } else if (col < C_AQ) { o = silu_f(v);
    } else if (col < C_AV) {
        if (!isctx) {
            const int d = (col - C_AQ) & 63, hf = d >> 5, dd = d & 31, j = dd & 15;
            const int pos = hf == 0 ? (t >> 6) : (t & 63);
            const float inv = powf(10000.f, -(float)j / 16.f), ang = (float)pos * inv; float sn, cs; sincosf(ang, &sn, &cs);
            if (dd < 16) o = v * cs - tr[col + 16] * sn; else o = tr[col - 16] * sn + v * cs;
        }
        if (col < C_AK) o *= 0.125f * LOG2E;
    }
    proj[idx] = f2bf_n(o);
}
__global__ __launch_bounds__(128) void nv_ret_scan(const bf16* proj, const float* ret_decay, float* ofb) {
    const int h = blockIdx.x & 7, dir = blockIdx.x >> 3, v = threadIdx.x;
    const float gam = __expf(-__expf(ret_decay[dir * RH + h]));
    float S[64];
#pragma unroll
    for (int d = 0; d < 64; ++d) S[d] = 0.f;
    float* out = ofb + (size_t)dir * L * 1024 + h * 128 + v;
    for (int step = 0; step < LC + L; ++step) {
        int row; bool lat;
        if (dir == 0) { lat = step >= LC; row = lat ? step - LC : L + step; }
        else { lat = step >= LC; row = lat ? (L - 1 - (step - LC)) : (L + LC - 1 - step); }
        const bf16* pr = proj + (size_t)row * NPROJ;
        const float vv = bf2f(pr[C_RV + h * 128 + v]);
        float kf[64], qf[64];
#pragma unroll
        for (int i = 0; i < 8; ++i) { const u32x4 kk = *(const u32x4*)(pr + C_RK + h * 64 + i * 8); const u32x4 qq = *(const u32x4*)(pr + C_RQ + h * 64 + i * 8);
#pragma unroll
            for (int e = 0; e < 4; ++e) { kf[i * 8 + 2 * e] = __uint_as_float(kk[e] << 16); kf[i * 8 + 2 * e + 1] = __uint_as_float(kk[e] & 0xffff0000u);
                                          qf[i * 8 + 2 * e] = __uint_as_float(qq[e] << 16); qf[i * 8 + 2 * e + 1] = __uint_as_float(qq[e] & 0xffff0000u); } }
        if (dir == 0) {
            float o = 0.f;
#pragma unroll
            for (int d = 0; d < 64; ++d) { S[d] = gam * S[d] + kf[d] * vv; o += qf[d] * S[d]; }
            if (lat) out[(size_t)row * 1024] = o;
        } else {
            float o = 0.f;
#pragma unroll
            for (int d = 0; d < 64; ++d) { o += qf[d] * S[d]; S[d] = gam * S[d] + kf[d] * vv; }
            if (lat) out[(size_t)row * 1024] = gam * o;
        }
    }
}
__global__ __launch_bounds__(128) void nv_ret_out(const float* ofb, const bf16* proj, bf16* Y) {
    __shared__ float red[2];
    const int t = blockIdx.x >> 3, h = blockIdx.x & 7, v = threadIdx.x;
    const size_t i = (size_t)t * 1024 + h * 128 + v;
    const float o = ofb[i] + ofb[(size_t)L * 1024 + i];
    float ss = o * o;
#pragma unroll
    for (int k = 1; k < 64; k <<= 1) ss += __shfl_xor(ss, k);
    if ((v & 63) == 0) red[v >> 6] = ss;
    __syncthreads();
    const float r = rsqrtf((red[0] + red[1]) * (1.f / 128.f) + EPS);
    Y[(size_t)t * D + h * 128 + v] = f2bf_n(o * r * bf2f(proj[(size_t)t * NPROJ + C_RG + h * 128 + v]));
}
__global__ __launch_bounds__(64) void nv_attn(const bf16* proj, const float* sink, bf16* Y) {
    const int idx = blockIdx.x * 64 + threadIdx.x; const int hq = idx / L, t = idx % L, kvh = hq >> 2;
    float q[64], acc[64];
    const bf16* qp = proj + (size_t)t * NPROJ + C_AQ + hq * 64;
#pragma unroll
    for (int d = 0; d < 64; ++d) { q[d] = bf2f(qp[d]); acc[d] = 0.f; }
    float m = sink[hq] * LOG2E, l = 1.f;
    const int lo = t - WIN < 0 ? 0 : t - WIN, hi = t + WIN > L - 1 ? L - 1 : t + WIN;
    const int nloc = hi - lo + 1;
    for (int s = 0; s < nloc + LC; ++s) {
        const int row = s < nloc ? lo + s : L + (s - nloc);
        const bf16* kp = proj + (size_t)row * NPROJ + C_AK + kvh * 64; const bf16* vp = proj + (size_t)row * NPROJ + C_AV + kvh * 64;
        float sc = 0.f;
#pragma unroll
        for (int d = 0; d < 64; ++d) sc += q[d] * bf2f(kp[d]);
        float p;
        if (sc > m) { const float f = exp2f(m - sc); l *= f;
#pragma unroll
            for (int d = 0; d < 64; ++d) acc[d] *= f;
            m = sc; p = 1.f; }
        else p = exp2f(sc - m);
        l += p;
#pragma unroll
        for (int d = 0; d < 64; ++d) acc[d] += p * bf2f(vp[d]);
    }
    const float rl = 1.f / l;
    bf16* yp = Y + (size_t)t * D + 1024 + hq * 64;
#pragma unroll
    for (int d = 0; d < 64; ++d) yp[d] = f2bf_n(acc[d] * rl);
}
__global__ __launch_bounds__(256) void nv_final_norm(float* xio, const float* g) {
    __shared__ float red[4];
    float* x = xio + (size_t)blockIdx.x * D;
    float v[8]; float ss = 0.f;
#pragma unroll
    for (int i = 0; i < 8; ++i) { v[i] = x[threadIdx.x + 256 * i]; ss += v[i] * v[i]; }
#pragma unroll
    for (int o = 1; o < 64; o <<= 1) ss += __shfl_xor(ss, o);
    if ((threadIdx.x & 63) == 0) red[threadIdx.x >> 6] = ss;
    __syncthreads();
    const float r = rsqrtf((red[0] + red[1] + red[2] + red[3]) * (1.f / D) + EPS);
#pragma unroll
    for (int i = 0; i < 8; ++i) { const int c = threadIdx.x + 256 * i; x[c] = v[i] * r * g[c]; }
}

namespace pg8 {
#define PG8_LAS __attribute__((address_space(3)))
typedef unsigned short bf16_t;
typedef short bf16x8 __attribute__((ext_vector_type(8)));
typedef float f32x4 __attribute__((ext_vector_type(4)));
typedef unsigned u32x4 __attribute__((ext_vector_type(4)));
constexpr int BM = 256, BK = 64, HALF = 128, HTB = HALF * BK * 2  , STAGE_BYTES = 8 * HTB, NXCD = 8, WGM = 8;

__host__ __device__ __forceinline__ int lds_byte(int r, int c) { const int st = (r >> 4) * 2 + (c >> 5), rr = r & 15, cc = c & 31, ob = rr * 64 + cc * 2; return st * 1024 + (ob ^ (((ob >> 9) & 1) << 5)); }
__host__ __device__ __forceinline__ void stage_rc(int b, int& R, int& C) { const int st = b / 1024, sb = b % 1024, swz = sb ^ (((sb >> 9) & 1) << 5); R = (st >> 1) * 16 + swz / 64; C = (st & 1) * 32 + (swz % 64) / 2; }
__host__ __device__ __forceinline__ int perm32(int rho) { const int n = rho >> 4, i = rho & 15; return 8 * (i >> 2) + 4 * n + (i & 3); }

struct Unit { int pm, pn; };
struct Gemm { const bf16_t* A; const bf16_t* Bt; int M, N, K; };

struct StaticOrder {
    int nM, nN, nwg, G, c;
    __host__ __device__ void init(int M, int N, int G_, int c_) { nM = M / BM; nN = N / BM; nwg = nM * nN; G = G_; c = c_; }
    __host__ __device__ bool next(int i, Unit& u) const {
        const long L = (long)i * G + c; if (L >= nwg) return false;
        int wgid = (int)L; { const int q = nwg / NXCD, r = nwg % NXCD, xcd = wgid % NXCD, off = wgid / NXCD; wgid = (xcd < r ? xcd * (q + 1) : r * (q + 1) + (xcd - r) * q) + off; }
        const int nig = WGM * nN, gid = wgid / nig, fm = gid * WGM, gsz = (nM - fm) < WGM ? (nM - fm) : WGM;
        u.pm = fm + ((wgid % nig) % gsz); u.pn = (wgid % nig) / gsz; return true;
    }
    __device__ __forceinline__ void a_ready(const Unit&) const {}
    __device__ __forceinline__ void done(const Unit&) const {}
};
__device__ __forceinline__ unsigned cvt_pk_bf16(float lo, float hi) { unsigned r; asm volatile("v_cvt_pk_bf16_f32 %0, %1, %2" : "=v"(r) : "v"(lo), "v"(hi)); return r; }
typedef float f32x2 __attribute__((ext_vector_type(2)));
template <class Epi, class Sched, bool ALIGN_EPI = false, bool SP2 = false>
__device__ __forceinline__ void gemm_phase(PG8_LAS unsigned char* lds, const Gemm g, const Sched& S, const Epi& E) {
    const int tid = threadIdx.x, wid = __builtin_amdgcn_readfirstlane(tid >> 6), lane = tid & 63, wr = wid >> 2, wc = wid & 3, fr = lane & 15, fq = lane >> 4;
    const int K = g.K, nt = K / BK;
    unsigned voffA[2], voffB[2];
#pragma unroll
    for (int i = 0; i < 2; ++i) { int R, C; stage_rc(tid * 16 + i * 8192, R, C); const int Rb = Epi::PERM ? ((R & ~31) + perm32(R & 31)) : R;
        voffA[i] = (unsigned)(R * K + C) * 2u; voffB[i] = (unsigned)(Rb * K + C) * 2u; }
    const size_t kstep = (size_t)(BK * 2);
    const size_t hstep = (size_t)HALF * K * 2;
    const size_t tstep = 2 * hstep;
    const unsigned ldsw = (unsigned)wid * 1024u;
    const int aoff = lds_byte(wr * 64 + fr, fq * 8), boff = lds_byte(wc * 32 + fr, fq * 8);
#define PG8_SA(b, h) (((b) * 2 + (h)) * HTB)
#define PG8_SB(b, h) ((4 + (b) * 2 + (h)) * HTB)
#define PG8_STAGE(bufoff, gbase, voff) do { _Pragma("unroll") for (int _i = 0; _i < 2; ++_i) \
        __builtin_amdgcn_global_load_lds((const unsigned*)((const char*)(gbase) + (voff)[_i]), (PG8_LAS unsigned*)(lds + (bufoff) + ldsw + _i * 8192), 16, 0, 0); } while (0)
#define PG8_LDA(dst, b, h) do { _Pragma("unroll") for (int m = 0; m < 4; ++m) _Pragma("unroll") for (int k = 0; k < 2; ++k) dst[m][k] = *(const PG8_LAS bf16x8*)(lds + PG8_SA(b, h) + aoff + m * 2048 + k * 1024); } while (0)
#define PG8_LDB(dst, b, h) do { _Pragma("unroll") for (int n = 0; n < 2; ++n) _Pragma("unroll") for (int k = 0; k < 2; ++k) dst[n][k] = *(const PG8_LAS bf16x8*)(lds + PG8_SB(b, h) + boff + n * 2048 + k * 1024); } while (0)
#define PG8_MMA(ai, bj, At, Bt) do { __builtin_amdgcn_s_setprio(1); _Pragma("unroll") for (int m = 0; m < 4; ++m) _Pragma("unroll") for (int n = 0; n < 2; ++n) _Pragma("unroll") for (int k = 0; k < 2; ++k) \
        acc[ai][bj][m][n] = __builtin_amdgcn_mfma_f32_16x16x32_bf16(Bt[n][k], At[m][k], acc[ai][bj][m][n], 0, 0, 0); __builtin_amdgcn_s_setprio(0); } while (0)
#define PG8_WAIT_V(n) asm volatile("s_waitcnt vmcnt(" #n ")" ::: "memory")
#define PG8_WAIT_L(n) asm volatile("s_waitcnt lgkmcnt(" #n ")" ::: "memory")
#define PG8_BAR __builtin_amdgcn_s_barrier()
#define PG8_SCHED __builtin_amdgcn_sched_barrier(0)
    Unit cur, nxt; int ui = 0;
    if (!S.next(0, cur)) return;
    f32x4 acc[2][2][4][2];
#pragma unroll
    for (int a = 0; a < 2; ++a)
#pragma unroll
        for (int b = 0; b < 2; ++b)
#pragma unroll
            for (int m = 0; m < 4; ++m)
#pragma unroll
                for (int n = 0; n < 2; ++n) acc[a][b][m][n] = (f32x4){0.f, 0.f, 0.f, 0.f};
    bf16x8 At[4][2], B0[2][2], B1[2][2];
    const char* cA = (const char*)g.A + (size_t)cur.pm * tstep; const char* cB = (const char*)g.Bt + (size_t)cur.pn * tstep;
    S.a_ready(cur);
    if constexpr (SP2) {
        PG8_STAGE(PG8_SB(0, 0), cB, voffB); PG8_STAGE(PG8_SB(0, 1), cB + hstep, voffB); PG8_STAGE(PG8_SA(0, 0), cA, voffA); PG8_STAGE(PG8_SA(0, 1), cA + hstep, voffA);
        if (wr == 1) PG8_BAR;
        PG8_WAIT_V(2); PG8_BAR;
        PG8_STAGE(PG8_SB(1, 0), cB + kstep, voffB); PG8_STAGE(PG8_SA(1, 0), cA + kstep, voffA); PG8_STAGE(PG8_SB(1, 1), cB + hstep + kstep, voffB);
        PG8_WAIT_V(6); PG8_BAR;
    } else {
        PG8_STAGE(PG8_SB(0, 0), cB, voffB); PG8_STAGE(PG8_SA(0, 0), cA, voffA); PG8_STAGE(PG8_SB(0, 1), cB + hstep, voffB); PG8_STAGE(PG8_SA(0, 1), cA + hstep, voffA);
        if (wr == 1) PG8_BAR;
        PG8_WAIT_V(4); PG8_BAR;
        PG8_STAGE(PG8_SB(1, 0), cB + kstep, voffB); PG8_STAGE(PG8_SA(1, 0), cA + kstep, voffA); PG8_STAGE(PG8_SB(1, 1), cB + hstep + kstep, voffB);
        PG8_WAIT_V(6); PG8_BAR;
    }
    for (;;) {
        const bool has_next = S.next(ui + 1, nxt);
        const char* nA = has_next ? (const char*)g.A + (size_t)nxt.pm * tstep : cA; const char* nB = has_next ? (const char*)g.Bt + (size_t)nxt.pn * tstep : cB;
        for (int t = 0; t < nt; t += 2) {
            const bool last = (t == nt - 2);
            const char* a1 = cA + (size_t)(t + 1) * kstep;
            const char* a2 = last ? nA : cA + (size_t)(t + 2) * kstep; const char* b2 = last ? nB : cB + (size_t)(t + 2) * kstep;
            const char* a3 = a2 + kstep; const char* b3 = b2 + kstep;
            if (last && has_next) S.a_ready(nxt);
            if constexpr (SP2) {
            PG8_LDB(B0, 0, 0); PG8_LDB(B1, 0, 1); PG8_SCHED; PG8_LDA(At, 0, 0); PG8_STAGE(PG8_SA(1, 1), a1 + hstep, voffA);
            PG8_WAIT_V(8); PG8_WAIT_L(0); PG8_BAR; PG8_MMA(0, 0, At, B0); PG8_MMA(0, 1, At, B1); PG8_BAR; PG8_SCHED;
            PG8_LDA(At, 0, 1); PG8_STAGE(PG8_SB(0, 0), b2, voffB); PG8_STAGE(PG8_SB(0, 1), b2 + hstep, voffB); PG8_STAGE(PG8_SA(0, 0), a2, voffA);
            PG8_WAIT_V(8); PG8_WAIT_L(0); PG8_BAR; PG8_MMA(1, 0, At, B0); PG8_MMA(1, 1, At, B1); PG8_BAR; PG8_SCHED;
            PG8_LDB(B0, 1, 0); PG8_LDB(B1, 1, 1); PG8_SCHED; PG8_LDA(At, 1, 0); PG8_STAGE(PG8_SA(0, 1), a2 + hstep, voffA);
            PG8_WAIT_V(8); PG8_WAIT_L(0); PG8_BAR; PG8_MMA(0, 0, At, B0); PG8_MMA(0, 1, At, B1); PG8_BAR; PG8_SCHED;
            PG8_LDA(At, 1, 1); PG8_STAGE(PG8_SB(1, 0), b3, voffB); PG8_STAGE(PG8_SB(1, 1), b3 + hstep, voffB); PG8_STAGE(PG8_SA(1, 0), a3, voffA);
            PG8_WAIT_V(8); PG8_WAIT_L(0); PG8_BAR; PG8_MMA(1, 0, At, B0); PG8_MMA(1, 1, At, B1); PG8_BAR; PG8_SCHED;
            } else {
            PG8_LDB(B0, 0, 0); PG8_SCHED; PG8_LDA(At, 0, 0); PG8_STAGE(PG8_SA(1, 1), a1 + hstep, voffA);
            PG8_WAIT_L(8); PG8_BAR; PG8_WAIT_L(0); PG8_MMA(0, 0, At, B0); PG8_BAR; PG8_SCHED;
            PG8_LDB(B1, 0, 1); PG8_STAGE(PG8_SB(0, 0), b2, voffB);
            PG8_BAR; PG8_WAIT_L(0); PG8_MMA(0, 1, At, B1); PG8_BAR;
            PG8_LDA(At, 0, 1); PG8_STAGE(PG8_SA(0, 0), a2, voffA);
            PG8_BAR; PG8_WAIT_L(0); PG8_MMA(1, 0, At, B0); PG8_BAR; PG8_SCHED;
            PG8_STAGE(PG8_SB(0, 1), b2 + hstep, voffB);
            PG8_WAIT_V(6); PG8_BAR; PG8_MMA(1, 1, At, B1); PG8_BAR;
            PG8_LDB(B0, 1, 0); PG8_SCHED; PG8_LDA(At, 1, 0); PG8_STAGE(PG8_SA(0, 1), a2 + hstep, voffA);
            PG8_WAIT_L(8); PG8_BAR; PG8_WAIT_L(0); PG8_MMA(0, 0, At, B0); PG8_BAR; PG8_SCHED;
            PG8_LDB(B1, 1, 1); PG8_STAGE(PG8_SB(1, 0), b3, voffB);
            PG8_BAR; PG8_WAIT_L(0); PG8_MMA(0, 1, At, B1); PG8_BAR;
            PG8_LDA(At, 1, 1); PG8_STAGE(PG8_SA(1, 0), a3, voffA);
            PG8_BAR; PG8_WAIT_L(0); PG8_MMA(1, 0, At, B0); PG8_BAR; PG8_SCHED;
            PG8_STAGE(PG8_SB(1, 1), b3 + hstep, voffB);
            PG8_WAIT_V(6); PG8_BAR; PG8_MMA(1, 1, At, B1); PG8_BAR;
            }
        }
        if constexpr (ALIGN_EPI) { if (wr == 0) PG8_BAR; }
        if constexpr (!Epi::AFTER_DRAIN) { E(acc, cur, wr, wc, fr, fq); S.done(cur); }
        if (!has_next) break;
#pragma unroll
        for (int a = 0; a < 2; ++a)
#pragma unroll
            for (int b = 0; b < 2; ++b)
#pragma unroll
                for (int m = 0; m < 4; ++m)
#pragma unroll
                    for (int n = 0; n < 2; ++n) acc[a][b][m][n] = (f32x4){0.f, 0.f, 0.f, 0.f};
        cur = nxt; cA = nA; cB = nB; ++ui;
        if constexpr (ALIGN_EPI) { if (wr == 1) PG8_BAR; }
    }
    PG8_WAIT_V(0);
    if constexpr (!ALIGN_EPI) { if (wr == 0) PG8_BAR; }
    PG8_BAR;
    if constexpr (Epi::AFTER_DRAIN) { E.fused(acc, cur, wr, wc, fr, fq, lds, wid, lane); S.done(cur); }
#undef PG8_SA
#undef PG8_SB
#undef PG8_STAGE
#undef PG8_LDA
#undef PG8_LDB
#undef PG8_MMA
#undef PG8_WAIT_V
#undef PG8_WAIT_L
#undef PG8_BAR
#undef PG8_SCHED
}
}
namespace pg8 {
__device__ __forceinline__ float silu_fast(float x) { return x * __builtin_amdgcn_rcpf(1.f + __expf(-x)); }
struct EpiProj {
    static constexpr bool PERM = true, AFTER_DRAIN = false;
    bf16_t* P; const float* rtc; const float* rts; const float* axc; const float* axs;
    __device__ __forceinline__ void operator()(const f32x4 (&acc)[2][2][4][2], const Unit& u, int wr, int wc, int fr, int fq) const {
        const int pn = u.pn; const bool isctx = (u.pm == 32);
        const int row0 = u.pm * BM + wr * 64 + fr;
        int type = 0; float sc = 1.f;
        if (pn < 4) { type = 2; if (pn >= 2) sc = 0.125f; }
        else if (pn < 8) type = 0;
        else if (pn < 12) type = 1;
        else if (pn < 17) { type = 3; if (pn < 16) sc = 0.125f * 1.4426950408889634f; }
        if (type < 2) {
#pragma unroll
            for (int ai = 0; ai < 2; ++ai)
#pragma unroll
                for (int m = 0; m < 4; ++m) { bf16_t* rowp = P + (size_t)(row0 + ai * HALF + m * 16) * 4608 + pn * BM + wc * 32 + 8 * fq;
#pragma unroll
                    for (int bj = 0; bj < 2; ++bj) { f32x4 v0 = acc[ai][bj][m][0], v1 = acc[ai][bj][m][1];
                        if (type == 1) {
#pragma unroll
                            for (int e = 0; e < 4; ++e) { v0[e] = silu_fast(v0[e]); v1[e] = silu_fast(v1[e]); } }
                        u32x4 w; w.x = cvt_pk_bf16(v0[0], v0[1]); w.y = cvt_pk_bf16(v0[2], v0[3]); w.z = cvt_pk_bf16(v1[0], v1[1]); w.w = cvt_pk_bf16(v1[2], v1[3]);
                        *(u32x4*)(rowp + bj * HALF) = w; } }
        } else {
            const int hf = fq >> 1;
#pragma unroll
            for (int ai = 0; ai < 2; ++ai)
#pragma unroll
                for (int m = 0; m < 4; ++m) { const int r = row0 + ai * HALF + m * 16;
                    f32x4 cs[2], sn[2];
                    if (isctx) { cs[0] = cs[1] = (f32x4){1.f, 1.f, 1.f, 1.f}; sn[0] = sn[1] = (f32x4){0.f, 0.f, 0.f, 0.f}; }
                    else if (type == 2) { const size_t o = (size_t)r * 32 + 8 * fq; cs[0] = *(const f32x4*)(rtc + o); cs[1] = *(const f32x4*)(rtc + o + 4); sn[0] = *(const f32x4*)(rts + o); sn[1] = *(const f32x4*)(rts + o + 4); }
                    else { const int pos = hf ? (r & 63) : (r >> 6); const int o = pos * 16 + 8 * (fq & 1); cs[0] = *(const f32x4*)(axc + o); cs[1] = *(const f32x4*)(axc + o + 4); sn[0] = *(const f32x4*)(axs + o); sn[1] = *(const f32x4*)(axs + o + 4); }
                    f32x4 o1[2], o2[2];
#pragma unroll
                    for (int n = 0; n < 2; ++n) { const f32x4 x1 = acc[ai][0][m][n], x2 = acc[ai][1][m][n]; o1[n] = (x1 * cs[n] - x2 * sn[n]) * sc; o2[n] = (x1 * sn[n] + x2 * cs[n]) * sc; }
                    u32x4 w1, w2; w1.x = cvt_pk_bf16(o1[0][0], o1[0][1]); w1.y = cvt_pk_bf16(o1[0][2], o1[0][3]); w1.z = cvt_pk_bf16(o1[1][0], o1[1][1]); w1.w = cvt_pk_bf16(o1[1][2], o1[1][3]);
                    w2.x = cvt_pk_bf16(o2[0][0], o2[0][1]); w2.y = cvt_pk_bf16(o2[0][2], o2[0][3]); w2.z = cvt_pk_bf16(o2[1][0], o2[1][1]); w2.w = cvt_pk_bf16(o2[1][2], o2[1][3]);
                    bf16_t* rowp = P + (size_t)r * 4608 + pn * BM + wc * 64;
                    if (type == 2) { *(u32x4*)(rowp + 8 * fq) = w1; *(u32x4*)(rowp + 32 + 8 * fq) = w2; }
                    else { *(u32x4*)(rowp + 32 * hf + 8 * (fq & 1)) = w1; *(u32x4*)(rowp + 32 * hf + 16 + 8 * (fq & 1)) = w2; } }
        }
    }
};
struct EpiResid {
    static constexpr bool PERM = false, AFTER_DRAIN = false;
    const float* R; float* out; const float* gate; int ldc;
    __device__ __forceinline__ void operator()(const f32x4 (&acc)[2][2][4][2], const Unit& u, int wr, int wc, int fr, int fq) const {
        const int row0 = u.pm * BM + wr * 64 + fr, col0 = u.pn * BM + wc * 32 + 4 * fq;
        f32x4 gv[2][2];
#pragma unroll
        for (int bj = 0; bj < 2; ++bj)
#pragma unroll
            for (int n = 0; n < 2; ++n) gv[bj][n] = *(const f32x4*)(gate + col0 + bj * HALF + n * 16);
#pragma unroll
        for (int ai = 0; ai < 2; ++ai)
#pragma unroll
            for (int m = 0; m < 4; ++m) { const size_t off = (size_t)(row0 + ai * HALF + m * 16) * ldc + col0;
#pragma unroll
                for (int bj = 0; bj < 2; ++bj)
#pragma unroll
                    for (int n = 0; n < 2; ++n) { const f32x4 rs = *(const f32x4*)(R + off + bj * HALF + n * 16); *(f32x4*)(out + off + bj * HALF + n * 16) = rs + gv[bj][n] * acc[ai][bj][m][n]; } }
    }
};
struct EpiSwiglu {
    static constexpr bool PERM = true, AFTER_DRAIN = false;
    bf16_t* O; int ldc;
    __device__ __forceinline__ void operator()(const f32x4 (&acc)[2][2][4][2], const Unit& u, int wr, int wc, int fr, int fq) const {
        const int row0 = u.pm * BM + wr * 64 + fr, col0 = u.pn * HALF + wc * 32 + 8 * fq;
#pragma unroll
        for (int ai = 0; ai < 2; ++ai)
#pragma unroll
            for (int m = 0; m < 4; ++m) { f32x4 v[2];
#pragma unroll
                for (int n = 0; n < 2; ++n) { const f32x4 g = acc[ai][0][m][n], up = acc[ai][1][m][n];
#pragma unroll
                    for (int e = 0; e < 4; ++e) v[n][e] = silu_fast(g[e]) * up[e]; }
                u32x4 w; w.x = cvt_pk_bf16(v[0][0], v[0][1]); w.y = cvt_pk_bf16(v[0][2], v[0][3]); w.z = cvt_pk_bf16(v[1][0], v[1][1]); w.w = cvt_pk_bf16(v[1][2], v[1][3]);
                *(u32x4*)(O + (size_t)(row0 + ai * HALF + m * 16) * ldc + col0) = w; }
    }
};
}
#define GAS __attribute__((address_space(1)))
#define LAS __attribute__((address_space(3)))
typedef unsigned short bf16;
typedef unsigned v4u __attribute__((ext_vector_type(4)));
typedef float f32x4 __attribute__((ext_vector_type(4)));
typedef short bf16x8 __attribute__((ext_vector_type(8)));
typedef GAS unsigned gu32;
typedef GAS unsigned long long gu64;
#define RLX_AGENT __ATOMIC_RELAXED, __HIP_MEMORY_SCOPE_AGENT
#define LDS_WAIT() asm volatile("s_waitcnt lgkmcnt(0)" ::: "memory")
#define VM_WAIT() asm volatile("s_waitcnt vmcnt(0)" ::: "memory")
__device__ __forceinline__ unsigned long long rt() { return __builtin_amdgcn_s_memrealtime(); }
__device__ __forceinline__ unsigned f2bf(float f) { unsigned u = __builtin_bit_cast(unsigned, f); return (u + 0x7fffu + ((u >> 16) & 1u)) >> 16; }
__device__ __forceinline__ unsigned pk2(float lo, float hi) { return f2bf(lo) | (f2bf(hi) << 16); }
#define XB_TMO      128
#define XB_XCNT(j)  (256  + 64 * (j))
#define XB_XSUB(j)  (1280 + 64 * (j))
#define XB_XGEN(j)  (2304 + 64 * (j))
#define XB_TOP      3328
#define XB_TOPGEN   3392
#define XCD_BAR_WORDS 3456
#define XB_SPIN_CAP (1u << 18)

__device__ __forceinline__ unsigned xb_ld(unsigned* p)              { return __hip_atomic_load(p, __ATOMIC_RELAXED, __HIP_MEMORY_SCOPE_AGENT); }
__device__ __forceinline__ unsigned xb_add(unsigned* p, unsigned v) { return __hip_atomic_fetch_add(p, v, __ATOMIC_RELAXED, __HIP_MEMORY_SCOPE_AGENT); }
__device__ __forceinline__ unsigned xb_xcc_id() { return (unsigned)__builtin_amdgcn_s_getreg((3 << 11) | 20) & 0xFu; }
#define XB_SPIN(cond, bar) do { unsigned _sp = 0; while (cond) { __builtin_amdgcn_s_sleep(1); \
    if ((++_sp & 255u) == 0u) { if (xb_ld(&(bar)[XB_TMO])) break; if (_sp > XB_SPIN_CAP) { atomicAdd(&(bar)[XB_TMO], 1u); break; } } } } while (0)

struct XcdBarrier {
    unsigned* bar; unsigned x;
    volatile LAS unsigned* st;
};

__device__ __forceinline__ XcdBarrier xcd_barrier_post(unsigned* bar, volatile LAS unsigned* st) {
    XcdBarrier b; b.bar = bar; b.x = xb_xcc_id(); b.st = st;
    if (threadIdx.x == 0) (void)xb_add(&bar[XB_XCNT(b.x)], 1u);
    return b;
}
__device__ __forceinline__ void xcd_barrier_complete(unsigned* bar, unsigned x, unsigned& nloc, unsigned& nx) {
    const unsigned G = gridDim.x * gridDim.y * gridDim.z;
    unsigned sum, cnt, mine, sp = 0u;
    for (;;) {
        sum = 0u; cnt = 0u; mine = 0u;
#pragma unroll
        for (unsigned j = 0; j < 16; ++j) { const unsigned c = xb_ld(&bar[XB_XCNT(j)]); sum += c; cnt += (c > 0u) ? 1u : 0u; mine = (j == x) ? c : mine; }
        if (sum == G) break;
        __builtin_amdgcn_s_sleep(1);
        if ((++sp & 255u) == 0u) { if (xb_ld(&bar[XB_TMO])) break; if (sp > XB_SPIN_CAP) { atomicAdd(&bar[XB_TMO], 1u); break; } }
    }
    nloc = mine > 0u ? mine : 1u; nx = cnt > 0u ? cnt : 1u;
}

__device__ __forceinline__ void xcd_barrier(const XcdBarrier& b) {
    asm volatile("s_waitcnt vmcnt(0)" ::: "memory");
    __syncthreads();
    if (threadIdx.x == 0) {
        unsigned* bar = b.bar;
        __builtin_amdgcn_s_waitcnt(0);
        unsigned nloc = b.st[0], nx = b.st[1];
        if (nloc == 0u) { xcd_barrier_complete(bar, b.x, nloc, nx); b.st[0] = nloc; b.st[1] = nx; }
        const unsigned old = xb_add(&bar[XB_XSUB(b.x)], 1u);
        const unsigned gen = old / nloc;
        if (old + 1u == (gen + 1u) * nloc) {
            __builtin_amdgcn_fence(__ATOMIC_RELEASE, "agent");
            asm volatile("s_waitcnt vmcnt(0)" ::: "memory");
            const unsigned og = xb_add(&bar[XB_TOP], 1u);
            const unsigned tg = og / nx;
            if (og + 1u == (tg + 1u) * nx) xb_add(&bar[XB_TOPGEN], 1u);
            else XB_SPIN(xb_ld(&bar[XB_TOPGEN]) == tg, bar);
            __builtin_amdgcn_fence(__ATOMIC_ACQUIRE, "agent");
            xb_add(&bar[XB_XGEN(b.x)], 1u);
            asm volatile("s_waitcnt vmcnt(0)" ::: "memory");
        } else {
            XB_SPIN(xb_ld(&bar[XB_XGEN(b.x)]) == gen, bar);
            __builtin_amdgcn_fence(__ATOMIC_ACQUIRE, "agent");
            asm volatile("s_waitcnt vmcnt(0)" ::: "memory");
        }
    }
    __syncthreads();
}
constexpr int NWAVES = 8;
constexpr int RING_OFF = 0, RING_BYTES = 131072;
constexpr int LDSCTL_OFF = RING_BYTES, MISC_OFF = LDSCTL_OFF + 320;
constexpr int LDS_BYTES = 147456;
constexpr size_t WS_MODACC = 512 * 1024;
constexpr size_t WS_RT = 2 * MiB;
constexpr size_t WS_AXT = 4 * MiB;
constexpr size_t WS_WIN = 8 * MiB, WS_WOUT = 26 * MiB, WS_WGU = 34 * MiB, WS_WDN = 78 * MiB;
constexpr size_t WS_KVT = 241 * MiB;
constexpr size_t WS_SPT = 274 * MiB;
constexpr int CW_TMO = 0, CW_CODE = 1, CW_BAR = 4096;

struct Frame {
    LAS unsigned char* lds; volatile LAS unsigned* MISC; gu32* ctl;
    int tid, lane, wave, vcu, G;
};
__device__ __forceinline__ float wave_sum(float v) {
#pragma unroll
    for (int o = 1; o < 64; o <<= 1) v += __shfl_xor(v, o);
    return v;
}
__device__ __forceinline__ int sigma_in(int p) {
    const int pn = p >> 8, q = p & 255, bj = q >> 7, wc = (q >> 5) & 3, off = q & 31;
    if (pn < 4) return pn * 256 + wc * 64 + bj * 32 + off;
    if (pn >= 12 && pn < 17) return pn * 256 + wc * 64 + (off >> 4) * 32 + bj * 16 + (off & 15);
    return p;
}
__device__ __forceinline__ void p0_transpose_item(const float* W, int K, int N, bf16* WT, int p0, int k0, int srccol, LAS float* scr, int lane) {
#pragma unroll 8
    for (int i = 0; i < 32; ++i) { const int kk = 2 * i + (lane >> 5); scr[kk * 33 + (lane & 31)] = W[(size_t)(k0 + kk) * N + srccol]; }
    LDS_WAIT(); asm volatile("" ::: "memory");
    const int c = lane & 7;
#pragma unroll
    for (int j = 0; j < 4; ++j) { const int n = (lane >> 3) + 8 * j; const LAS float* s = scr + (8 * c) * 33 + n;
        v4u o; o.x = pk2(s[0 * 33], s[1 * 33]); o.y = pk2(s[2 * 33], s[3 * 33]); o.z = pk2(s[4 * 33], s[5 * 33]); o.w = pk2(s[6 * 33], s[7 * 33]);
        *(GAS v4u*)(WT + (size_t)(p0 + n) * K + k0 + 8 * c) = o; }
    LDS_WAIT(); asm volatile("" ::: "memory");
}
struct Args { const float* in[16]; float* out; unsigned char* ws; int ph_lo, ph_hi, li, pad; };

__device__ __forceinline__ void p0_prologue(Frame& F, const Args& a) {
    LAS float* scr = (LAS float*)(F.lds + RING_OFF + F.wave * 16384);
    const int gw = F.vcu * NWAVES + F.wave, NGW = F.G * NWAVES, lane = F.lane;
    const float* w_mod = a.in[4]; const float* w_in = a.in[8]; const float* w_out = a.in[11]; const float* w_gate = a.in[12]; const float* w_up = a.in[13]; const float* w_down = a.in[14];
    float* modacc = (float*)(a.ws + WS_MODACC);
    constexpr int I_GEMV = 48 * 32, I_RT = 128, I_AX = 1;
    constexpr int I_IN = 144 * 32, I_OUT = 64 * 32, I_GU = 352 * 32, I_DN = 64 * 88;
    constexpr int NITEMS = I_GEMV + I_RT + I_AX + I_IN + I_OUT + I_GU + I_DN;
    for (int it = gw; it < NITEMS; it += NGW) {
        int r = it;
        if (r < I_GEMV) {
            const int strip = r % 48, ks = r / 48; const int n = strip * 256 + 4 * lane;
            f32x4 a0 = {0.f, 0.f, 0.f, 0.f}, a1 = {0.f, 0.f, 0.f, 0.f};
            const float cv = a.in[1][ks * 64 + lane], cc = a.in[3][ks * 64 + lane];
            const float s0 = cv / (1.f + __expf(-cv)), s1 = cc / (1.f + __expf(-cc));
#pragma unroll 16
            for (int k = 0; k < 64; ++k) { const f32x4 w = *(const GAS f32x4*)(w_mod + (size_t)(ks * 64 + k) * (6 * D) + n);
                const float t0 = __shfl(s0, k), t1 = __shfl(s1, k); a0 += w * t0; a1 += w * t1; }
            if (ks == 0) { const f32x4 b = *(const f32x4*)(a.in[5] + n); a0 += b; a1 += b; }
#pragma unroll
            for (int e = 0; e < 4; ++e) { unsafeAtomicAdd(modacc + n + e, a0[e]); unsafeAtomicAdd(modacc + 6 * D + n + e, a1[e]); }
            continue; }
        r -= I_GEMV;
        if (r < I_RT) {
            const int t = r * 64 + lane; float* rc = (float*)(a.ws + WS_RT); float* rs = (float*)(a.ws + WS_RT + MiB);
            for (int j = 0; j < 32; ++j) { const float inv = powf(10000.f, -(float)j / 32.f), ang = (float)t * inv; float sn, cs; sincosf(ang, &sn, &cs); rc[t * 32 + j] = cs; rs[t * 32 + j] = sn; }
            continue; }
        r -= I_RT;
        if (r < I_AX) {
            float* ac = (float*)(a.ws + WS_AXT); float* as = (float*)(a.ws + WS_AXT + 8192);
            for (int i = lane; i < 128 * 16; i += 64) { const int pos = i >> 4, j = i & 15; const float inv = powf(10000.f, -(float)j / 16.f), ang = (float)pos * inv; float sn, cs; sincosf(ang, &sn, &cs); ac[i] = cs; as[i] = sn; }
            continue; }
        r -= I_AX;
        if (r < I_IN) { const int grp = r % 144, kb = r / 144; p0_transpose_item(w_in, D, NPROJ, (bf16*)(a.ws + WS_WIN), grp * 32, kb * 64, sigma_in(grp * 32 + (lane & 31)), scr, lane); continue; }
        r -= I_IN;
        if (r < I_OUT) { const int grp = r % 64, kb = r / 64; p0_transpose_item(w_out, D, D, (bf16*)(a.ws + WS_WOUT), grp * 32, kb * 64, grp * 32 + (lane & 31), scr, lane); continue; }
        r -= I_OUT;
        if (r < I_GU) { const int grp = r % 352, kb = r / 352; const int pn = grp >> 3, gg = grp & 7;
            p0_transpose_item((gg >> 2) ? w_up : w_gate, D, DFF, (bf16*)(a.ws + WS_WGU), grp * 32, kb * 64, pn * 128 + (gg & 3) * 32 + (lane & 31), scr, lane); continue; }
        r -= I_GU;
        { const int grp = r % 64, kb = r / 64; p0_transpose_item(w_down, DFF, D, (bf16*)(a.ws + WS_WDN), grp * 32, kb * 64, grp * 32 + (lane & 31), scr, lane); }
    }
}
__device__ __forceinline__ void modulate_row(const float* xrow, const float* g, const float* shift, const float* scale, bf16* orow, int lane) {
    const GAS f32x4* xr = (const GAS f32x4*)xrow + lane;
    f32x4 v[8]; float s = 0.f;
#pragma unroll
    for (int j = 0; j < 8; ++j) { v[j] = xr[64 * j]; s += (v[j].x * v[j].x + v[j].y * v[j].y) + (v[j].z * v[j].z + v[j].w * v[j].w); }
    const float r = rsqrtf(wave_sum(s) * (1.f / D) + EPS);
    GAS unsigned long long* o8 = (GAS unsigned long long*)orow + lane;
#pragma unroll
    for (int j = 0; j < 8; ++j) { const int c = 4 * lane + 256 * j; const f32x4 gg = *(const f32x4*)(g + c), sh = *(const f32x4*)(shift + c), sc = *(const f32x4*)(scale + c);
        const f32x4 y = v[j] * r * gg * (sc + 1.f) + sh;
        o8[64 * j] = (unsigned long long)pk2(y.x, y.y) | ((unsigned long long)pk2(y.z, y.w) << 32); }
}
__device__ __forceinline__ void final_norm_row(float* xrow, const float* g, int lane) {
    GAS f32x4* xr = (GAS f32x4*)xrow + lane;
    f32x4 v[8]; float s = 0.f;
#pragma unroll
    for (int j = 0; j < 8; ++j) { v[j] = xr[64 * j]; s += (v[j].x * v[j].x + v[j].y * v[j].y) + (v[j].z * v[j].z + v[j].w * v[j].w); }
    const float r = rsqrtf(wave_sum(s) * (1.f / D) + EPS);
#pragma unroll
    for (int j = 0; j < 8; ++j) { const f32x4 gg = *(const f32x4*)(g + 4 * lane + 256 * j); xr[64 * j] = v[j] * r * gg; }
}

__global__ void __launch_bounds__(NWAVES * 64, 2) mk_fwd(Args args) {
    extern __shared__ __attribute__((aligned(16))) unsigned char lds[];
    Frame F;
    F.lds = (LAS unsigned char*)lds;
    F.MISC = (volatile LAS unsigned*)(F.lds + MISC_OFF);
    F.tid = threadIdx.x; F.lane = F.tid & 63; F.wave = __builtin_amdgcn_readfirstlane(F.tid >> 6);
    F.G = gridDim.x; { const int bx = blockIdx.x; F.vcu = (F.G % 8 == 0) ? (bx % 8) * (F.G / 8) + bx / 8 : bx; }
    unsigned char* ws = args.ws;
    F.ctl = (gu32*)(ws + WS_CTL);
    for (int u = F.tid; u < (LDS_BYTES - LDSCTL_OFF) / 4; u += NWAVES * 64) ((LAS unsigned*)(F.lds + LDSCTL_OFF))[u] = 0u;
    __syncthreads();
    XcdBarrier bar = xcd_barrier_post((unsigned*)(F.ctl + CW_BAR) + args.li * XCD_BAR_WORDS, F.MISC + 8);
    const int lo = args.ph_lo, hi = args.ph_hi;
#define IN(k) (lo <= (k) && (k) < hi)
#define BOTH(k) (IN(k) && IN((k) + 1))
    const float* mod = (const float*)(ws + WS_MODACC);
    bf16* HX = (bf16*)(ws + WS_HX); bf16* PROJ = (bf16*)(ws + WS_PROJ); bf16* Y = (bf16*)(ws + WS_Y); bf16* ACT = (bf16*)(ws + WS_ACT);
    const int gw = F.vcu * NWAVES + F.wave, NGW = F.G * NWAVES;

    if (IN(0)) { p0_prologue(F, args); if (BOTH(0)) xcd_barrier(bar); }
    if (IN(1)) {
        for (int m = gw; m < MROWS; m += NGW) {
            const float* src = m < L ? args.in[0] + (size_t)m * D : args.in[2] + (size_t)(m - L) * D; const float* mb = m < L ? mod : mod + 6 * D;
            modulate_row(src, args.in[6], mb, mb + D, HX + (size_t)m * D, F.lane); }
        if (BOTH(1)) xcd_barrier(bar);
    }
    if (IN(2)) {
        pg8::Gemm g{HX, (const bf16*)(ws + WS_WIN), MROWS, NPROJ, D}; pg8::StaticOrder S; S.init(MROWS, NPROJ, F.G, (int)blockIdx.x);
        pg8::EpiProj E{PROJ, (const float*)(ws + WS_RT), (const float*)(ws + WS_RT + MiB), (const float*)(ws + WS_AXT), (const float*)(ws + WS_AXT + 8192)};
        pg8::gemm_phase<pg8::EpiProj, pg8::StaticOrder, true, true>(F.lds + RING_OFF, g, S, E);
        if (BOTH(2)) xcd_barrier(bar);
    }
    if (IN(6)) {
        pg8::Gemm g{Y, (const bf16*)(ws + WS_WOUT), L, D, D}; pg8::StaticOrder S; S.init(L, D, F.G, (int)blockIdx.x);
        pg8::EpiResid E{args.in[0], args.out, mod + 2 * D, D};
        pg8::gemm_phase<pg8::EpiResid, pg8::StaticOrder, true, true>(F.lds + RING_OFF, g, S, E);
        if (BOTH(6)) xcd_barrier(bar);
    }
    if (IN(7)) {
        for (int m = gw; m < L; m += NGW) modulate_row(args.out + (size_t)m * D, args.in[7], mod + 3 * D, mod + 4 * D, HX + (size_t)m * D, F.lane);
        if (BOTH(7)) xcd_barrier(bar);
    }
    if (IN(8)) {
        pg8::Gemm g{HX, (const bf16*)(ws + WS_WGU), L, 2 * DFF, D}; pg8::StaticOrder S; S.init(L, 2 * DFF, F.G, (int)blockIdx.x);
        pg8::EpiSwiglu E{ACT, DFF};
        pg8::gemm_phase<pg8::EpiSwiglu, pg8::StaticOrder, true, true>(F.lds + RING_OFF, g, S, E);
        if (BOTH(8)) xcd_barrier(bar);
    }
    if (IN(9)) {
        pg8::Gemm g{ACT, (const bf16*)(ws + WS_WDN), L, D, DFF}; pg8::StaticOrder S; S.init(L, D, F.G, (int)blockIdx.x);
        pg8::EpiResid E{args.out, args.out, mod + 5 * D, D};
        pg8::gemm_phase<pg8::EpiResid, pg8::StaticOrder, true, true>(F.lds + RING_OFF, g, S, E);
        if (BOTH(9)) xcd_barrier(bar);
    }
    if (IN(10)) { for (int m = gw; m < L; m += NGW) final_norm_row(args.out + (size_t)m * D, args.in[15], F.lane); }
#undef IN
#undef BOTH
}

extern "C" void kernel_launch(void* const* d_in, const int* in_sizes, int n_in, void* d_out, int out_size, void* d_ws, size_t ws_size, hipStream_t stream) {
    static int grid = 0;
    if (grid == 0) {
        if (n_in != 16 || in_sizes[0] != L * D || out_size != L * D || ws_size < WS_END) { fprintf(stderr, "kernel_launch: unexpected shapes (n_in %d, in0 %d, out %d, ws %zu)\n", n_in, n_in > 0 ? in_sizes[0] : -1, out_size, ws_size); grid = -1; return; }
        int dev = 0, cus = 0, per_cu = 0;
        if (hipGetDevice(&dev) != hipSuccess || hipDeviceGetAttribute(&cus, hipDeviceAttributeMultiprocessorCount, dev) != hipSuccess) { grid = -1; return; }
        if (hipFuncSetAttribute((const void*)mk_fwd, hipFuncAttributeMaxDynamicSharedMemorySize, LDS_BYTES) != hipSuccess) { fprintf(stderr, "kernel_launch: hipFuncSetAttribute failed\n"); grid = -1; return; }
        if (hipOccupancyMaxActiveBlocksPerMultiprocessor(&per_cu, (const void*)mk_fwd, NWAVES * 64, LDS_BYTES) != hipSuccess || per_cu < 1) { fprintf(stderr, "kernel_launch: occupancy query says %d blocks per CU\n", per_cu); grid = -1; (void)hipGetLastError(); return; }
        (void)hipGetLastError();
        grid = cus;
    }
    if (grid < 0) return;
    const float* x = (const float*)d_in[0]; const float* ret_decay = (const float*)d_in[9]; const float* sink = (const float*)d_in[10];
    unsigned char* ws = (unsigned char*)d_ws;
    bf16* PROJ = (bf16*)(ws + WS_PROJ); bf16* Y = (bf16*)(ws + WS_Y); float* OFB = (float*)(ws + WS_OFB);
    (void)x;
    hipMemsetAsync(ws + WS_CTL, 0, CTL_BYTES, stream);
    Args a{};
    for (int i = 0; i < 16; ++i) a.in[i] = (const float*)d_in[i];
    a.out = (float*)d_out; a.ws = ws;
    a.ph_lo = 0; a.ph_hi = 3; a.li = 0;
    hipLaunchKernelGGL(mk_fwd, dim3(grid), dim3(NWAVES * 64), LDS_BYTES, stream, a);
    nv_ret_scan<<<16, 128, 0, stream>>>(PROJ, ret_decay, OFB);
    nv_ret_out<<<L * RH, 128, 0, stream>>>(OFB, PROJ, Y);
    nv_attn<<<L * AH / 64, 64, 0, stream>>>(PROJ, sink, Y);
    a.ph_lo = 6; a.ph_hi = 11; a.li = 1;
    hipLaunchKernelGGL(mk_fwd, dim3(grid), dim3(NWAVES * 64), LDS_BYTES, stream, a);
}
```

```cpp
#include <hip/hip_runtime.h>
#include <cstdio>
#include <cstdint>
#include <cmath>

typedef unsigned short bf16;
typedef unsigned u32x4 __attribute__((ext_vector_type(4)));
typedef float f32x4 __attribute__((ext_vector_type(4)));

constexpr int D = 2048, L = 8192, LC = 256, MROWS = L + LC;
constexpr int NPROJ = 4608, DFF = 5632;
constexpr int RH = 8, RDK = 64, RDV = 128, CH = 128, NCH = L / CH;
constexpr int AH = 16, AKV = 4, ADH = 64, WIN = 128;
constexpr float EPS = 1e-6f;
constexpr float LOG2E = 1.4426950408889634f;
constexpr int C_RQ = 0, C_RK = 512, C_RV = 1024, C_RG = 2048, C_AQ = 3072, C_AK = 4096, C_AV = 4352;

constexpr size_t MiB = 1u << 20;
constexpr size_t WS_CTL = 0, CTL_BYTES = 1 * MiB;
constexpr size_t WS_MOD = 1 * MiB;
constexpr size_t WS_HX = 100 * MiB;
constexpr size_t WS_PROJ = 134 * MiB;
constexpr size_t WS_Y = 209 * MiB;
constexpr size_t WS_ACT = 290 * MiB;
constexpr size_t WS_TMP = 209 * MiB;
constexpr size_t WS_OFB = 290 * MiB;
constexpr size_t WS_END = 384 * MiB;

__device__ __forceinline__ float bf2f(bf16 v) { return __uint_as_float((unsigned)v << 16); }
__device__ __forceinline__ bf16 f2bf_n(float f) { unsigned u = __float_as_uint(f); return (bf16)((u + 0x7fffu + ((u >> 16) & 1u)) >> 16); }
__device__ __forceinline__ float silu_f(float x) { return x / (1.f + __expf(-x)); }

__global__ __launch_bounds__(256) void nv_mod(const float* c, const float* cctx, const float* w_mod, const float* b_mod, float* mod) {
    __shared__ float s[2][D];
    for (int i = threadIdx.x; i < D; i += 256) { s[0][i] = silu_f(c[i]); s[1][i] = silu_f(cctx[i]); }
    __syncthreads();
    const int n = blockIdx.x * 256 + threadIdx.x;
    float a0 = 0.f, a1 = 0.f;
    for (int k = 0; k < D; ++k) { const float w = w_mod[(size_t)k * (6 * D) + n]; a0 += s[0][k] * w; a1 += s[1][k] * w; }
    mod[n] = a0 + b_mod[n]; mod[6 * D + n] = a1 + b_mod[n];
}
__global__ __launch_bounds__(256) void nv_modulate(const float* src, const float* g, const float* shift, const float* scale, bf16* out) {
    __shared__ float red[4];
    const int row = blockIdx.x; const float* x = src + (size_t)row * D;
    float v[8]; float ss = 0.f;
#pragma unroll
    for (int i = 0; i < 8; ++i) { v[i] = x[threadIdx.x + 256 * i]; ss += v[i] * v[i]; }
#pragma unroll
    for (int o = 1; o < 64; o <<= 1) ss += __shfl_xor(ss, o);
    if ((threadIdx.x & 63) == 0) red[threadIdx.x >> 6] = ss;
    __syncthreads();
    const float r = rsqrtf((red[0] + red[1] + red[2] + red[3]) * (1.f / D) + EPS);
#pragma unroll
    for (int i = 0; i < 8; ++i) { const int cidx = threadIdx.x + 256 * i; out[(size_t)row * D + cidx] = f2bf_n(v[i] * r * g[cidx] * (1.f + scale[cidx]) + shift[cidx]); }
}
template <int MODE> __global__ __launch_bounds__(256) void nv_gemm(const bf16* A, int lda, const float* B, const float* B2, int ldb, int K,
                                                                     float* Cf, bf16* Cb, int ldc, const float* R, const float* gate) {
    __shared__ float As[16][132]; __shared__ float Bs[16][64]; __shared__ float Bs2[16][64];
    const int tid = threadIdx.x, tx = tid & 15, ty = tid >> 4;
    const int m0 = blockIdx.y * 128, n0 = blockIdx.x * 64;
    float acc[8][4], acc2[8][4];
#pragma unroll
    for (int i = 0; i < 8; ++i)
#pragma unroll
        for (int j = 0; j < 4; ++j) { acc[i][j] = 0.f; acc2[i][j] = 0.f; }
    const int arow = tid >> 1, akh = (tid & 1) * 8, bk = tid >> 4, bn4 = (tid & 15) * 4;
    for (int k0 = 0; k0 < K; k0 += 16) {
        const u32x4 av = *(const u32x4*)(A + (size_t)(m0 + arow) * lda + k0 + akh);
        const f32x4 bv = *(const f32x4*)(B + (size_t)(k0 + bk) * ldb + n0 + bn4);
        f32x4 bv2 = bv; if (MODE == 1) bv2 = *(const f32x4*)(B2 + (size_t)(k0 + bk) * ldb + n0 + bn4);
#pragma unroll
        for (int i = 0; i < 4; ++i) { As[akh + 2 * i][arow] = __uint_as_float(av[i] << 16); As[akh + 2 * i + 1][arow] = __uint_as_float(av[i] & 0xffff0000u); }
        *(f32x4*)&Bs[bk][bn4] = bv; if (MODE == 1) *(f32x4*)&Bs2[bk][bn4] = bv2;
        __syncthreads();
#pragma unroll
        for (int k = 0; k < 16; ++k) {
            float a[8], b[4], b2[4];
#pragma unroll
            for (int i = 0; i < 8; ++i) a[i] = As[k][ty * 8 + i];
#pragma unroll
            for (int j = 0; j < 4; ++j) { b[j] = Bs[k][tx * 4 + j]; b2[j] = (MODE == 1) ? Bs2[k][tx * 4 + j] : 0.f; }
#pragma unroll
            for (int i = 0; i < 8; ++i)
#pragma unroll
                for (int j = 0; j < 4; ++j) { acc[i][j] += a[i] * b[j]; if (MODE == 1) acc2[i][j] += a[i] * b2[j]; }
        }
        __syncthreads();
    }
#pragma unroll
    for (int i = 0; i < 8; ++i)
#pragma unroll
        for (int j = 0; j < 4; ++j) {
            const size_t r = m0 + ty * 8 + i; const int cidx = n0 + tx * 4 + j;
            if (MODE == 0) Cf[r * ldc + cidx] = acc[i][j];
            if (MODE == 1) Cb[r * ldc + cidx] = f2bf_n(silu_f(acc[i][j]) * acc2[i][j]);
            if (MODE == 2) Cf[r * ldc + cidx] = R[r * ldc + cidx] + gate[cidx] * acc[i][j];
        }
}
__global__ __launch_bounds__(256) void nv_proj_epi(const float* tmp, bf16* proj) {
    const size_t idx = (size_t)blockIdx.x * 256 + threadIdx.x;
    const int row = (int)(idx / NPROJ), col = (int)(idx % NPROJ);
    const bool isctx = row >= L; const int t = row;
    const float* tr = tmp + (size_t)row * NPROJ;
    const float v = tr[col]; float o = v;
    if (col < C_RV) {
        if (!isctx) {
            const int d = col & 63, j = d & 31;
            const float inv = powf(10000.f, -(float)j / 32.f), ang = (float)t * inv; float sn, cs; sincosf(ang, &sn, &cs);
            if (d < 32) o = v * cs - tr[col + 32] * sn; else o = tr[col - 32] * sn + v * cs;
        }
        if (col >= C_RK) o *= 0.125f;
    } else if (col < C_RG) {
    } else if (col < C_AQ) { o = silu_f(v);
    } else if (col < C_AV) {
        if (!isctx) {
            const int d = (col - C_AQ) & 63, hf = d >> 5, dd = d & 31, j = dd & 15;
            const int pos = hf == 0 ? (t >> 6) : (t & 63);
            const float inv = powf(10000.f, -(float)j / 16.f), ang = (float)pos * inv; float sn, cs; sincosf(ang, &sn, &cs);
            if (dd < 16) o = v * cs - tr[col + 16] * sn; else o = tr[col - 16] * sn + v * cs;
        }
        if (col < C_AK) o *= 0.125f * LOG2E;
    }
    proj[idx] = f2bf_n(o);
}
__global__ __launch_bounds__(128) void nv_ret_scan(const bf16* proj, const float* ret_decay, float* ofb) {
    const int h = blockIdx.x & 7, dir = blockIdx.x >> 3, v = threadIdx.x;
    const float gam = __expf(-__expf(ret_decay[dir * RH + h]));
    float S[64];
#pragma unroll
    for (int d = 0; d < 64; ++d) S[d] = 0.f;
    float* out = ofb + (size_t)dir * L * 1024 + h * 128 + v;
    for (int step = 0; step < LC + L; ++step) {
        int row; bool lat;
        if (dir == 0) { lat = step >= LC; row = lat ? step - LC : L + step; }
        else { lat = step >= LC; row = lat ? (L - 1 - (step - LC)) : (L + LC - 1 - step); }
        const bf16* pr = proj + (size_t)row * NPROJ;
        const float vv = bf2f(pr[C_RV + h * 128 + v]);
        float kf[64], qf[64];
#pragma unroll
        for (int i = 0; i < 8; ++i) { const u32x4 kk = *(const u32x4*)(pr + C_RK + h * 64 + i * 8); const u32x4 qq = *(const u32x4*)(pr + C_RQ + h * 64 + i * 8);
#pragma unroll
            for (int e = 0; e < 4; ++e) { kf[i * 8 + 2 * e] = __uint_as_float(kk[e] << 16); kf[i * 8 + 2 * e + 1] = __uint_as_float(kk[e] & 0xffff0000u);
                                          qf[i * 8 + 2 * e] = __uint_as_float(qq[e] << 16); qf[i * 8 + 2 * e + 1] = __uint_as_float(qq[e] & 0xffff0000u); } }
        if (dir == 0) {
            float o = 0.f;
#pragma unroll
            for (int d = 0; d < 64; ++d) { S[d] = gam * S[d] + kf[d] * vv; o += qf[d] * S[d]; }
            if (lat) out[(size_t)row * 1024] = o;
        } else {
            float o = 0.f;
#pragma unroll
            for (int d = 0; d < 64; ++d) { o += qf[d] * S[d]; S[d] = gam * S[d] + kf[d] * vv; }
            if (lat) out[(size_t)row * 1024] = gam * o;
        }
    }
}
__global__ __launch_bounds__(128) void nv_ret_out(const float* ofb, const bf16* proj, bf16* Y) {
    __shared__ float red[2];
    const int t = blockIdx.x >> 3, h = blockIdx.x & 7, v = threadIdx.x;
    const size_t i = (size_t)t * 1024 + h * 128 + v;
    const float o = ofb[i] + ofb[(size_t)L * 1024 + i];
    float ss = o * o;
#pragma unroll
    for (int k = 1; k < 64; k <<= 1) ss += __shfl_xor(ss, k);
    if ((v & 63) == 0) red[v >> 6] = ss;
    __syncthreads();
    const float r = rsqrtf((red[0] + red[1]) * (1.f / 128.f) + EPS);
    Y[(size_t)t * D + h * 128 + v] = f2bf_n(o * r * bf2f(proj[(size_t)t * NPROJ + C_RG + h * 128 + v]));
}
__global__ __launch_bounds__(64) void nv_attn(const bf16* proj, const float* sink, bf16* Y) {
    const int idx = blockIdx.x * 64 + threadIdx.x; const int hq = idx / L, t = idx % L, kvh = hq >> 2;
    float q[64], acc[64];
    const bf16* qp = proj + (size_t)t * NPROJ + C_AQ + hq * 64;
#pragma unroll
    for (int d = 0; d < 64; ++d) { q[d] = bf2f(qp[d]); acc[d] = 0.f; }
    float m = sink[hq] * LOG2E, l = 1.f;
    const int lo = t - WIN < 0 ? 0 : t - WIN, hi = t + WIN > L - 1 ? L - 1 : t + WIN;
    const int nloc = hi - lo + 1;
    for (int s = 0; s < nloc + LC; ++s) {
        const int row = s < nloc ? lo + s : L + (s - nloc);
        const bf16* kp = proj + (size_t)row * NPROJ + C_AK + kvh * 64; const bf16* vp = proj + (size_t)row * NPROJ + C_AV + kvh * 64;
        float sc = 0.f;
#pragma unroll
        for (int d = 0; d < 64; ++d) sc += q[d] * bf2f(kp[d]);
        float p;
        if (sc > m) { const float f = exp2f(m - sc); l *= f;
#pragma unroll
            for (int d = 0; d < 64; ++d) acc[d] *= f;
            m = sc; p = 1.f; }
        else p = exp2f(sc - m);
        l += p;
#pragma unroll
        for (int d = 0; d < 64; ++d) acc[d] += p * bf2f(vp[d]);
    }
    const float rl = 1.f / l;
    bf16* yp = Y + (size_t)t * D + 1024 + hq * 64;
#pragma unroll
    for (int d = 0; d < 64; ++d) yp[d] = f2bf_n(acc[d] * rl);
}
__global__ __launch_bounds__(256) void nv_final_norm(float* xio, const float* g) {
    __shared__ float red[4];
    float* x = xio + (size_t)blockIdx.x * D;
    float v[8]; float ss = 0.f;
#pragma unroll
    for (int i = 0; i < 8; ++i) { v[i] = x[threadIdx.x + 256 * i]; ss += v[i] * v[i]; }
#pragma unroll
    for (int o = 1; o < 64; o <<= 1) ss += __shfl_xor(ss, o);
    if ((threadIdx.x & 63) == 0) red[threadIdx.x >> 6] = ss;
    __syncthreads();
    const float r = rsqrtf((red[0] + red[1] + red[2] + red[3]) * (1.f / D) + EPS);
#pragma unroll
    for (int i = 0; i < 8; ++i) { const int c = threadIdx.x + 256 * i; x[c] = v[i] * r * g[c]; }
}

namespace pg8 {
#define PG8_LAS __attribute__((address_space(3)))
typedef unsigned short bf16_t;
typedef short bf16x8 __attribute__((ext_vector_type(8)));
typedef float f32x4 __attribute__((ext_vector_type(4)));
typedef unsigned u32x4 __attribute__((ext_vector_type(4)));
constexpr int BM = 256, BK = 64, HALF = 128, HTB = HALF * BK * 2  , STAGE_BYTES = 8 * HTB, NXCD = 8, WGM = 8;

__host__ __device__ __forceinline__ int lds_byte(int r, int c) { const int st = (r >> 4) * 2 + (c >> 5), rr = r & 15, cc = c & 31, ob = rr * 64 + cc * 2; return st * 1024 + (ob ^ (((ob >> 9) & 1) << 5)); }
__host__ __device__ __forceinline__ void stage_rc(int b, int& R, int& C) { const int st = b / 1024, sb = b % 1024, swz = sb ^ (((sb >> 9) & 1) << 5); R = (st >> 1) * 16 + swz / 64; C = (st & 1) * 32 + (swz % 64) / 2; }
__host__ __device__ __forceinline__ int perm32(int rho) { const int n = rho >> 4, i = rho & 15; return 8 * (i >> 2) + 4 * n + (i & 3); }

struct Unit { int pm, pn; };
struct Gemm { const bf16_t* A; const bf16_t* Bt; int M, N, K; };

struct StaticOrder {
    int nM, nN, nwg, G, c;
    __host__ __device__ void init(int M, int N, int G_, int c_) { nM = M / BM; nN = N / BM; nwg = nM * nN; G = G_; c = c_; }
    __host__ __device__ bool next(int i, Unit& u) const {
        const long L = (long)i * G + c; if (L >= nwg) return false;
        int wgid = (int)L; { const int q = nwg / NXCD, r = nwg % NXCD, xcd = wgid % NXCD, off = wgid / NXCD; wgid = (xcd < r ? xcd * (q + 1) : r * (q + 1) + (xcd - r) * q) + off; }
        const int nig = WGM * nN, gid = wgid / nig, fm = gid * WGM, gsz = (nM - fm) < WGM ? (nM - fm) : WGM;
        u.pm = fm + ((wgid % nig) % gsz); u.pn = (wgid % nig) / gsz; return true;
    }
    __device__ __forceinline__ void a_ready(const Unit&) const {}
    __device__ __forceinline__ void done(const Unit&) const {}
};
__device__ __forceinline__ unsigned cvt_pk_bf16(float lo, float hi) { unsigned r; asm volatile("v_cvt_pk_bf16_f32 %0, %1, %2" : "=v"(r) : "v"(lo), "v"(hi)); return r; }
typedef float f32x2 __attribute__((ext_vector_type(2)));
template <class Epi, class Sched, bool ALIGN_EPI = false, bool SP2 = false>
__device__ __forceinline__ void gemm_phase(PG8_LAS unsigned char* lds, const Gemm g, const Sched& S, const Epi& E) {
    const int tid = threadIdx.x, wid = __builtin_amdgcn_readfirstlane(tid >> 6), lane = tid & 63, wr = wid >> 2, wc = wid & 3, fr = lane & 15, fq = lane >> 4;
    const int K = g.K, nt = K / BK;
    unsigned voffA[2], voffB[2];
#pragma unroll
    for (int i = 0; i < 2; ++i) { int R, C; stage_rc(tid * 16 + i * 8192, R, C); const int Rb = Epi::PERM ? ((R & ~31) + perm32(R & 31)) : R;
        voffA[i] = (unsigned)(R * K + C) * 2u; voffB[i] = (unsigned)(Rb * K + C) * 2u; }
    const size_t kstep = (size_t)(BK * 2);
    const size_t hstep = (size_t)HALF * K * 2;
    const size_t tstep = 2 * hstep;
    const unsigned ldsw = (unsigned)wid * 1024u;
    const int aoff = lds_byte(wr * 64 + fr, fq * 8), boff = lds_byte(wc * 32 + fr, fq * 8);
#define PG8_SA(b, h) (((b) * 2 + (h)) * HTB)
#define PG8_SB(b, h) ((4 + (b) * 2 + (h)) * HTB)
#define PG8_STAGE(bufoff, gbase, voff) do { _Pragma("unroll") for (int _i = 0; _i < 2; ++_i) \
        __builtin_amdgcn_global_load_lds((const unsigned*)((const char*)(gbase) + (voff)[_i]), (PG8_LAS unsigned*)(lds + (bufoff) + ldsw + _i * 8192), 16, 0, 0); } while (0)
#define PG8_LDA(dst, b, h) do { _Pragma("unroll") for (int m = 0; m < 4; ++m) _Pragma("unroll") for (int k = 0; k < 2; ++k) dst[m][k] = *(const PG8_LAS bf16x8*)(lds + PG8_SA(b, h) + aoff + m * 2048 + k * 1024); } while (0)
#define PG8_LDB(dst, b, h) do { _Pragma("unroll") for (int n = 0; n < 2; ++n) _Pragma("unroll") for (int k = 0; k < 2; ++k) dst[n][k] = *(const PG8_LAS bf16x8*)(lds + PG8_SB(b, h) + boff + n * 2048 + k * 1024); } while (0)
#define PG8_MMA(ai, bj, At, Bt) do { __builtin_amdgcn_s_setprio(1); _Pragma("unroll") for (int m = 0; m < 4; ++m) _Pragma("unroll") for (int n = 0; n < 2; ++n) _Pragma("unroll") for (int k = 0; k < 2; ++k) \
        acc[ai][bj][m][n] = __builtin_amdgcn_mfma_f32_16x16x32_bf16(Bt[n][k], At[m][k], acc[ai][bj][m][n], 0, 0, 0); __builtin_amdgcn_s_setprio(0); } while (0)
#define PG8_WAIT_V(n) asm volatile("s_waitcnt vmcnt(" #n ")" ::: "memory")
#define PG8_WAIT_L(n) asm volatile("s_waitcnt lgkmcnt(" #n ")" ::: "memory")
#define PG8_BAR __builtin_amdgcn_s_barrier()
#define PG8_SCHED __builtin_amdgcn_sched_barrier(0)
    Unit cur, nxt; int ui = 0;
    if (!S.next(0, cur)) return;
    f32x4 acc[2][2][4][2];
#pragma unroll
    for (int a = 0; a < 2; ++a)
#pragma unroll
        for (int b = 0; b < 2; ++b)
#pragma unroll
            for (int m = 0; m < 4; ++m)
#pragma unroll
                for (int n = 0; n < 2; ++n) acc[a][b][m][n] = (f32x4){0.f, 0.f, 0.f, 0.f};
    bf16x8 At[4][2], B0[2][2], B1[2][2];
    const char* cA = (const char*)g.A + (size_t)cur.pm * tstep; const char* cB = (const char*)g.Bt + (size_t)cur.pn * tstep;
    S.a_ready(cur);
    if constexpr (SP2) {
        PG8_STAGE(PG8_SB(0, 0), cB, voffB); PG8_STAGE(PG8_SB(0, 1), cB + hstep, voffB); PG8_STAGE(PG8_SA(0, 0), cA, voffA); PG8_STAGE(PG8_SA(0, 1), cA + hstep, voffA);
        if (wr == 1) PG8_BAR;
        PG8_WAIT_V(2); PG8_BAR;
        PG8_STAGE(PG8_SB(1, 0), cB + kstep, voffB); PG8_STAGE(PG8_SA(1, 0), cA + kstep, voffA); PG8_STAGE(PG8_SB(1, 1), cB + hstep + kstep, voffB);
        PG8_WAIT_V(6); PG8_BAR;
    } else {
        PG8_STAGE(PG8_SB(0, 0), cB, voffB); PG8_STAGE(PG8_SA(0, 0), cA, voffA); PG8_STAGE(PG8_SB(0, 1), cB + hstep, voffB); PG8_STAGE(PG8_SA(0, 1), cA + hstep, voffA);
        if (wr == 1) PG8_BAR;
        PG8_WAIT_V(4); PG8_BAR;
        PG8_STAGE(PG8_SB(1, 0), cB + kstep, voffB); PG8_STAGE(PG8_SA(1, 0), cA + kstep, voffA); PG8_STAGE(PG8_SB(1, 1), cB + hstep + kstep, voffB);
        PG8_WAIT_V(6); PG8_BAR;
    }
    for (;;) {
        const bool has_next = S.next(ui + 1, nxt);
        const char* nA = has_next ? (const char*)g.A + (size_t)nxt.pm * tstep : cA; const char* nB = has_next ? (const char*)g.Bt + (size_t)nxt.pn * tstep : cB;
        for (int t = 0; t < nt; t += 2) {
            const bool last = (t == nt - 2);
            const char* a1 = cA + (size_t)(t + 1) * kstep;
            const char* a2 = last ? nA : cA + (size_t)(t + 2) * kstep; const char* b2 = last ? nB : cB + (size_t)(t + 2) * kstep;
            const char* a3 = a2 + kstep; const char* b3 = b2 + kstep;
            if (last && has_next) S.a_ready(nxt);
            if constexpr (SP2) {
            PG8_LDB(B0, 0, 0); PG8_LDB(B1, 0, 1); PG8_SCHED; PG8_LDA(At, 0, 0); PG8_STAGE(PG8_SA(1, 1), a1 + hstep, voffA);
            PG8_WAIT_V(8); PG8_WAIT_L(0); PG8_BAR; PG8_MMA(0, 0, At, B0); PG8_MMA(0, 1, At, B1); PG8_BAR; PG8_SCHED;
            PG8_LDA(At, 0, 1); PG8_STAGE(PG8_SB(0, 0), b2, voffB); PG8_STAGE(PG8_SB(0, 1), b2 + hstep, voffB); PG8_STAGE(PG8_SA(0, 0), a2, voffA);
            PG8_WAIT_V(8); PG8_WAIT_L(0); PG8_BAR; PG8_MMA(1, 0, At, B0); PG8_MMA(1, 1, At, B1); PG8_BAR; PG8_SCHED;
            PG8_LDB(B0, 1, 0); PG8_LDB(B1, 1, 1); PG8_SCHED; PG8_LDA(At, 1, 0); PG8_STAGE(PG8_SA(0, 1), a2 + hstep, voffA);
            PG8_WAIT_V(8); PG8_WAIT_L(0); PG8_BAR; PG8_MMA(0, 0, At, B0); PG8_MMA(0, 1, At, B1); PG8_BAR; PG8_SCHED;
            PG8_LDA(At, 1, 1); PG8_STAGE(PG8_SB(1, 0), b3, voffB); PG8_STAGE(PG8_SB(1, 1), b3 + hstep, voffB); PG8_STAGE(PG8_SA(1, 0), a3, voffA);
            PG8_WAIT_V(8); PG8_WAIT_L(0); PG8_BAR; PG8_MMA(1, 0, At, B0); PG8_MMA(1, 1, At, B1); PG8_BAR; PG8_SCHED;
            } else {
            PG8_LDB(B0, 0, 0); PG8_SCHED; PG8_LDA(At, 0, 0); PG8_STAGE(PG8_SA(1, 1), a1 + hstep, voffA);
            PG8_WAIT_L(8); PG8_BAR; PG8_WAIT_L(0); PG8_MMA(0, 0, At, B0); PG8_BAR; PG8_SCHED;
            PG8_LDB(B1, 0, 1); PG8_STAGE(PG8_SB(0, 0), b2, voffB);
            PG8_BAR; PG8_WAIT_L(0); PG8_MMA(0, 1, At, B1); PG8_BAR;
            PG8_LDA(At, 0, 1); PG8_STAGE(PG8_SA(0, 0), a2, voffA);
            PG8_BAR; PG8_WAIT_L(0); PG8_MMA(1, 0, At, B0); PG8_BAR; PG8_SCHED;
            PG8_STAGE(PG8_SB(0, 1), b2 + hstep, voffB);
            PG8_WAIT_V(6); PG8_BAR; PG8_MMA(1, 1, At, B1); PG8_BAR;
            PG8_LDB(B0, 1, 0); PG8_SCHED; PG8_LDA(At, 1, 0); PG8_STAGE(PG8_SA(0, 1), a2 + hstep, voffA);
            PG8_WAIT_L(8); PG8_BAR; PG8_WAIT_L(0); PG8_MMA(0, 0, At, B0); PG8_BAR; PG8_SCHED;
            PG8_LDB(B1, 1, 1); PG8_STAGE(PG8_SB(1, 0), b3, voffB);
            PG8_BAR; PG8_WAIT_L(0); PG8_MMA(0, 1, At, B1); PG8_BAR;
            PG8_LDA(At, 1, 1); PG8_STAGE(PG8_SA(1, 0), a3, voffA);
            PG8_BAR; PG8_WAIT_L(0); PG8_MMA(1, 0, At, B0); PG8_BAR; PG8_SCHED;
            PG8_STAGE(PG8_SB(1, 1), b3 + hstep, voffB);
            PG8_WAIT_V(6); PG8_BAR; PG8_MMA(1, 1, At, B1); PG8_BAR;
            }
        }
        if constexpr (ALIGN_EPI) { if (wr == 0) PG8_BAR; }
        if constexpr (!Epi::AFTER_DRAIN) { E(acc, cur, wr, wc, fr, fq); S.done(cur); }
        if (!has_next) break;
#pragma unroll
        for (int a = 0; a < 2; ++a)
#pragma unroll
            for (int b = 0; b < 2; ++b)
#pragma unroll
                for (int m = 0; m < 4; ++m)
#pragma unroll
                    for (int n = 0; n < 2; ++n) acc[a][b][m][n] = (f32x4){0.f, 0.f, 0.f, 0.f};
        cur = nxt; cA = nA; cB = nB; ++ui;
        if constexpr (ALIGN_EPI) { if (wr == 1) PG8_BAR; }
    }
    PG8_WAIT_V(0);
    if constexpr (!ALIGN_EPI) { if (wr == 0) PG8_BAR; }
    PG8_BAR;
    if constexpr (Epi::AFTER_DRAIN) { E.fused(acc, cur, wr, wc, fr, fq, lds, wid, lane); S.done(cur); }
#undef PG8_SA
#undef PG8_SB
#undef PG8_STAGE
#undef PG8_LDA
#undef PG8_LDB
#undef PG8_MMA
#undef PG8_WAIT_V
#undef PG8_WAIT_L
#undef PG8_BAR
#undef PG8_SCHED
}
}
namespace pg8 {
__device__ __forceinline__ float silu_fast(float x) { return x * __builtin_amdgcn_rcpf(1.f + __expf(-x)); }
struct EpiProj {
    static constexpr bool PERM = true, AFTER_DRAIN = false;
    bf16_t* P; const float* rtc; const float* rts; const float* axc; const float* axs;
    __device__ __forceinline__ void operator()(const f32x4 (&acc)[2][2][4][2], const Unit& u, int wr, int wc, int fr, int fq) const {
        const int pn = u.pn; const bool isctx = (u.pm == 32);
        const int row0 = u.pm * BM + wr * 64 + fr;
        int type = 0; float sc = 1.f;
        if (pn < 4) { type = 2; if (pn >= 2) sc = 0.125f; }
        else if (pn < 8) type = 0;
        else if (pn < 12) type = 1;
        else if (pn < 17) { type = 3; if (pn < 16) sc = 0.125f * 1.4426950408889634f; }
        if (type < 2) {
#pragma unroll
            for (int ai = 0; ai < 2; ++ai)
#pragma unroll
                for (int m = 0; m < 4; ++m) { bf16_t* rowp = P + (size_t)(row0 + ai * HALF + m * 16) * 4608 + pn * BM + wc * 32 + 8 * fq;
#pragma unroll
                    for (int bj = 0; bj < 2; ++bj) { f32x4 v0 = acc[ai][bj][m][0], v1 = acc[ai][bj][m][1];
                        if (type == 1) {
#pragma unroll
                            for (int e = 0; e < 4; ++e) { v0[e] = silu_fast(v0[e]); v1[e] = silu_fast(v1[e]); } }
                        u32x4 w; w.x = cvt_pk_bf16(v0[0], v0[1]); w.y = cvt_pk_bf16(v0[2], v0[3]); w.z = cvt_pk_bf16(v1[0], v1[1]); w.w = cvt_pk_bf16(v1[2], v1[3]);
                        *(u32x4*)(rowp + bj * HALF) = w; } }
        } else {
            const int hf = fq >> 1;
#pragma unroll
            for (int ai = 0; ai < 2; ++ai)
#pragma unroll
                for (int m = 0; m < 4; ++m) { const int r = row0 + ai * HALF + m * 16;
                    f32x4 cs[2], sn[2];
                    if (isctx) { cs[0] = cs[1] = (f32x4){1.f, 1.f, 1.f, 1.f}; sn[0] = sn[1] = (f32x4){0.f, 0.f, 0.f, 0.f}; }
                    else if (type == 2) { const size_t o = (size_t)r * 32 + 8 * fq; cs[0] = *(const f32x4*)(rtc + o); cs[1] = *(const f32x4*)(rtc + o + 4); sn[0] = *(const f32x4*)(rts + o); sn[1] = *(const f32x4*)(rts + o + 4); }
                    else { const int pos = hf ? (r & 63) : (r >> 6); const int o = pos * 16 + 8 * (fq & 1); cs[0] = *(const f32x4*)(axc + o); cs[1] = *(const f32x4*)(axc + o + 4); sn[0] = *(const f32x4*)(axs + o); sn[1] = *(const f32x4*)(axs + o + 4); }
                    f32x4 o1[2], o2[2];
#pragma unroll
                    for (int n = 0; n < 2; ++n) { const f32x4 x1 = acc[ai][0][m][n], x2 = acc[ai][1][m][n]; o1[n] = (x1 * cs[n] - x2 * sn[n]) * sc; o2[n] = (x1 * sn[n] + x2 * cs[n]) * sc; }
                    u32x4 w1, w2; w1.x = cvt_pk_bf16(o1[0][0], o1[0][1]); w1.y = cvt_pk_bf16(o1[0][2], o1[0][3]); w1.z = cvt_pk_bf16(o1[1][0], o1[1][1]); w1.w = cvt_pk_bf16(o1[1][2], o1[1][3]);
                    w2.x = cvt_pk_bf16(o2[0][0], o2[0][1]); w2.y = cvt_pk_bf16(o2[0][2], o2[0][3]); w2.z = cvt_pk_bf16(o2[1][0], o2[1][1]); w2.w = cvt_pk_bf16(o2[1][2], o2[1][3]);
                    bf16_t* rowp = P + (size_t)r * 4608 + pn * BM + wc * 64;
                    if (type == 2) { *(u32x4*)(rowp + 8 * fq) = w1; *(u32x4*)(rowp + 32 + 8 * fq) = w2; }
                    else { *(u32x4*)(rowp + 32 * hf + 8 * (fq & 1)) = w1; *(u32x4*)(rowp + 32 * hf + 16 + 8 * (fq & 1)) = w2; } }
        }
    }
};
struct EpiResid {
    static constexpr bool PERM = false, AFTER_DRAIN = false;
    const float* R; float* out; const float* gate; int ldc;
    __device__ __forceinline__ void operator()(const f32x4 (&acc)[2][2][4][2], const Unit& u, int wr, int wc, int fr, int fq) const {
        const int row0 = u.pm * BM + wr * 64 + fr, col0 = u.pn * BM + wc * 32 + 4 * fq;
        f32x4 gv[2][2];
#pragma unroll
        for (int bj = 0; bj < 2; ++bj)
#pragma unroll
            for (int n = 0; n < 2; ++n) gv[bj][n] = *(const f32x4*)(gate + col0 + bj * HALF + n * 16);
#pragma unroll
        for (int ai = 0; ai < 2; ++ai)
#pragma unroll
            for (int m = 0; m < 4; ++m) { const size_t off = (size_t)(row0 + ai * HALF + m * 16) * ldc + col0;
#pragma unroll
                for (int bj = 0; bj < 2; ++bj)
#pragma unroll
                    for (int n = 0; n < 2; ++n) { const f32x4 rs = *(const f32x4*)(R + off + bj * HALF + n * 16); *(f32x4*)(out + off + bj * HALF + n * 16) = rs + gv[bj][n] * acc[ai][bj][m][n]; } }
    }
};
struct EpiSwiglu {
    static constexpr bool PERM = true, AFTER_DRAIN = false;
    bf16_t* O; int ldc;
    __device__ __forceinline__ void operator()(const f32x4 (&acc)[2][2][4][2], const Unit& u, int wr, int wc, int fr, int fq) const {
        const int row0 = u.pm * BM + wr * 64 + fr, col0 = u.pn * HALF + wc * 32 + 8 * fq;
#pragma unroll
        for (int ai = 0; ai < 2; ++ai)
#pragma unroll
            for (int m = 0; m < 4; ++m) { f32x4 v[2];
#pragma unroll
                for (int n = 0; n < 2; ++n) { const f32x4 g = acc[ai][0][m][n], up = acc[ai][1][m][n];
#pragma unroll
                    for (int e = 0; e < 4; ++e) v[n][e] = silu_fast(g[e]) * up[e]; }
                u32x4 w; w.x = cvt_pk_bf16(v[0][0], v[0][1]); w.y = cvt_pk_bf16(v[0][2], v[0][3]); w.z = cvt_pk_bf16(v[1][0], v[1][1]); w.w = cvt_pk_bf16(v[1][2], v[1][3]);
                *(u32x4*)(O + (size_t)(row0 + ai * HALF + m * 16) * ldc + col0) = w; }
    }
};
}
#define GAS __attribute__((address_space(1)))
#define LAS __attribute__((address_space(3)))
typedef unsigned short bf16;
typedef unsigned v4u __attribute__((ext_vector_type(4)));
typedef float f32x4 __attribute__((ext_vector_type(4)));
typedef short bf16x8 __attribute__((ext_vector_type(8)));
typedef GAS unsigned gu32;
typedef GAS unsigned long long gu64;
#define RLX_AGENT __ATOMIC_RELAXED, __HIP_MEMORY_SCOPE_AGENT
#define LDS_WAIT() asm volatile("s_waitcnt lgkmcnt(0)" ::: "memory")
#define VM_WAIT() asm volatile("s_waitcnt vmcnt(0)" ::: "memory")
__device__ __forceinline__ unsigned long long rt() { return __builtin_amdgcn_s_memrealtime(); }
__device__ __forceinline__ unsigned f2bf(float f) { unsigned u = __builtin_bit_cast(unsigned, f); return (u + 0x7fffu + ((u >> 16) & 1u)) >> 16; }
__device__ __forceinline__ unsigned pk2(float lo, float hi) { return f2bf(lo) | (f2bf(hi) << 16); }
#define XB_TMO      128
#define XB_XCNT(j)  (256  + 64 * (j))
#define XB_XSUB(j)  (1280 + 64 * (j))
#define XB_XGEN(j)  (2304 + 64 * (j))
#define XB_TOP      3328
#define XB_TOPGEN   3392
#define XCD_BAR_WORDS 3456
#define XB_SPIN_CAP (1u << 18)

__device__ __forceinline__ unsigned xb_ld(unsigned* p)              { return __hip_atomic_load(p, __ATOMIC_RELAXED, __HIP_MEMORY_SCOPE_AGENT); }
__device__ __forceinline__ unsigned xb_add(unsigned* p, unsigned v) { return __hip_atomic_fetch_add(p, v, __ATOMIC_RELAXED, __HIP_MEMORY_SCOPE_AGENT); }
__device__ __forceinline__ unsigned xb_xcc_id() { return (unsigned)__builtin_amdgcn_s_getreg((3 << 11) | 20) & 0xFu; }
#define XB_SPIN(cond, bar) do { unsigned _sp = 0; while (cond) { __builtin_amdgcn_s_sleep(1); \
    if ((++_sp & 255u) == 0u) { if (xb_ld(&(bar)[XB_TMO])) break; if (_sp > XB_SPIN_CAP) { atomicAdd(&(bar)[XB_TMO], 1u); break; } } } } while (0)

struct XcdBarrier {
    unsigned* bar; unsigned x;
    volatile LAS unsigned* st;
};

__device__ __forceinline__ XcdBarrier xcd_barrier_post(unsigned* bar, volatile LAS unsigned* st) {
    XcdBarrier b; b.bar = bar; b.x = xb_xcc_id(); b.st = st;
    if (threadIdx.x == 0) (void)xb_add(&bar[XB_XCNT(b.x)], 1u);
    return b;
}
__device__ __forceinline__ void xcd_barrier_complete(unsigned* bar, unsigned x, unsigned& nloc, unsigned& nx) {
    const unsigned G = gridDim.x * gridDim.y * gridDim.z;
    unsigned sum, cnt, mine, sp = 0u;
    for (;;) {
        sum = 0u; cnt = 0u; mine = 0u;
#pragma unroll
        for (unsigned j = 0; j < 16; ++j) { const unsigned c = xb_ld(&bar[XB_XCNT(j)]); sum += c; cnt += (c > 0u) ? 1u : 0u; mine = (j == x) ? c : mine; }
        if (sum == G) break;
        __builtin_amdgcn_s_sleep(1);
        if ((++sp & 255u) == 0u) { if (xb_ld(&bar[XB_TMO])) break; if (sp > XB_SPIN_CAP) { atomicAdd(&bar[XB_TMO], 1u); break; } }
    }
    nloc = mine > 0u ? mine : 1u; nx = cnt > 0u ? cnt : 1u;
}

__device__ __forceinline__ void xcd_barrier(const XcdBarrier& b) {
    asm volatile("s_waitcnt vmcnt(0)" ::: "memory");
    __syncthreads();
    if (threadIdx.x == 0) {
        unsigned* bar = b.bar;
        __builtin_amdgcn_s_waitcnt(0);
        unsigned nloc = b.st[0], nx = b.st[1];
        if (nloc == 0u) { xcd_barrier_complete(bar, b.x, nloc, nx); b.st[0] = nloc; b.st[1] = nx; }
        const unsigned old = xb_add(&bar[XB_XSUB(b.x)], 1u);
        const unsigned gen = old / nloc;
        if (old + 1u == (gen + 1u) * nloc) {
            __builtin_amdgcn_fence(__ATOMIC_RELEASE, "agent");
            asm volatile("s_waitcnt vmcnt(0)" ::: "memory");
            const unsigned og = xb_add(&bar[XB_TOP], 1u);
            const unsigned tg = og / nx;
            if (og + 1u == (tg + 1u) * nx) xb_add(&bar[XB_TOPGEN], 1u);
            else XB_SPIN(xb_ld(&bar[XB_TOPGEN]) == tg, bar);
            __builtin_amdgcn_fence(__ATOMIC_ACQUIRE, "agent");
            xb_add(&bar[XB_XGEN(b.x)], 1u);
            asm volatile("s_waitcnt vmcnt(0)" ::: "memory");
        } else {
            XB_SPIN(xb_ld(&bar[XB_XGEN(b.x)]) == gen, bar);
            __builtin_amdgcn_fence(__ATOMIC_ACQUIRE, "agent");
            asm volatile("s_waitcnt vmcnt(0)" ::: "memory");
        }
    }
    __syncthreads();
}
constexpr int NWAVES = 8;
constexpr int RING_OFF = 0, RING_BYTES = 131072;
constexpr int LDSCTL_OFF = RING_BYTES, MISC_OFF = LDSCTL_OFF + 320;
constexpr int LDS_BYTES = 147456;
constexpr size_t WS_MODACC = 512 * 1024;
constexpr size_t WS_RT = 2 * MiB;
constexpr size_t WS_AXT = 4 * MiB;
constexpr size_t WS_WIN = 8 * MiB, WS_WOUT = 26 * MiB, WS_WGU = 34 * MiB, WS_WDN = 78 * MiB;
constexpr size_t WS_KVT = 241 * MiB;
constexpr size_t WS_SPT = 274 * MiB;
constexpr int CW_TMO = 0, CW_CODE = 1, CW_BAR = 4096;

struct Frame {
    LAS unsigned char* lds; volatile LAS unsigned* MISC; gu32* ctl;
    int tid, lane, wave, vcu, G;
};
__device__ __forceinline__ float wave_sum(float v) {
#pragma unroll
    for (int o = 1; o < 64; o <<= 1) v += __shfl_xor(v, o);
    return v;
}
__device__ __forceinline__ int sigma_in(int p) {
    const int pn = p >> 8, q = p & 255, bj = q >> 7, wc = (q >> 5) & 3, off = q & 31;
    if (pn < 4) return pn * 256 + wc * 64 + bj * 32 + off;
    if (pn >= 12 && pn < 17) return pn * 256 + wc * 64 + (off >> 4) * 32 + bj * 16 + (off & 15);
    return p;
}
__device__ __forceinline__ void p0_transpose_item(const float* W, int K, int N, bf16* WT, int p0, int k0, int srccol, LAS float* scr, int lane) {
#pragma unroll 8
    for (int i = 0; i < 32; ++i) { const int kk = 2 * i + (lane >> 5); scr[kk * 33 + (lane & 31)] = W[(size_t)(k0 + kk) * N + srccol]; }
    LDS_WAIT(); asm volatile("" ::: "memory");
    const int c = lane & 7;
#pragma unroll
    for (int j = 0; j < 4; ++j) { const int n = (lane >> 3) + 8 * j; const LAS float* s = scr + (8 * c) * 33 + n;
        v4u o; o.x = pk2(s[0 * 33], s[1 * 33]); o.y = pk2(s[2 * 33], s[3 * 33]); o.z = pk2(s[4 * 33], s[5 * 33]); o.w = pk2(s[6 * 33], s[7 * 33]);
        *(GAS v4u*)(WT + (size_t)(p0 + n) * K + k0 + 8 * c) = o; }
    LDS_WAIT(); asm volatile("" ::: "memory");
}
struct Args { const float* in[16]; float* out; unsigned char* ws; int ph_lo, ph_hi, li, pad; };

__device__ __forceinline__ void p0_prologue(Frame& F, const Args& a) {
    LAS float* scr = (LAS float*)(F.lds + RING_OFF + F.wave * 16384);
    const int gw = F.vcu * NWAVES + F.wave, NGW = F.G * NWAVES, lane = F.lane;
    const float* w_mod = a.in[4]; const float* w_in = a.in[8]; const float* w_out = a.in[11]; const float* w_gate = a.in[12]; const float* w_up = a.in[13]; const float* w_down = a.in[14];
    float* modacc = (float*)(a.ws + WS_MODACC);
    constexpr int I_GEMV = 48 * 32, I_RT = 128, I_AX = 1;
    constexpr int I_IN = 144 * 32, I_OUT = 64 * 32, I_GU = 352 * 32, I_DN = 64 * 88;
    constexpr int NITEMS = I_GEMV + I_RT + I_AX + I_IN + I_OUT + I_GU + I_DN;
    for (int it = gw; it < NITEMS; it += NGW) {
        int r = it;
        if (r < I_GEMV) {
            const int strip = r % 48, ks = r / 48; const int n = strip * 256 + 4 * lane;
            f32x4 a0 = {0.f, 0.f, 0.f, 0.f}, a1 = {0.f, 0.f, 0.f, 0.f};
            const float cv = a.in[1][ks * 64 + lane], cc = a.in[3][ks * 64 + lane];
            const float s0 = cv / (1.f + __expf(-cv)), s1 = cc / (1.f + __expf(-cc));
#pragma unroll 16
            for (int k = 0; k < 64; ++k) { const f32x4 w = *(const GAS f32x4*)(w_mod + (size_t)(ks * 64 + k) * (6 * D) + n);
                const float t0 = __shfl(s0, k), t1 = __shfl(s1, k); a0 += w * t0; a1 += w * t1; }
            if (ks == 0) { const f32x4 b = *(const f32x4*)(a.in[5] + n); a0 += b; a1 += b; }
#pragma unroll
            for (int e = 0; e < 4; ++e) { unsafeAtomicAdd(modacc + n + e, a0[e]); unsafeAtomicAdd(modacc + 6 * D + n + e, a1[e]); }
            continue; }
        r -= I_GEMV;
        if (r < I_RT) {
            const int t = r * 64 + lane; float* rc = (float*)(a.ws + WS_RT); float* rs = (float*)(a.ws + WS_RT + MiB);
            for (int j = 0; j < 32; ++j) { const float inv = powf(10000.f, -(float)j / 32.f), ang = (float)t * inv; float sn, cs; sincosf(ang, &sn, &cs); rc[t * 32 + j] = cs; rs[t * 32 + j] = sn; }
            continue; }
        r -= I_RT;
        if (r < I_AX) {
            float* ac = (float*)(a.ws + WS_AXT); float* as = (float*)(a.ws + WS_AXT + 8192);
            for (int i = lane; i < 128 * 16; i += 64) { const int pos = i >> 4, j = i & 15; const float inv = powf(10000.f, -(float)j / 16.f), ang = (float)pos * inv; float sn, cs; sincosf(ang, &sn, &cs); ac[i] = cs; as[i] = sn; }
            continue; }
        r -= I_AX;
        if (r < I_IN) { const int grp = r % 144, kb = r / 144; p0_transpose_item(w_in, D, NPROJ, (bf16*)(a.ws + WS_WIN), grp * 32, kb * 64, sigma_in(grp * 32 + (lane & 31)), scr, lane); continue; }
        r -= I_IN;
        if (r < I_OUT) { const int grp = r % 64, kb = r / 64; p0_transpose_item(w_out, D, D, (bf16*)(a.ws + WS_WOUT), grp * 32, kb * 64, grp * 32 + (lane & 31), scr, lane); continue; }
        r -= I_OUT;
        if (r < I_GU) { const int grp = r % 352, kb = r / 352; const int pn = grp >> 3, gg = grp & 7;
            p0_transpose_item((gg >> 2) ? w_up : w_gate, D, DFF, (bf16*)(a.ws + WS_WGU), grp * 32, kb * 64, pn * 128 + (gg & 3) * 32 + (lane & 31), scr, lane); continue; }
        r -= I_GU;
        { const int grp = r % 64, kb = r / 64; p0_transpose_item(w_down, DFF, D, (bf16*)(a.ws + WS_WDN), grp * 32, kb * 64, grp * 32 + (lane & 31), scr, lane); }
    }
}
__device__ __forceinline__ void modulate_row(const float* xrow, const float* g, const float* shift, const float* scale, bf16* orow, int lane) {
    const GAS f32x4* xr = (const GAS f32x4*)xrow + lane;
    f32x4 v[8]; float s = 0.f;
#pragma unroll
    for (int j = 0; j < 8; ++j) { v[j] = xr[64 * j]; s += (v[j].x * v[j].x + v[j].y * v[j].y) + (v[j].z * v[j].z + v[j].w * v[j].w); }
    const float r = rsqrtf(wave_sum(s) * (1.f / D) + EPS);
    GAS unsigned long long* o8 = (GAS unsigned long long*)orow + lane;
#pragma unroll
    for (int j = 0; j < 8; ++j) { const int c = 4 * lane + 256 * j; const f32x4 gg = *(const f32x4*)(g + c), sh = *(const f32x4*)(shift + c), sc = *(const f32x4*)(scale + c);
        const f32x4 y = v[j] * r * gg * (sc + 1.f) + sh;
        o8[64 * j] = (unsigned long long)pk2(y.x, y.y) | ((unsigned long long)pk2(y.z, y.w) << 32); }
}
__device__ __forceinline__ void final_norm_row(float* xrow, const float* g, int lane) {
    GAS f32x4* xr = (GAS f32x4*)xrow + lane;
    f32x4 v[8]; float s = 0.f;
#pragma unroll
    for (int j = 0; j < 8; ++j) { v[j] = xr[64 * j]; s += (v[j].x * v[j].x + v[j].y * v[j].y) + (v[j].z * v[j].z + v[j].w * v[j].w); }
    const float r = rsqrtf(wave_sum(s) * (1.f / D) + EPS);
#pragma unroll
    for (int j = 0; j < 8; ++j) { const f32x4 gg = *(const f32x4*)(g + 4 * lane + 256 * j); xr[64 * j] = v[j] * r * gg; }
}

typedef short s16x4 __attribute__((ext_vector_type(4)));
typedef short v4i16_t __attribute__((ext_vector_type(4)));
__device__ __forceinline__ s16x4 vtr(const LAS unsigned char* p) { return __builtin_bit_cast(s16x4, __builtin_amdgcn_ds_read_tr16_b64_v4i16((LAS v4i16_t*)p)); }
__device__ __forceinline__ bf16x8 cat8(s16x4 lo, s16x4 hi) { return (bf16x8){lo[0], lo[1], lo[2], lo[3], hi[0], hi[1], hi[2], hi[3]}; }
__device__ __forceinline__ f32x4 mfma16(bf16x8 a, bf16x8 b, f32x4 c) { return __builtin_amdgcn_mfma_f32_16x16x32_bf16(a, b, c, 0, 0, 0); }
__device__ __forceinline__ float ex2(float x) { return __builtin_amdgcn_exp2f(x); }
__device__ __forceinline__ unsigned pk2f(float lo, float hi) { return pg8::cvt_pk_bf16(lo, hi); }
constexpr int RSV = 288;
constexpr int RSK = 160;
__device__ __forceinline__ bf16x8 tr_frag(const LAS unsigned char* tile, int rs, int r0, int cb, int fr, int fq) {
    const LAS unsigned char* p = tile + (r0 + 4 * fq + (fr >> 2)) * rs + cb + 8 * (fr & 3);
    return cat8(vtr(p), vtr(p + 16 * rs));
}

__device__ __forceinline__ void ret_kv_item(Frame& F, const bf16* PROJ, float* KVT, int cc, int h, float lf2, float lb2) {
    const int lane = F.lane, fr = lane & 15, fq = lane >> 4, w = F.wave, tid = F.tid;
    const int row0 = cc < 2 ? L + 128 * cc : 128 * (cc - 2);
    LAS unsigned char* Vl = F.lds; LAS unsigned char* Kf = F.lds + 128 * RSV; LAS unsigned char* Kb = Kf + 128 * RSK;
    __syncthreads();
#pragma unroll
    for (int p = 0; p < 4; ++p) { const int idx = p * 512 + tid, row = idx >> 4, ch = idx & 15;
        const v4u v = *(const GAS v4u*)(PROJ + (size_t)(row0 + row) * NPROJ + C_RV + h * 128 + ch * 8); *(LAS v4u*)(Vl + row * RSV + ch * 16) = v; }
#pragma unroll
    for (int p = 0; p < 2; ++p) { const int idx = p * 512 + tid, row = idx >> 3, ch = idx & 7;
        const v4u v = *(const GAS v4u*)(PROJ + (size_t)(row0 + row) * NPROJ + C_RK + h * 64 + ch * 8);
        const float wf = ex2(lf2 * (float)(127 - row)), wb = ex2(lb2 * (float)row);
        v4u of, ob;
#pragma unroll
        for (int e = 0; e < 4; ++e) { const float lo = __uint_as_float(v[e] << 16), hi = __uint_as_float(v[e] & 0xffff0000u); of[e] = pk2f(lo * wf, hi * wf); ob[e] = pk2f(lo * wb, hi * wb); }
        *(LAS v4u*)(Kf + row * RSK + ch * 16) = of; *(LAS v4u*)(Kb + row * RSK + ch * 16) = ob; }
    __syncthreads();
    bf16x8 aV[4];
#pragma unroll
    for (int st = 0; st < 4; ++st) aV[st] = tr_frag(Vl, RSV, 32 * st, 32 * w, fr, fq);
#pragma unroll
    for (int dir = 0; dir < 2; ++dir) { const LAS unsigned char* Kx = dir ? Kb : Kf;
        float* outp = KVT + (((size_t)dir * 66 + cc) * 8 + h) * 8192 + (16 * w + 4 * fq) * 64 + fr;
#pragma unroll
        for (int dt = 0; dt < 4; ++dt) { f32x4 acc = {0.f, 0.f, 0.f, 0.f};
#pragma unroll
            for (int st = 0; st < 4; ++st) acc = mfma16(aV[st], tr_frag(Kx, RSK, 32 * st, 32 * dt, fr, fq), acc);
#pragma unroll
            for (int r = 0; r < 4; ++r) outp[r * 64 + 16 * dt] = acc[r]; } }
}
__device__ __forceinline__ void ret_scan_phase(Frame& F, const float* KVT, bf16* SPT, const float* ret_decay) {
    const int nthr = F.G * 512;
    for (int e = F.vcu * 512 + F.tid; e < 2 * 8 * 8192; e += nthr) {
        const int dir = e >> 16, h = (e >> 13) & 7, vd = e & 8191;
        const float g = __expf(-128.f * __expf(ret_decay[dir * 8 + h]));
        const float* kv = KVT + ((size_t)dir * 66 * 8 + h) * 8192 + vd;
        bf16* sp = SPT + ((size_t)dir * 64 * 8 + h) * 8192 + vd;
        float S = 0.f;
        if (dir == 0) { S = kv[0]; S = g * S + kv[65536];
#pragma unroll 8
            for (int c = 0; c < 64; ++c) { sp[(size_t)c * 65536] = (bf16)f2bf(S); S = g * S + kv[(size_t)(2 + c) * 65536]; } }
        else { S = kv[65536]; S = g * S + kv[0];
#pragma unroll 8
            for (int c = 63; c >= 0; --c) { sp[(size_t)c * 65536] = (bf16)f2bf(S); S = g * S + kv[(size_t)(2 + c) * 65536]; } }
    }
}
__device__ __forceinline__ void ret_out_item(Frame& F, const bf16* PROJ, const bf16* SPT, bf16* Y, int c, int h, float lf2, float lb2) {
    const int lane = F.lane, fr = lane & 15, fq = lane >> 4, w = F.wave, tid = F.tid;
    const int t0 = c * 128;
    LAS unsigned char* Vl = F.lds;
    __syncthreads();
#pragma unroll
    for (int p = 0; p < 4; ++p) { const int idx = p * 512 + tid, row = idx >> 4, ch = idx & 15;
        const v4u v = *(const GAS v4u*)(PROJ + (size_t)(t0 + row) * NPROJ + C_RV + h * 128 + ch * 8); *(LAS v4u*)(Vl + row * RSV + ch * 16) = v; }
    const int il = 16 * w + fr;
    const bf16* qrow = PROJ + (size_t)(t0 + il) * NPROJ + C_RQ + h * 64 + 8 * fq;
    bf16x8 qB[2]; qB[0] = *(const GAS bf16x8*)(qrow); qB[1] = *(const GAS bf16x8*)(qrow + 32);
    const float wf = ex2(lf2 * (float)(il + 1)), wb = ex2(lb2 * (float)(128 - il));
    const bf16* Sf = SPT + ((size_t)(0 * 64 + c) * 8 + h) * 8192 + fr * 64 + 8 * fq;
    const bf16* Sb = SPT + ((size_t)(1 * 64 + c) * 8 + h) * 8192 + fr * 64 + 8 * fq;
    f32x4 O[8];
#pragma unroll
    for (int vt = 0; vt < 8; ++vt) { f32x4 xf = {0.f, 0.f, 0.f, 0.f}, xb = {0.f, 0.f, 0.f, 0.f};
#pragma unroll
        for (int s = 0; s < 2; ++s) { xf = mfma16(*(const GAS bf16x8*)(Sf + vt * 1024 + 32 * s), qB[s], xf); xb = mfma16(*(const GAS bf16x8*)(Sb + vt * 1024 + 32 * s), qB[s], xb); }
        O[vt] = xf * wf + xb * wb; }
    unsigned pt[8][2];
    const bf16* krow = PROJ + (size_t)(t0 + fr) * NPROJ + C_RK + h * 64 + 8 * fq;
#pragma unroll
    for (int T = 0; T < 8; ++T) { f32x4 st = {0.f, 0.f, 0.f, 0.f};
#pragma unroll
        for (int s = 0; s < 2; ++s) st = mfma16(*(const GAS bf16x8*)(krow + (size_t)(16 * T) * NPROJ + 32 * s), qB[s], st);
#pragma unroll
        for (int r = 0; r < 4; ++r) { const int diff = il - (16 * T + 4 * fq + r); st[r] *= diff >= 0 ? ex2(lf2 * (float)diff) : ex2(lb2 * (float)(-diff)); }
        pt[T][0] = pk2f(st[0], st[1]); pt[T][1] = pk2f(st[2], st[3]); }
    __syncthreads();
#pragma unroll
    for (int st = 0; st < 4; ++st) { const v4u pw = {pt[2 * st][0], pt[2 * st][1], pt[2 * st + 1][0], pt[2 * st + 1][1]}; const bf16x8 pb = __builtin_bit_cast(bf16x8, pw);
#pragma unroll
        for (int vt = 0; vt < 8; ++vt) O[vt] = mfma16(tr_frag(Vl, RSV, 32 * st, 32 * vt, fr, fq), pb, O[vt]); }
    float ss = 0.f;
#pragma unroll
    for (int vt = 0; vt < 8; ++vt) ss += (O[vt][0] * O[vt][0] + O[vt][1] * O[vt][1]) + (O[vt][2] * O[vt][2] + O[vt][3] * O[vt][3]);
    ss += __shfl_xor(ss, 16); ss += __shfl_xor(ss, 32);
    const float r = rsqrtf(ss * (1.f / 128.f) + EPS);
    const bf16* grow = PROJ + (size_t)(t0 + il) * NPROJ + C_RG + h * 128 + 4 * fq;
    bf16* yrow = Y + (size_t)(t0 + il) * D + h * 128 + 4 * fq;
#pragma unroll
    for (int vt = 0; vt < 8; ++vt) { const unsigned long long gw = *(const GAS unsigned long long*)(grow + 16 * vt); const unsigned g0 = (unsigned)gw, g1 = (unsigned)(gw >> 32);
        const float y0 = O[vt][0] * r * __uint_as_float(g0 << 16), y1 = O[vt][1] * r * __uint_as_float(g0 & 0xffff0000u), y2 = O[vt][2] * r * __uint_as_float(g1 << 16), y3 = O[vt][3] * r * __uint_as_float(g1 & 0xffff0000u);
        *(GAS unsigned long long*)(yrow + 16 * vt) = (unsigned long long)pk2f(y0, y1) | ((unsigned long long)pk2f(y2, y3) << 32); }
}
constexpr int ATT_ROWS = 640;
__device__ __forceinline__ void attn_item(Frame& F, const bf16* PROJ, const float* sink, bf16* Y, int b, int kvh) {
    const int lane = F.lane, fr = lane & 15, fq = lane >> 4, w = F.wave, tid = F.tid;
    LAS unsigned char* Vl = F.lds;
    __syncthreads();
#pragma unroll
    for (int p = 0; p < 10; ++p) { const int idx = p * 512 + tid, row = idx >> 3, ch = idx & 7;
        int src; bool ok = true;
        if (row < 384) { const int key = 128 * b - 128 + row; ok = key >= 0 && key < L; src = ok ? key : 0; } else src = L + (row - 384);
        v4u v = *(const GAS v4u*)(PROJ + (size_t)src * NPROJ + C_AV + kvh * 64 + ch * 8);
        if (!ok) v = (v4u){0u, 0u, 0u, 0u};
        *(LAS v4u*)(Vl + row * RSK + ch * 16) = v; }
    const int iq = 128 * b + 16 * w + fr;
    bf16x8 qB[4][2]; float m[4], l[4]; f32x4 O[4][4];
#pragma unroll
    for (int g = 0; g < 4; ++g) { const bf16* qrow = PROJ + (size_t)iq * NPROJ + C_AQ + (4 * kvh + g) * 64 + 8 * fq;
        qB[g][0] = *(const GAS bf16x8*)(qrow); qB[g][1] = *(const GAS bf16x8*)(qrow + 32);
        m[g] = sink[4 * kvh + g] * LOG2E; l[g] = fq == 0 ? 1.f : 0.f;
#pragma unroll
        for (int dt = 0; dt < 4; ++dt) O[g][dt] = (f32x4){0.f, 0.f, 0.f, 0.f}; }
    __syncthreads();
    for (int step = 0; step < 17; ++step) {
        const bool isloc = step < 9;
        const int ldsrow0 = isloc ? 32 * ((w >> 1) + step) : 384 + 32 * (step - 9);
        const int key0 = 128 * b - 128 + ldsrow0;
        bf16x8 kA[2][2];
#pragma unroll
        for (int tt = 0; tt < 2; ++tt) { int kr;
            if (isloc) { kr = key0 + 16 * tt + fr; kr = kr < 0 ? 0 : (kr > L - 1 ? L - 1 : kr); } else kr = L + (ldsrow0 - 384) + 16 * tt + fr;
            const bf16* kp = PROJ + (size_t)kr * NPROJ + C_AK + kvh * 64 + 8 * fq;
            kA[tt][0] = *(const GAS bf16x8*)(kp); kA[tt][1] = *(const GAS bf16x8*)(kp + 32); }
        bf16x8 vA[4];
#pragma unroll
        for (int dt = 0; dt < 4; ++dt) vA[dt] = tr_frag(Vl, RSK, ldsrow0, 32 * dt, fr, fq);
#pragma unroll
        for (int g = 0; g < 4; ++g) {
            f32x4 s0 = {0.f, 0.f, 0.f, 0.f}, s1 = {0.f, 0.f, 0.f, 0.f};
            s0 = mfma16(kA[0][0], qB[g][0], s0); s0 = mfma16(kA[0][1], qB[g][1], s0);
            s1 = mfma16(kA[1][0], qB[g][0], s1); s1 = mfma16(kA[1][1], qB[g][1], s1);
            if (isloc) {
#pragma unroll
                for (int r = 0; r < 4; ++r) { const int k0 = key0 + 4 * fq + r, k1 = k0 + 16; const int d0 = iq - k0, d1 = iq - k1;
                    if (!(k0 >= 0 && k0 < L && d0 <= WIN && d0 >= -WIN)) s0[r] = -INFINITY;
                    if (!(k1 >= 0 && k1 < L && d1 <= WIN && d1 >= -WIN)) s1[r] = -INFINITY; } }
            float mx = fmaxf(fmaxf(fmaxf(s0[0], s0[1]), fmaxf(s0[2], s0[3])), fmaxf(fmaxf(s1[0], s1[1]), fmaxf(s1[2], s1[3])));
            mx = fmaxf(mx, __shfl_xor(mx, 16)); mx = fmaxf(mx, __shfl_xor(mx, 32));
            const float mn = fmaxf(m[g], mx), alpha = ex2(m[g] - mn); m[g] = mn;
            float ps = 0.f;
#pragma unroll
            for (int r = 0; r < 4; ++r) { s0[r] = ex2(s0[r] - mn); s1[r] = ex2(s1[r] - mn); ps += s0[r] + s1[r]; }
            l[g] = l[g] * alpha + ps;
            const v4u pw = {pk2f(s0[0], s0[1]), pk2f(s0[2], s0[3]), pk2f(s1[0], s1[1]), pk2f(s1[2], s1[3])}; const bf16x8 pb = __builtin_bit_cast(bf16x8, pw);
#pragma unroll
            for (int dt = 0; dt < 4; ++dt) { O[g][dt] *= alpha; O[g][dt] = mfma16(vA[dt], pb, O[g][dt]); }
        }
    }
#pragma unroll
    for (int g = 0; g < 4; ++g) { float lt = l[g]; lt += __shfl_xor(lt, 16); lt += __shfl_xor(lt, 32); const float inv = 1.f / lt;
        bf16* yrow = Y + (size_t)iq * D + 1024 + (4 * kvh + g) * 64 + 4 * fq;
#pragma unroll
        for (int dt = 0; dt < 4; ++dt) *(GAS unsigned long long*)(yrow + 16 * dt) = (unsigned long long)pk2f(O[g][dt][0] * inv, O[g][dt][1] * inv) | ((unsigned long long)pk2f(O[g][dt][2] * inv, O[g][dt][3] * inv) << 32); }
}
__global__ void __launch_bounds__(NWAVES * 64, 2) mk_fwd(Args args) {
    extern __shared__ __attribute__((aligned(16))) unsigned char lds[];
    Frame F;
    F.lds = (LAS unsigned char*)lds;
    F.MISC = (volatile LAS unsigned*)(F.lds + MISC_OFF);
    F.tid = threadIdx.x; F.lane = F.tid & 63; F.wave = __builtin_amdgcn_readfirstlane(F.tid >> 6);
    F.G = gridDim.x; { const int bx = blockIdx.x; F.vcu = (F.G % 8 == 0) ? (bx % 8) * (F.G / 8) + bx / 8 : bx; }
    unsigned char* ws = args.ws;
    F.ctl = (gu32*)(ws + WS_CTL);
    for (int u = F.tid; u < (LDS_BYTES - LDSCTL_OFF) / 4; u += NWAVES * 64) ((LAS unsigned*)(F.lds + LDSCTL_OFF))[u] = 0u;
    __syncthreads();
    XcdBarrier bar = xcd_barrier_post((unsigned*)(F.ctl + CW_BAR) + args.li * XCD_BAR_WORDS, F.MISC + 8);
    const int lo = args.ph_lo, hi = args.ph_hi;
#define IN(k) (lo <= (k) && (k) < hi)
#define BOTH(k) (IN(k) && IN((k) + 1))
    const float* mod = (const float*)(ws + WS_MODACC);
    bf16* HX = (bf16*)(ws + WS_HX); bf16* PROJ = (bf16*)(ws + WS_PROJ); bf16* Y = (bf16*)(ws + WS_Y); bf16* ACT = (bf16*)(ws + WS_ACT);
    const int gw = F.vcu * NWAVES + F.wave, NGW = F.G * NWAVES;

    if (IN(0)) { p0_prologue(F, args); if (BOTH(0)) xcd_barrier(bar); }
    if (IN(1)) {
        for (int m = gw; m < MROWS; m += NGW) {
            const float* src = m < L ? args.in[0] + (size_t)m * D : args.in[2] + (size_t)(m - L) * D; const float* mb = m < L ? mod : mod + 6 * D;
            modulate_row(src, args.in[6], mb, mb + D, HX + (size_t)m * D, F.lane); }
        if (BOTH(1)) xcd_barrier(bar);
    }
    if (IN(2)) {
        pg8::Gemm g{HX, (const bf16*)(ws + WS_WIN), MROWS, NPROJ, D}; pg8::StaticOrder S; S.init(MROWS, NPROJ, F.G, (int)blockIdx.x);
        pg8::EpiProj E{PROJ, (const float*)(ws + WS_RT), (const float*)(ws + WS_RT + MiB), (const float*)(ws + WS_AXT), (const float*)(ws + WS_AXT + 8192)};
        pg8::gemm_phase<pg8::EpiProj, pg8::StaticOrder, true, true>(F.lds + RING_OFF, g, S, E);
        if (BOTH(2)) xcd_barrier(bar);
    }
    if (IN(3)) {
        const float* rd = args.in[9];
        for (int it = F.vcu; it < 256; it += F.G) attn_item(F, PROJ, args.in[10], Y, it >> 2, it & 3);
        for (int it = F.vcu; it < 528; it += F.G) { const int cc = it >> 3, h = it & 7;
            ret_kv_item(F, PROJ, (float*)(ws + WS_KVT), cc, h, -__expf(rd[h]) * LOG2E, -__expf(rd[8 + h]) * LOG2E); }
        if (BOTH(3)) xcd_barrier(bar);
    }
    if (IN(4)) { ret_scan_phase(F, (const float*)(ws + WS_KVT), (bf16*)(ws + WS_SPT), args.in[9]); if (BOTH(4)) xcd_barrier(bar); }
    if (IN(5)) {
        const float* rd = args.in[9];
        for (int it = F.vcu; it < 512; it += F.G) { const int c = it >> 3, h = it & 7;
            ret_out_item(F, PROJ, (const bf16*)(ws + WS_SPT), Y, c, h, -__expf(rd[h]) * LOG2E, -__expf(rd[8 + h]) * LOG2E); }
        if (BOTH(5)) xcd_barrier(bar);
    }
    if (IN(6)) {
        pg8::Gemm g{Y, (const bf16*)(ws + WS_WOUT), L, D, D}; pg8::StaticOrder S; S.init(L, D, F.G, (int)blockIdx.x);
        pg8::EpiResid E{args.in[0], args.out, mod + 2 * D, D};
        pg8::gemm_phase<pg8::EpiResid, pg8::StaticOrder, true, true>(F.lds + RING_OFF, g, S, E);
        if (BOTH(6)) xcd_barrier(bar);
    }
    if (IN(7)) {
        for (int m = gw; m < L; m += NGW) modulate_row(args.out + (size_t)m * D, args.in[7], mod + 3 * D, mod + 4 * D, HX + (size_t)m * D, F.lane);
        if (BOTH(7)) xcd_barrier(bar);
    }
    if (IN(8)) {
        pg8::Gemm g{HX, (const bf16*)(ws + WS_WGU), L, 2 * DFF, D}; pg8::StaticOrder S; S.init(L, 2 * DFF, F.G, (int)blockIdx.x);
        pg8::EpiSwiglu E{ACT, DFF};
        pg8::gemm_phase<pg8::EpiSwiglu, pg8::StaticOrder, true, true>(F.lds + RING_OFF, g, S, E);
        if (BOTH(8)) xcd_barrier(bar);
    }
    if (IN(9)) {
        pg8::Gemm g{ACT, (const bf16*)(ws + WS_WDN), L, D, DFF}; pg8::StaticOrder S; S.init(L, D, F.G, (int)blockIdx.x);
        pg8::EpiResid E{args.out, args.out, mod + 5 * D, D};
        pg8::gemm_phase<pg8::EpiResid, pg8::StaticOrder, true, true>(F.lds + RING_OFF, g, S, E);
        if (BOTH(9)) xcd_barrier(bar);
    }
    if (IN(10)) { for (int m = gw; m < L; m += NGW) final_norm_row(args.out + (size_t)m * D, args.in[15], F.lane); }
#undef IN
#undef BOTH
}

extern "C" void kernel_launch(void* const* d_in, const int* in_sizes, int n_in, void* d_out, int out_size, void* d_ws, size_t ws_size, hipStream_t stream) {
    static int grid = 0;
    if (grid == 0) {
        if (n_in != 16 || in_sizes[0] != L * D || out_size != L * D || ws_size < WS_END) { fprintf(stderr, "kernel_launch: unexpected shapes (n_in %d, in0 %d, out %d, ws %zu)\n", n_in, n_in > 0 ? in_sizes[0] : -1, out_size, ws_size); grid = -1; return; }
        int dev = 0, cus = 0, per_cu = 0;
        if (hipGetDevice(&dev) != hipSuccess || hipDeviceGetAttribute(&cus, hipDeviceAttributeMultiprocessorCount, dev) != hipSuccess) { grid = -1; return; }
        if (hipFuncSetAttribute((const void*)mk_fwd, hipFuncAttributeMaxDynamicSharedMemorySize, LDS_BYTES) != hipSuccess) { fprintf(stderr, "kernel_launch: hipFuncSetAttribute failed\n"); grid = -1; return; }
        if (hipOccupancyMaxActiveBlocksPerMultiprocessor(&per_cu, (const void*)mk_fwd, NWAVES * 64, LDS_BYTES) != hipSuccess || per_cu < 1) { fprintf(stderr, "kernel_launch: occupancy query says %d blocks per CU\n", per_cu); grid = -1; (void)hipGetLastError(); return; }
        (void)hipGetLastError();
        grid = cus;
    }
    if (grid < 0) return;
    unsigned char* ws = (unsigned char*)d_ws;
    hipMemsetAsync(ws + WS_CTL, 0, CTL_BYTES, stream);
    Args a{};
    for (int i = 0; i < 16; ++i) a.in[i] = (const float*)d_in[i];
    a.out = (float*)d_out; a.ws = ws;
    a.ph_lo = 0; a.ph_hi = 11; a.li = 0;
    hipLaunchKernelGGL(mk_fwd, dim3(grid), dim3(NWAVES * 64), LDS_BYTES, stream, a);
}
```

```cpp
#ifndef PROBE_DBL
#define PROBE_DBL 0
#endif
#include <hip/hip_runtime.h>
#include <cstdio>
#include <cstdint>
#include <cmath>

typedef unsigned short bf16;
typedef unsigned u32x4 __attribute__((ext_vector_type(4)));
typedef float f32x4 __attribute__((ext_vector_type(4)));

constexpr int D = 2048, L = 8192, LC = 256, MROWS = L + LC;
constexpr int NPROJ = 4608, DFF = 5632;
constexpr int RH = 8, RDK = 64, RDV = 128, CH = 128, NCH = L / CH;
constexpr int AH = 16, AKV = 4, ADH = 64, WIN = 128;
constexpr float EPS = 1e-6f;
constexpr float LOG2E = 1.4426950408889634f;
constexpr int C_RQ = 0, C_RK = 512, C_RV = 1024, C_RG = 2048, C_AQ = 3072, C_AK = 4096, C_AV = 4352;

constexpr size_t MiB = 1u << 20;
constexpr size_t WS_CTL = 0, CTL_BYTES = 1 * MiB;
constexpr size_t WS_MOD = 1 * MiB;
constexpr size_t WS_HX = 100 * MiB;
constexpr size_t WS_PROJ = 134 * MiB;
constexpr size_t WS_Y = 209 * MiB;
constexpr size_t WS_ACT = 290 * MiB;
constexpr size_t WS_TMP = 209 * MiB;
constexpr size_t WS_OFB = 290 * MiB;
constexpr size_t WS_END = 384 * MiB;

__device__ __forceinline__ float bf2f(bf16 v) { return __uint_as_float((unsigned)v << 16); }
__device__ __forceinline__ bf16 f2bf_n(float f) { unsigned u = __float_as_uint(f); return (bf16)((u + 0x7fffu + ((u >> 16) & 1u)) >> 16); }
__device__ __forceinline__ float silu_f(float x) { return x / (1.f + __expf(-x)); }

__global__ __launch_bounds__(256) void nv_mod(const float* c, const float* cctx, const float* w_mod, const float* b_mod, float* mod) {
    __shared__ float s[2][D];
    for (int i = threadIdx.x; i < D; i += 256) { s[0][i] = silu_f(c[i]); s[1][i] = silu_f(cctx[i]); }
    __syncthreads();
    const int n = blockIdx.x * 256 + threadIdx.x;
    float a0 = 0.f, a1 = 0.f;
    for (int k = 0; k < D; ++k) { const float w = w_mod[(size_t)k * (6 * D) + n]; a0 += s[0][k] * w; a1 += s[1][k] * w; }
    mod[n] = a0 + b_mod[n]; mod[6 * D + n] = a1 + b_mod[n];
}
__global__ __launch_bounds__(256) void nv_modulate(const float* src, const float* g, const float* shift, const float* scale, bf16* out) {
    __shared__ float red[4];
    const int row = blockIdx.x; const float* x = src + (size_t)row * D;
    float v[8]; float ss = 0.f;
#pragma unroll
    for (int i = 0; i < 8; ++i) { v[i] = x[threadIdx.x + 256 * i]; ss += v[i] * v[i]; }
#pragma unroll
    for (int o = 1; o < 64; o <<= 1) ss += __shfl_xor(ss, o);
    if ((threadIdx.x & 63) == 0) red[threadIdx.x >> 6] = ss;
    __syncthreads();
    const float r = rsqrtf((red[0] + red[1] + red[2] + red[3]) * (1.f / D) + EPS);
#pragma unroll
    for (int i = 0; i < 8; ++i) { const int cidx = threadIdx.x + 256 * i; out[(size_t)row * D + cidx] = f2bf_n(v[i] * r * g[cidx] * (1.f + scale[cidx]) + shift[cidx]); }
}
template <int MODE> __global__ __launch_bounds__(256) void nv_gemm(const bf16* A, int lda, const float* B, const float* B2, int ldb, int K,
                                                                     float* Cf, bf16* Cb, int ldc, const float* R, const float* gate) {
    __shared__ float As[16][132]; __shared__ float Bs[16][64]; __shared__ float Bs2[16][64];
    const int tid = threadIdx.x, tx = tid & 15, ty = tid >> 4;
    const int m0 = blockIdx.y * 128, n0 = blockIdx.x * 64;
    float acc[8][4], acc2[8][4];
#pragma unroll
    for (int i = 0; i < 8; ++i)
#pragma unroll
        for (int j = 0; j < 4; ++j) { acc[i][j] = 0.f; acc2[i][j] = 0.f; }
    const int arow = tid >> 1, akh = (tid & 1) * 8, bk = tid >> 4, bn4 = (tid & 15) * 4;
    for (int k0 = 0; k0 < K; k0 += 16) {
        const u32x4 av = *(const u32x4*)(A + (size_t)(m0 + arow) * lda + k0 + akh);
        const f32x4 bv = *(const f32x4*)(B + (size_t)(k0 + bk) * ldb + n0 + bn4);
        f32x4 bv2 = bv; if (MODE == 1) bv2 = *(const f32x4*)(B2 + (size_t)(k0 + bk) * ldb + n0 + bn4);
#pragma unroll
        for (int i = 0; i < 4; ++i) { As[akh + 2 * i][arow] = __uint_as_float(av[i] << 16); As[akh + 2 * i + 1][arow] = __uint_as_float(av[i] & 0xffff0000u); }
        *(f32x4*)&Bs[bk][bn4] = bv; if (MODE == 1) *(f32x4*)&Bs2[bk][bn4] = bv2;
        __syncthreads();
#pragma unroll
        for (int k = 0; k < 16; ++k) {
            float a[8], b[4], b2[4];
#pragma unroll
            for (int i = 0; i < 8; ++i) a[i] = As[k][ty * 8 + i];
#pragma unroll
            for (int j = 0; j < 4; ++j) { b[j] = Bs[k][tx * 4 + j]; b2[j] = (MODE == 1) ? Bs2[k][tx * 4 + j] : 0.f; }
#pragma unroll
            for (int i = 0; i < 8; ++i)
#pragma unroll
                for (int j = 0; j < 4; ++j) { acc[i][j] += a[i] * b[j]; if (MODE == 1) acc2[i][j] += a[i] * b2[j]; }
        }
        __syncthreads();
    }
#pragma unroll
    for (int i = 0; i < 8; ++i)
#pragma unroll
        for (int j = 0; j < 4; ++j) {
            const size_t r = m0 + ty * 8 + i; const int cidx = n0 + tx * 4 + j;
            if (MODE == 0) Cf[r * ldc + cidx] = acc[i][j];
            if (MODE == 1) Cb[r * ldc + cidx] = f2bf_n(silu_f(acc[i][j]) * acc2[i][j]);
            if (MODE == 2) Cf[r * ldc + cidx] = R[r * ldc + cidx] + gate[cidx] * acc[i][j];
        }
}
__global__ __launch_bounds__(256) void nv_proj_epi(const float* tmp, bf16* proj) {
    const size_t idx = (size_t)blockIdx.x * 256 + threadIdx.x;
    const int row = (int)(idx / NPROJ), col = (int)(idx % NPROJ);
    const bool isctx = row >= L; const int t = row;
    const float* tr = tmp + (size_t)row * NPROJ;
    const float v = tr[col]; float o = v;
    if (col < C_RV) {
        if (!isctx) {
            const int d = col & 63, j = d & 31;
            const float inv = powf(10000.f, -(float)j / 32.f), ang = (float)t * inv; float sn, cs; sincosf(ang, &sn, &cs);
            if (d < 32) o = v * cs - tr[col + 32] * sn; else o = tr[col - 32] * sn + v * cs;
        }
        if (col >= C_RK) o *= 0.125f;
    } else if (col < C_RG) {
    } else if (col < C_AQ) { o = silu_f(v);
    } else if (col < C_AV) {
        if (!isctx) {
            const int d = (col - C_AQ) & 63, hf = d >> 5, dd = d & 31, j = dd & 15;
            const int pos = hf == 0 ? (t >> 6) : (t & 63);
            const float inv = powf(10000.f, -(float)j / 16.f), ang = (float)pos * inv; float sn, cs; sincosf(ang, &sn, &cs);
            if (dd < 16) o = v * cs - tr[col + 16] * sn; else o = tr[col - 16] * sn + v * cs;
        }
        if (col < C_AK) o *= 0.125f * LOG2E;
    }
    proj[idx] = f2bf_n(o);
}
__global__ __launch_bounds__(128) void nv_ret_scan(const bf16* proj, const float* ret_decay, float* ofb) {
    const int h = blockIdx.x & 7, dir = blockIdx.x >> 3, v = threadIdx.x;
    const float gam = __expf(-__expf(ret_decay[dir * RH + h]));
    float S[64];
#pragma unroll
    for (int d = 0; d < 64; ++d) S[d] = 0.f;
    float* out = ofb + (size_t)dir * L * 1024 + h * 128 + v;
    for (int step = 0; step < LC + L; ++step) {
        int row; bool lat;
        if (dir == 0) { lat = step >= LC; row = lat ? step - LC : L + step; }
        else { lat = step >= LC; row = lat ? (L - 1 - (step - LC)) : (L + LC - 1 - step); }
        const bf16* pr = proj + (size_t)row * NPROJ;
        const float vv = bf2f(pr[C_RV + h * 128 + v]);
        float kf[64], qf[64];
#pragma unroll
        for (int i = 0; i < 8; ++i) { const u32x4 kk = *(const u32x4*)(pr + C_RK + h * 64 + i * 8); const u32x4 qq = *(const u32x4*)(pr + C_RQ + h * 64 + i * 8);
#pragma unroll
            for (int e = 0; e < 4; ++e) { kf[i * 8 + 2 * e] = __uint_as_float(kk[e] << 16); kf[i * 8 + 2 * e + 1] = __uint_as_float(kk[e] & 0xffff0000u);
                                          qf[i * 8 + 2 * e] = __uint_as_float(qq[e] << 16); qf[i * 8 + 2 * e + 1] = __uint_as_float(qq[e] & 0xffff0000u); } }
        if (dir == 0) {
            float o = 0.f;
#pragma unroll
            for (int d = 0; d < 64; ++d) { S[d] = gam * S[d] + kf[d] * vv; o += qf[d] * S[d]; }
            if (lat) out[(size_t)row * 1024] = o;
        } else {
            float o = 0.f;
#pragma unroll
            for (int d = 0; d < 64; ++d) { o += qf[d] * S[d]; S[d] = gam * S[d] + kf[d] * vv; }
            if (lat) out[(size_t)row * 1024] = gam * o;
        }
    }
}
__global__ __launch_bounds__(128) void nv_ret_out(const float* ofb, const bf16* proj, bf16* Y) {
    __shared__ float red[2];
    const int t = blockIdx.x >> 3, h = blockIdx.x & 7, v = threadIdx.x;
    const size_t i = (size_t)t * 1024 + h * 128 + v;
    const float o = ofb[i] + ofb[(size_t)L * 1024 + i];
    float ss = o * o;
#pragma unroll
    for (int k = 1; k < 64; k <<= 1) ss += __shfl_xor(ss, k);
    if ((v & 63) == 0) red[v >> 6] = ss;
    __syncthreads();
    const float r = rsqrtf((red[0] + red[1]) * (1.f / 128.f) + EPS);
    Y[(size_t)t * D + h * 128 + v] = f2bf_n(o * r * bf2f(proj[(size_t)t * NPROJ + C_RG + h * 128 + v]));
}
__global__ __launch_bounds__(64) void nv_attn(const bf16* proj, const float* sink, bf16* Y) {
    const int idx = blockIdx.x * 64 + threadIdx.x; const int hq = idx / L, t = idx % L, kvh = hq >> 2;
    float q[64], acc[64];
    const bf16* qp = proj + (size_t)t * NPROJ + C_AQ + hq * 64;
#pragma unroll
    for (int d = 0; d < 64; ++d) { q[d] = bf2f(qp[d]); acc[d] = 0.f; }
    float m = sink[hq] * LOG2E, l = 1.f;
    const int lo = t - WIN < 0 ? 0 : t - WIN, hi = t + WIN > L - 1 ? L - 1 : t + WIN;
    const int nloc = hi - lo + 1;
    for (int s = 0; s < nloc + LC; ++s) {
        const int row = s < nloc ? lo + s : L + (s - nloc);
        const bf16* kp = proj + (size_t)row * NPROJ + C_AK + kvh * 64; const bf16* vp = proj + (size_t)row * NPROJ + C_AV + kvh * 64;
        float sc = 0.f;
#pragma unroll
        for (int d = 0; d < 64; ++d) sc += q[d] * bf2f(kp[d]);
        float p;
        if (sc > m) { const float f = exp2f(m - sc); l *= f;
#pragma unroll
            for (int d = 0; d < 64; ++d) acc[d] *= f;
            m = sc; p = 1.f; }
        else p = exp2f(sc - m);
        l += p;
#pragma unroll
        for (int d = 0; d < 64; ++d) acc[d] += p * bf2f(vp[d]);
    }
    const float rl = 1.f / l;
    bf16* yp = Y + (size_t)t * D + 1024 + hq * 64;
#pragma unroll
    for (int d = 0; d < 64; ++d) yp[d] = f2bf_n(acc[d] * rl);
}
__global__ __launch_bounds__(256) void nv_final_norm(float* xio, const float* g) {
    __shared__ float red[4];
    float* x = xio + (size_t)blockIdx.x * D;
    float v[8]; float ss = 0.f;
#pragma unroll
    for (int i = 0; i < 8; ++i) { v[i] = x[threadIdx.x + 256 * i]; ss += v[i] * v[i]; }
#pragma unroll
    for (int o = 1; o < 64; o <<= 1) ss += __shfl_xor(ss, o);
    if ((threadIdx.x & 63) == 0) red[threadIdx.x >> 6] = ss;
    __syncthreads();
    const float r = rsqrtf((red[0] + red[1] + red[2] + red[3]) * (1.f / D) + EPS);
#pragma unroll
    for (int i = 0; i < 8; ++i) { const int c = threadIdx.x + 256 * i; x[c] = v[i] * r * g[c]; }
}

namespace pg8 {
#define PG8_LAS __attribute__((address_space(3)))
typedef unsigned short bf16_t;
typedef short bf16x8 __attribute__((ext_vector_type(8)));
typedef float f32x4 __attribute__((ext_vector_type(4)));
typedef unsigned u32x4 __attribute__((ext_vector_type(4)));
constexpr int BM = 256, BK = 64, HALF = 128, HTB = HALF * BK * 2  , STAGE_BYTES = 8 * HTB, NXCD = 8, WGM = 8;

__host__ __device__ __forceinline__ int lds_byte(int r, int c) { const int st = (r >> 4) * 2 + (c >> 5), rr = r & 15, cc = c & 31, ob = rr * 64 + cc * 2; return st * 1024 + (ob ^ (((ob >> 9) & 1) << 5)); }
__host__ __device__ __forceinline__ void stage_rc(int b, int& R, int& C) { const int st = b / 1024, sb = b % 1024, swz = sb ^ (((sb >> 9) & 1) << 5); R = (st >> 1) * 16 + swz / 64; C = (st & 1) * 32 + (swz % 64) / 2; }
__host__ __device__ __forceinline__ int perm32(int rho) { const int n = rho >> 4, i = rho & 15; return 8 * (i >> 2) + 4 * n + (i & 3); }

struct Unit { int pm, pn; };
struct Gemm { const bf16_t* A; const bf16_t* Bt; int M, N, K; };

struct StaticOrder {
    int nM, nN, nwg, G, c;
    __host__ __device__ void init(int M, int N, int G_, int c_) { nM = M / BM; nN = N / BM; nwg = nM * nN; G = G_; c = c_; }
    __host__ __device__ bool next(int i, Unit& u) const {
        const long L = (long)i * G + c; if (L >= nwg) return false;
        int wgid = (int)L; { const int q = nwg / NXCD, r = nwg % NXCD, xcd = wgid % NXCD, off = wgid / NXCD; wgid = (xcd < r ? xcd * (q + 1) : r * (q + 1) + (xcd - r) * q) + off; }
        const int nig = WGM * nN, gid = wgid / nig, fm = gid * WGM, gsz = (nM - fm) < WGM ? (nM - fm) : WGM;
        u.pm = fm + ((wgid % nig) % gsz); u.pn = (wgid % nig) / gsz; return true;
    }
    __device__ __forceinline__ void a_ready(const Unit&) const {}
    __device__ __forceinline__ void done(const Unit&) const {}
};
__device__ __forceinline__ unsigned cvt_pk_bf16(float lo, float hi) { unsigned r; asm volatile("v_cvt_pk_bf16_f32 %0, %1, %2" : "=v"(r) : "v"(lo), "v"(hi)); return r; }
typedef float f32x2 __attribute__((ext_vector_type(2)));
template <class Epi, class Sched, bool ALIGN_EPI = false, bool SP2 = false>
__device__ __forceinline__ void gemm_phase(PG8_LAS unsigned char* lds, const Gemm g, const Sched& S, const Epi& E) {
    const int tid = threadIdx.x, wid = __builtin_amdgcn_readfirstlane(tid >> 6), lane = tid & 63, wr = wid >> 2, wc = wid & 3, fr = lane & 15, fq = lane >> 4;
    const int K = g.K, nt = K / BK;
    unsigned voffA[2], voffB[2];
#pragma unroll
    for (int i = 0; i < 2; ++i) { int R, C; stage_rc(tid * 16 + i * 8192, R, C); const int Rb = Epi::PERM ? ((R & ~31) + perm32(R & 31)) : R;
        voffA[i] = (unsigned)(R * K + C) * 2u; voffB[i] = (unsigned)(Rb * K + C) * 2u; }
    const size_t kstep = (size_t)(BK * 2);
    const size_t hstep = (size_t)HALF * K * 2;
    const size_t tstep = 2 * hstep;
    const unsigned ldsw = (unsigned)wid * 1024u;
    const int aoff = lds_byte(wr * 64 + fr, fq * 8), boff = lds_byte(wc * 32 + fr, fq * 8);
#define PG8_SA(b, h) (((b) * 2 + (h)) * HTB)
#define PG8_SB(b, h) ((4 + (b) * 2 + (h)) * HTB)
#define PG8_STAGE(bufoff, gbase, voff) do { _Pragma("unroll") for (int _i = 0; _i < 2; ++_i) \
        __builtin_amdgcn_global_load_lds((const unsigned*)((const char*)(gbase) + (voff)[_i]), (PG8_LAS unsigned*)(lds + (bufoff) + ldsw + _i * 8192), 16, 0, 0); } while (0)
#define PG8_LDA(dst, b, h) do { _Pragma("unroll") for (int m = 0; m < 4; ++m) _Pragma("unroll") for (int k = 0; k < 2; ++k) dst[m][k] = *(const PG8_LAS bf16x8*)(lds + PG8_SA(b, h) + aoff + m * 2048 + k * 1024); } while (0)
#define PG8_LDB(dst, b, h) do { _Pragma("unroll") for (int n = 0; n < 2; ++n) _Pragma("unroll") for (int k = 0; k < 2; ++k) dst[n][k] = *(const PG8_LAS bf16x8*)(lds + PG8_SB(b, h) + boff + n * 2048 + k * 1024); } while (0)
#define PG8_MMA(ai, bj, At, Bt) do { __builtin_amdgcn_s_setprio(1); _Pragma("unroll") for (int m = 0; m < 4; ++m) _Pragma("unroll") for (int n = 0; n < 2; ++n) _Pragma("unroll") for (int k = 0; k < 2; ++k) \
        acc[ai][bj][m][n] = __builtin_amdgcn_mfma_f32_16x16x32_bf16(Bt[n][k], At[m][k], acc[ai][bj][m][n], 0, 0, 0); __builtin_amdgcn_s_setprio(0); } while (0)
#define PG8_WAIT_V(n) asm volatile("s_waitcnt vmcnt(" #n ")" ::: "memory")
#define PG8_WAIT_L(n) asm volatile("s_waitcnt lgkmcnt(" #n ")" ::: "memory")
#define PG8_BAR __builtin_amdgcn_s_barrier()
#define PG8_SCHED __builtin_amdgcn_sched_barrier(0)
    Unit cur, nxt; int ui = 0;
    if (!S.next(0, cur)) return;
    f32x4 acc[2][2][4][2];
#pragma unroll
    for (int a = 0; a < 2; ++a)
#pragma unroll
        for (int b = 0; b < 2; ++b)
#pragma unroll
            for (int m = 0; m < 4; ++m)
#pragma unroll
                for (int n = 0; n < 2; ++n) acc[a][b][m][n] = (f32x4){0.f, 0.f, 0.f, 0.f};
    bf16x8 At[4][2], B0[2][2], B1[2][2];
    const char* cA = (const char*)g.A + (size_t)cur.pm * tstep; const char* cB = (const char*)g.Bt + (size_t)cur.pn * tstep;
    S.a_ready(cur);
    if constexpr (SP2) {
        PG8_STAGE(PG8_SB(0, 0), cB, voffB); PG8_STAGE(PG8_SB(0, 1), cB + hstep, voffB); PG8_STAGE(PG8_SA(0, 0), cA, voffA); PG8_STAGE(PG8_SA(0, 1), cA + hstep, voffA);
        if (wr == 1) PG8_BAR;
        PG8_WAIT_V(2); PG8_BAR;
        PG8_STAGE(PG8_SB(1, 0), cB + kstep, voffB); PG8_STAGE(PG8_SA(1, 0), cA + kstep, voffA); PG8_STAGE(PG8_SB(1, 1), cB + hstep + kstep, voffB);
        PG8_WAIT_V(6); PG8_BAR;
    } else {
        PG8_STAGE(PG8_SB(0, 0), cB, voffB); PG8_STAGE(PG8_SA(0, 0), cA, voffA); PG8_STAGE(PG8_SB(0, 1), cB + hstep, voffB); PG8_STAGE(PG8_SA(0, 1), cA + hstep, voffA);
        if (wr == 1) PG8_BAR;
        PG8_WAIT_V(4); PG8_BAR;
        PG8_STAGE(PG8_SB(1, 0), cB + kstep, voffB); PG8_STAGE(PG8_SA(1, 0), cA + kstep, voffA); PG8_STAGE(PG8_SB(1, 1), cB + hstep + kstep, voffB);
        PG8_WAIT_V(6); PG8_BAR;
    }
    for (;;) {
        const bool has_next = S.next(ui + 1, nxt);
        const char* nA = has_next ? (const char*)g.A + (size_t)nxt.pm * tstep : cA; const char* nB = has_next ? (const char*)g.Bt + (size_t)nxt.pn * tstep : cB;
        for (int t = 0; t < nt; t += 2) {
            const bool last = (t == nt - 2);
            const char* a1 = cA + (size_t)(t + 1) * kstep;
            const char* a2 = last ? nA : cA + (size_t)(t + 2) * kstep; const char* b2 = last ? nB : cB + (size_t)(t + 2) * kstep;
            const char* a3 = a2 + kstep; const char* b3 = b2 + kstep;
            if (last && has_next) S.a_ready(nxt);
            if constexpr (SP2) {
            PG8_LDB(B0, 0, 0); PG8_LDB(B1, 0, 1); PG8_SCHED; PG8_LDA(At, 0, 0); PG8_STAGE(PG8_SA(1, 1), a1 + hstep, voffA);
            PG8_WAIT_V(8); PG8_WAIT_L(0); PG8_BAR; PG8_MMA(0, 0, At, B0); PG8_MMA(0, 1, At, B1); PG8_BAR; PG8_SCHED;
            PG8_LDA(At, 0, 1); PG8_STAGE(PG8_SB(0, 0), b2, voffB); PG8_STAGE(PG8_SB(0, 1), b2 + hstep, voffB); PG8_STAGE(PG8_SA(0, 0), a2, voffA);
            PG8_WAIT_V(8); PG8_WAIT_L(0); PG8_BAR; PG8_MMA(1, 0, At, B0); PG8_MMA(1, 1, At, B1); PG8_BAR; PG8_SCHED;
            PG8_LDB(B0, 1, 0); PG8_LDB(B1, 1, 1); PG8_SCHED; PG8_LDA(At, 1, 0); PG8_STAGE(PG8_SA(0, 1), a2 + hstep, voffA);
            PG8_WAIT_V(8); PG8_WAIT_L(0); PG8_BAR; PG8_MMA(0, 0, At, B0); PG8_MMA(0, 1, At, B1); PG8_BAR; PG8_SCHED;
            PG8_LDA(At, 1, 1); PG8_STAGE(PG8_SB(1, 0), b3, voffB); PG8_STAGE(PG8_SB(1, 1), b3 + hstep, voffB); PG8_STAGE(PG8_SA(1, 0), a3, voffA);
            PG8_WAIT_V(8); PG8_WAIT_L(0); PG8_BAR; PG8_MMA(1, 0, At, B0); PG8_MMA(1, 1, At, B1); PG8_BAR; PG8_SCHED;
            } else {
            PG8_LDB(B0, 0, 0); PG8_SCHED; PG8_LDA(At, 0, 0); PG8_STAGE(PG8_SA(1, 1), a1 + hstep, voffA);
            PG8_WAIT_L(8); PG8_BAR; PG8_WAIT_L(0); PG8_MMA(0, 0, At, B0); PG8_BAR; PG8_SCHED;
            PG8_LDB(B1, 0, 1); PG8_STAGE(PG8_SB(0, 0), b2, voffB);
            PG8_BAR; PG8_WAIT_L(0); PG8_MMA(0, 1, At, B1); PG8_BAR;
            PG8_LDA(At, 0, 1); PG8_STAGE(PG8_SA(0, 0), a2, voffA);
            PG8_BAR; PG8_WAIT_L(0); PG8_MMA(1, 0, At, B0); PG8_BAR; PG8_SCHED;
            PG8_STAGE(PG8_SB(0, 1), b2 + hstep, voffB);
            PG8_WAIT_V(6); PG8_BAR; PG8_MMA(1, 1, At, B1); PG8_BAR;
            PG8_LDB(B0, 1, 0); PG8_SCHED; PG8_LDA(At, 1, 0); PG8_STAGE(PG8_SA(0, 1), a2 + hstep, voffA);
            PG8_WAIT_L(8); PG8_BAR; PG8_WAIT_L(0); PG8_MMA(0, 0, At, B0); PG8_BAR; PG8_SCHED;
            PG8_LDB(B1, 1, 1); PG8_STAGE(PG8_SB(1, 0), b3, voffB);
            PG8_BAR; PG8_WAIT_L(0); PG8_MMA(0, 1, At, B1); PG8_BAR;
            PG8_LDA(At, 1, 1); PG8_STAGE(PG8_SA(1, 0), a3, voffA);
            PG8_BAR; PG8_WAIT_L(0); PG8_MMA(1, 0, At, B0); PG8_BAR; PG8_SCHED;
            PG8_STAGE(PG8_SB(1, 1), b3 + hstep, voffB);
            PG8_WAIT_V(6); PG8_BAR; PG8_MMA(1, 1, At, B1); PG8_BAR;
            }
        }
        if constexpr (ALIGN_EPI) { if (wr == 0) PG8_BAR; }
        if constexpr (!Epi::AFTER_DRAIN) { E(acc, cur, wr, wc, fr, fq); S.done(cur); }
        if (!has_next) break;
#pragma unroll
        for (int a = 0; a < 2; ++a)
#pragma unroll
            for (int b = 0; b < 2; ++b)
#pragma unroll
                for (int m = 0; m < 4; ++m)
#pragma unroll
                    for (int n = 0; n < 2; ++n) acc[a][b][m][n] = (f32x4){0.f, 0.f, 0.f, 0.f};
        cur = nxt; cA = nA; cB = nB; ++ui;
        if constexpr (ALIGN_EPI) { if (wr == 1) PG8_BAR; }
    }
    PG8_WAIT_V(0);
    if constexpr (!ALIGN_EPI) { if (wr == 0) PG8_BAR; }
    PG8_BAR;
    if constexpr (Epi::AFTER_DRAIN) { E.fused(acc, cur, wr, wc, fr, fq, lds, wid, lane); S.done(cur); }
#undef PG8_SA
#undef PG8_SB
#undef PG8_STAGE
#undef PG8_LDA
#undef PG8_LDB
#undef PG8_MMA
#undef PG8_WAIT_V
#undef PG8_WAIT_L
#undef PG8_BAR
#undef PG8_SCHED
}
}
namespace pg8 {
__device__ __forceinline__ float silu_fast(float x) { return x * __builtin_amdgcn_rcpf(1.f + __expf(-x)); }
struct EpiProj {
    static constexpr bool PERM = true, AFTER_DRAIN = false;
    bf16_t* P; const float* rtc; const float* rts; const float* axc; const float* axs;
    __device__ __forceinline__ void operator()(const f32x4 (&acc)[2][2][4][2], const Unit& u, int wr, int wc, int fr, int fq) const {
        const int pn = u.pn; const bool isctx = (u.pm == 32);
        const int row0 = u.pm * BM + wr * 64 + fr;
        int type = 0; float sc = 1.f;
        if (pn < 4) { type = 2; if (pn >= 2) sc = 0.125f; }
        else if (pn < 8) type = 0;
        else if (pn < 12) type = 1;
        else if (pn < 17) { type = 3; if (pn < 16) sc = 0.125f * 1.4426950408889634f; }
        if (type < 2) {
#pragma unroll
            for (int ai = 0; ai < 2; ++ai)
#pragma unroll
                for (int m = 0; m < 4; ++m) { bf16_t* rowp = P + (size_t)(row0 + ai * HALF + m * 16) * 4608 + pn * BM + wc * 32 + 8 * fq;
#pragma unroll
                    for (int bj = 0; bj < 2; ++bj) { f32x4 v0 = acc[ai][bj][m][0], v1 = acc[ai][bj][m][1];
                        if (type == 1) {
#pragma unroll
                            for (int e = 0; e < 4; ++e) { v0[e] = silu_fast(v0[e]); v1[e] = silu_fast(v1[e]); } }
                        u32x4 w; w.x = cvt_pk_bf16(v0[0], v0[1]); w.y = cvt_pk_bf16(v0[2], v0[3]); w.z = cvt_pk_bf16(v1[0], v1[1]); w.w = cvt_pk_bf16(v1[2], v1[3]);
                        *(u32x4*)(rowp + bj * HALF) = w; } }
        } else {
            const int hf = fq >> 1;
#pragma unroll
            for (int ai = 0; ai < 2; ++ai)
#pragma unroll
                for (int m = 0; m < 4; ++m) { const int r = row0 + ai * HALF + m * 16;
                    f32x4 cs[2], sn[2];
                    if (isctx) { cs[0] = cs[1] = (f32x4){1.f, 1.f, 1.f, 1.f}; sn[0] = sn[1] = (f32x4){0.f, 0.f, 0.f, 0.f}; }
                    else if (type == 2) { const size_t o = (size_t)r * 32 + 8 * fq; cs[0] = *(const f32x4*)(rtc + o); cs[1] = *(const f32x4*)(rtc + o + 4); sn[0] = *(const f32x4*)(rts + o); sn[1] = *(const f32x4*)(rts + o + 4); }
                    else { const int pos = hf ? (r & 63) : (r >> 6); const int o = pos * 16 + 8 * (fq & 1); cs[0] = *(const f32x4*)(axc + o); cs[1] = *(const f32x4*)(axc + o + 4); sn[0] = *(const f32x4*)(axs + o); sn[1] = *(const f32x4*)(axs + o + 4); }
                    f32x4 o1[2], o2[2];
#pragma unroll
                    for (int n = 0; n < 2; ++n) { const f32x4 x1 = acc[ai][0][m][n], x2 = acc[ai][1][m][n]; o1[n] = (x1 * cs[n] - x2 * sn[n]) * sc; o2[n] = (x1 * sn[n] + x2 * cs[n]) * sc; }
                    u32x4 w1, w2; w1.x = cvt_pk_bf16(o1[0][0], o1[0][1]); w1.y = cvt_pk_bf16(o1[0][2], o1[0][3]); w1.z = cvt_pk_bf16(o1[1][0], o1[1][1]); w1.w = cvt_pk_bf16(o1[1][2], o1[1][3]);
                    w2.x = cvt_pk_bf16(o2[0][0], o2[0][1]); w2.y = cvt_pk_bf16(o2[0][2], o2[0][3]); w2.z = cvt_pk_bf16(o2[1][0], o2[1][1]); w2.w = cvt_pk_bf16(o2[1][2], o2[1][3]);
                    bf16_t* rowp = P + (size_t)r * 4608 + pn * BM + wc * 64;
                    if (type == 2) { *(u32x4*)(rowp + 8 * fq) = w1; *(u32x4*)(rowp + 32 + 8 * fq) = w2; }
                    else { *(u32x4*)(rowp + 32 * hf + 8 * (fq & 1)) = w1; *(u32x4*)(rowp + 32 * hf + 16 + 8 * (fq & 1)) = w2; } }
        }
    }
};
struct EpiResid {
    static constexpr bool PERM = false, AFTER_DRAIN = false;
    const float* R; float* out; const float* gate; int ldc;
    __device__ __forceinline__ void operator()(const f32x4 (&acc)[2][2][4][2], const Unit& u, int wr, int wc, int fr, int fq) const {
        const int row0 = u.pm * BM + wr * 64 + fr, col0 = u.pn * BM + wc * 32 + 4 * fq;
        f32x4 gv[2][2];
#pragma unroll
        for (int bj = 0; bj < 2; ++bj)
#pragma unroll
            for (int n = 0; n < 2; ++n) gv[bj][n] = *(const f32x4*)(gate + col0 + bj * HALF + n * 16);
#pragma unroll
        for (int ai = 0; ai < 2; ++ai)
#pragma unroll
            for (int m = 0; m < 4; ++m) { const size_t off = (size_t)(row0 + ai * HALF + m * 16) * ldc + col0;
#pragma unroll
                for (int bj = 0; bj < 2; ++bj)
#pragma unroll
                    for (int n = 0; n < 2; ++n) { const f32x4 rs = *(const f32x4*)(R + off + bj * HALF + n * 16); *(f32x4*)(out + off + bj * HALF + n * 16) = rs + gv[bj][n] * acc[ai][bj][m][n]; } }
    }
};
struct EpiSwiglu {
    static constexpr bool PERM = true, AFTER_DRAIN = false;
    bf16_t* O; int ldc;
    __device__ __forceinline__ void operator()(const f32x4 (&acc)[2][2][4][2], const Unit& u, int wr, int wc, int fr, int fq) const {
        const int row0 = u.pm * BM + wr * 64 + fr, col0 = u.pn * HALF + wc * 32 + 8 * fq;
#pragma unroll
        for (int ai = 0; ai < 2; ++ai)
#pragma unroll
            for (int m = 0; m < 4; ++m) { f32x4 v[2];
#pragma unroll
                for (int n = 0; n < 2; ++n) { const f32x4 g = acc[ai][0][m][n], up = acc[ai][1][m][n];
#pragma unroll
                    for (int e = 0; e < 4; ++e) v[n][e] = silu_fast(g[e]) * up[e]; }
                u32x4 w; w.x = cvt_pk_bf16(v[0][0], v[0][1]); w.y = cvt_pk_bf16(v[0][2], v[0][3]); w.z = cvt_pk_bf16(v[1][0], v[1][1]); w.w = cvt_pk_bf16(v[1][2], v[1][3]);
                *(u32x4*)(O + (size_t)(row0 + ai * HALF + m * 16) * ldc + col0) = w; }
    }
};
}
#define GAS __attribute__((address_space(1)))
#define LAS __attribute__((address_space(3)))
typedef unsigned short bf16;
typedef unsigned v4u __attribute__((ext_vector_type(4)));
typedef float f32x4 __attribute__((ext_vector_type(4)));
typedef short bf16x8 __attribute__((ext_vector_type(8)));
typedef GAS unsigned gu32;
typedef GAS unsigned long long gu64;
#define RLX_AGENT __ATOMIC_RELAXED, __HIP_MEMORY_SCOPE_AGENT
#define LDS_WAIT() asm volatile("s_waitcnt lgkmcnt(0)" ::: "memory")
#define VM_WAIT() asm volatile("s_waitcnt vmcnt(0)" ::: "memory")
__device__ __forceinline__ unsigned long long rt() { return __builtin_amdgcn_s_memrealtime(); }
__device__ __forceinline__ unsigned f2bf(float f) { unsigned u = __builtin_bit_cast(unsigned, f); return (u + 0x7fffu + ((u >> 16) & 1u)) >> 16; }
__device__ __forceinline__ unsigned pk2(float lo, float hi) { return f2bf(lo) | (f2bf(hi) << 16); }
#define XB_TMO      128
#define XB_XCNT(j)  (256  + 64 * (j))
#define XB_XSUB(j)  (1280 + 64 * (j))
#define XB_XGEN(j)  (2304 + 64 * (j))
#define XB_TOP      3328
#define XB_TOPGEN   3392
#define XCD_BAR_WORDS 3456
#define XB_SPIN_CAP (1u << 18)

__device__ __forceinline__ unsigned xb_ld(unsigned* p)              { return __hip_atomic_load(p, __ATOMIC_RELAXED, __HIP_MEMORY_SCOPE_AGENT); }
__device__ __forceinline__ unsigned xb_add(unsigned* p, unsigned v) { return __hip_atomic_fetch_add(p, v, __ATOMIC_RELAXED, __HIP_MEMORY_SCOPE_AGENT); }
__device__ __forceinline__ unsigned xb_xcc_id() { return (unsigned)__builtin_amdgcn_s_getreg((3 << 11) | 20) & 0xFu; }
#define XB_SPIN(cond, bar) do { unsigned _sp = 0; while (cond) { __builtin_amdgcn_s_sleep(1); \
    if ((++_sp & 255u) == 0u) { if (xb_ld(&(bar)[XB_TMO])) break; if (_sp > XB_SPIN_CAP) { atomicAdd(&(bar)[XB_TMO], 1u); break; } } } } while (0)

struct XcdBarrier {
    unsigned* bar; unsigned x;
    volatile LAS unsigned* st;
};

__device__ __forceinline__ XcdBarrier xcd_barrier_post(unsigned* bar, volatile LAS unsigned* st) {
    XcdBarrier b; b.bar = bar; b.x = xb_xcc_id(); b.st = st;
    if (threadIdx.x == 0) (void)xb_add(&bar[XB_XCNT(b.x)], 1u);
    return b;
}
__device__ __forceinline__ void xcd_barrier_complete(unsigned* bar, unsigned x, unsigned& nloc, unsigned& nx) {
    const unsigned G = gridDim.x * gridDim.y * gridDim.z;
    unsigned sum, cnt, mine, sp = 0u;
    for (;;) {
        sum = 0u; cnt = 0u; mine = 0u;
#pragma unroll
        for (unsigned j = 0; j < 16; ++j) { const unsigned c = xb_ld(&bar[XB_XCNT(j)]); sum += c; cnt += (c > 0u) ? 1u : 0u; mine = (j == x) ? c : mine; }
        if (sum == G) break;
        __builtin_amdgcn_s_sleep(1);
        if ((++sp & 255u) == 0u) { if (xb_ld(&bar[XB_TMO])) break; if (sp > XB_SPIN_CAP) { atomicAdd(&bar[XB_TMO], 1u); break; } }
    }
    nloc = mine > 0u ? mine : 1u; nx = cnt > 0u ? cnt : 1u;
}

__device__ __forceinline__ void xcd_barrier(const XcdBarrier& b) {
    asm volatile("s_waitcnt vmcnt(0)" ::: "memory");
    __syncthreads();
    if (threadIdx.x == 0) {
        unsigned* bar = b.bar;
        __builtin_amdgcn_s_waitcnt(0);
        unsigned nloc = b.st[0], nx = b.st[1];
        if (nloc == 0u) { xcd_barrier_complete(bar, b.x, nloc, nx); b.st[0] = nloc; b.st[1] = nx; }
        const unsigned old = xb_add(&bar[XB_XSUB(b.x)], 1u);
        const unsigned gen = old / nloc;
        if (old + 1u == (gen + 1u) * nloc) {
            __builtin_amdgcn_fence(__ATOMIC_RELEASE, "agent");
            asm volatile("s_waitcnt vmcnt(0)" ::: "memory");
            const unsigned og = xb_add(&bar[XB_TOP], 1u);
            const unsigned tg = og / nx;
            if (og + 1u == (tg + 1u) * nx) xb_add(&bar[XB_TOPGEN], 1u);
            else XB_SPIN(xb_ld(&bar[XB_TOPGEN]) == tg, bar);
            __builtin_amdgcn_fence(__ATOMIC_ACQUIRE, "agent");
            xb_add(&bar[XB_XGEN(b.x)], 1u);
            asm volatile("s_waitcnt vmcnt(0)" ::: "memory");
        } else {
            XB_SPIN(xb_ld(&bar[XB_XGEN(b.x)]) == gen, bar);
            __builtin_amdgcn_fence(__ATOMIC_ACQUIRE, "agent");
            asm volatile("s_waitcnt vmcnt(0)" ::: "memory");
        }
    }
    __syncthreads();
}
constexpr int NWAVES = 8;
constexpr int RING_OFF = 0, RING_BYTES = 131072;
constexpr int LDSCTL_OFF = RING_BYTES, MISC_OFF = LDSCTL_OFF + 320;
constexpr int LDS_BYTES = 147456;
constexpr size_t WS_MODACC = 512 * 1024;
constexpr size_t WS_RT = 2 * MiB;
constexpr size_t WS_AXT = 4 * MiB;
constexpr size_t WS_WIN = 8 * MiB, WS_WOUT = 26 * MiB, WS_WGU = 34 * MiB, WS_WDN = 78 * MiB;
constexpr size_t WS_KVT = 241 * MiB;
constexpr size_t WS_SPT = 274 * MiB;
constexpr int CW_TMO = 0, CW_CODE = 1, CW_BAR = 4096;

struct Frame {
    LAS unsigned char* lds; volatile LAS unsigned* MISC; gu32* ctl;
    int tid, lane, wave, vcu, G;
};
__device__ __forceinline__ float wave_sum(float v) {
#pragma unroll
    for (int o = 1; o < 64; o <<= 1) v += __shfl_xor(v, o);
    return v;
}
__device__ __forceinline__ int sigma_in(int p) {
    const int pn = p >> 8, q = p & 255, bj = q >> 7, wc = (q >> 5) & 3, off = q & 31;
    if (pn < 4) return pn * 256 + wc * 64 + bj * 32 + off;
    if (pn >= 12 && pn < 17) return pn * 256 + wc * 64 + (off >> 4) * 32 + bj * 16 + (off & 15);
    return p;
}
__device__ __forceinline__ void p0_transpose_item(const float* W, int K, int N, bf16* WT, int p0, int k0, int srccol, LAS float* scr, int lane) {
    float tv[32];
#pragma unroll
    for (int i = 0; i < 32; ++i) tv[i] = W[(size_t)(k0 + 2 * i + (lane >> 5)) * N + srccol];
#pragma unroll
    for (int i = 0; i < 32; ++i) scr[(2 * i + (lane >> 5)) * 33 + (lane & 31)] = tv[i];
    LDS_WAIT(); asm volatile("" ::: "memory");
    const int c = lane & 7;
#pragma unroll
    for (int j = 0; j < 4; ++j) { const int n = (lane >> 3) + 8 * j; const LAS float* s = scr + (8 * c) * 33 + n;
        v4u o; o.x = pk2(s[0 * 33], s[1 * 33]); o.y = pk2(s[2 * 33], s[3 * 33]); o.z = pk2(s[4 * 33], s[5 * 33]); o.w = pk2(s[6 * 33], s[7 * 33]);
        *(GAS v4u*)(WT + (size_t)(p0 + n) * K + k0 + 8 * c) = o; }
    LDS_WAIT(); asm volatile("" ::: "memory");
}
struct Args { const float* in[16]; float* out; unsigned char* ws; int ph_lo, ph_hi, li, pad; };

__device__ __forceinline__ void p0_prologue(Frame& F, const Args& a, bool do_atomics) {
    LAS float* scr = (LAS float*)(F.lds + RING_OFF + F.wave * 16384);
    const int gw = F.vcu * NWAVES + F.wave, NGW = F.G * NWAVES, lane = F.lane;
    const float* w_mod = a.in[4]; const float* w_in = a.in[8]; const float* w_out = a.in[11]; const float* w_gate = a.in[12]; const float* w_up = a.in[13]; const float* w_down = a.in[14];
    float* modacc = (float*)(a.ws + WS_MODACC);
    constexpr int I_GEMV = 48 * 32, I_RT = 128, I_AX = 1;
    constexpr int I_IN = 144 * 32, I_OUT = 64 * 32, I_GU = 352 * 32, I_DN = 64 * 88;
    constexpr int NITEMS = I_GEMV + I_RT + I_AX + I_IN + I_OUT + I_GU + I_DN;
    for (int it = gw; it < NITEMS; it += NGW) {
        int r = it;
        if (r < I_GEMV) {
            const int strip = r % 48, ks = r / 48; const int n = strip * 256 + 4 * lane;
            f32x4 a0 = {0.f, 0.f, 0.f, 0.f}, a1 = {0.f, 0.f, 0.f, 0.f};
            const float cv = a.in[1][ks * 64 + lane], cc = a.in[3][ks * 64 + lane];
            const float s0 = cv / (1.f + __expf(-cv)), s1 = cc / (1.f + __expf(-cc));
#pragma unroll 16
            for (int k = 0; k < 64; ++k) { const f32x4 w = *(const GAS f32x4*)(w_mod + (size_t)(ks * 64 + k) * (6 * D) + n);
                const float t0 = __shfl(s0, k), t1 = __shfl(s1, k); a0 += w * t0; a1 += w * t1; }
            if (ks == 0) { const f32x4 b = *(const f32x4*)(a.in[5] + n); a0 += b; a1 += b; }
#pragma unroll
            for (int e = 0; e < 4; ++e) { if (do_atomics) { unsafeAtomicAdd(modacc + n + e, a0[e]); unsafeAtomicAdd(modacc + 6 * D + n + e, a1[e]); } else asm volatile("" :: "v"(a0[e]), "v"(a1[e])); }
            continue; }
        r -= I_GEMV;
        if (r < I_RT) {
            const int t = r * 64 + lane; float* rc = (float*)(a.ws + WS_RT); float* rs = (float*)(a.ws + WS_RT + MiB);
            for (int j = 0; j < 32; ++j) { const float inv = powf(10000.f, -(float)j / 32.f), ang = (float)t * inv; float sn, cs; sincosf(ang, &sn, &cs); rc[t * 32 + j] = cs; rs[t * 32 + j] = sn; }
            continue; }
        r -= I_RT;
        if (r < I_AX) {
            float* ac = (float*)(a.ws + WS_AXT); float* as = (float*)(a.ws + WS_AXT + 8192);
            for (int i = lane; i < 128 * 16; i += 64) { const int pos = i >> 4, j = i & 15; const float inv = powf(10000.f, -(float)j / 16.f), ang = (float)pos * inv; float sn, cs; sincosf(ang, &sn, &cs); ac[i] = cs; as[i] = sn; }
            continue; }
        r -= I_AX;
        if (r < I_IN) { const int grp = r % 144, kb = r / 144; p0_transpose_item(w_in, D, NPROJ, (bf16*)(a.ws + WS_WIN), grp * 32, kb * 64, sigma_in(grp * 32 + (lane & 31)), scr, lane); continue; }
        r -= I_IN;
        if (r < I_OUT) { const int grp = r % 64, kb = r / 64; p0_transpose_item(w_out, D, D, (bf16*)(a.ws + WS_WOUT), grp * 32, kb * 64, grp * 32 + (lane & 31), scr, lane); continue; }
        r -= I_OUT;
        if (r < I_GU) { const int grp = r % 352, kb = r / 352; const int pn = grp >> 3, gg = grp & 7;
            p0_transpose_item((gg >> 2) ? w_up : w_gate, D, DFF, (bf16*)(a.ws + WS_WGU), grp * 32, kb * 64, pn * 128 + (gg & 3) * 32 + (lane & 31), scr, lane); continue; }
        r -= I_GU;
        { const int grp = r % 64, kb = r / 64; p0_transpose_item(w_down, DFF, D, (bf16*)(a.ws + WS_WDN), grp * 32, kb * 64, grp * 32 + (lane & 31), scr, lane); }
    }
}
__device__ __forceinline__ void modulate_row(const float* xrow, const float* g, const float* shift, const float* scale, bf16* orow, int lane) {
    const GAS f32x4* xr = (const GAS f32x4*)xrow + lane;
    f32x4 v[8]; float s = 0.f;
#pragma unroll
    for (int j = 0; j < 8; ++j) { v[j] = xr[64 * j]; s += (v[j].x * v[j].x + v[j].y * v[j].y) + (v[j].z * v[j].z + v[j].w * v[j].w); }
    const float r = rsqrtf(wave_sum(s) * (1.f / D) + EPS);
    GAS unsigned long long* o8 = (GAS unsigned long long*)orow + lane;
#pragma unroll
    for (int j = 0; j < 8; ++j) { const int c = 4 * lane + 256 * j; const f32x4 gg = *(const f32x4*)(g + c), sh = *(const f32x4*)(shift + c), sc = *(const f32x4*)(scale + c);
        const f32x4 y = v[j] * r * gg * (sc + 1.f) + sh;
        o8[64 * j] = (unsigned long long)pk2(y.x, y.y) | ((unsigned long long)pk2(y.z, y.w) << 32); }
}
__device__ __forceinline__ void modulate_row2(const float* x1, const float* x2, const float* g, const float* sh1, const float* sc1, const float* sh2, const float* sc2, bf16* o1, bf16* o2, int lane) {
    const GAS f32x4* xr1 = (const GAS f32x4*)x1 + lane; const GAS f32x4* xr2 = (const GAS f32x4*)x2 + lane;
    f32x4 v[8], u[8]; float s = 0.f, t = 0.f;
#pragma unroll
    for (int j = 0; j < 8; ++j) { v[j] = xr1[64 * j]; u[j] = xr2[64 * j]; }
#pragma unroll
    for (int j = 0; j < 8; ++j) { s += (v[j].x * v[j].x + v[j].y * v[j].y) + (v[j].z * v[j].z + v[j].w * v[j].w); t += (u[j].x * u[j].x + u[j].y * u[j].y) + (u[j].z * u[j].z + u[j].w * u[j].w); }
    const float r1 = rsqrtf(wave_sum(s) * (1.f / D) + EPS), r2 = rsqrtf(wave_sum(t) * (1.f / D) + EPS);
    GAS unsigned long long* p1 = (GAS unsigned long long*)o1 + lane; GAS unsigned long long* p2 = (GAS unsigned long long*)o2 + lane;
#pragma unroll
    for (int j = 0; j < 8; ++j) { const int c = 4 * lane + 256 * j; const f32x4 gg = *(const f32x4*)(g + c);
        const f32x4 y = v[j] * r1 * gg * (*(const f32x4*)(sc1 + c) + 1.f) + *(const f32x4*)(sh1 + c);
        const f32x4 z = u[j] * r2 * gg * (*(const f32x4*)(sc2 + c) + 1.f) + *(const f32x4*)(sh2 + c);
        p1[64 * j] = (unsigned long long)pk2(y.x, y.y) | ((unsigned long long)pk2(y.z, y.w) << 32);
        p2[64 * j] = (unsigned long long)pk2(z.x, z.y) | ((unsigned long long)pk2(z.z, z.w) << 32); }
}
__device__ __forceinline__ void final_norm_row(const float* xrow, float* orow, const float* g, int lane) {
    const GAS f32x4* xr = (const GAS f32x4*)xrow + lane; GAS f32x4* xo = (GAS f32x4*)orow + lane;
    f32x4 v[8]; float s = 0.f;
#pragma unroll
    for (int j = 0; j < 8; ++j) { v[j] = xr[64 * j]; s += (v[j].x * v[j].x + v[j].y * v[j].y) + (v[j].z * v[j].z + v[j].w * v[j].w); }
    const float r = rsqrtf(wave_sum(s) * (1.f / D) + EPS);
#pragma unroll
    for (int j = 0; j < 8; ++j) { const f32x4 gg = *(const f32x4*)(g + 4 * lane + 256 * j); xo[64 * j] = v[j] * r * gg; }
}

typedef short s16x4 __attribute__((ext_vector_type(4)));
typedef short v4i16_t __attribute__((ext_vector_type(4)));
__device__ __forceinline__ s16x4 vtr(const LAS unsigned char* p) { return __builtin_bit_cast(s16x4, __builtin_amdgcn_ds_read_tr16_b64_v4i16((LAS v4i16_t*)p)); }
__device__ __forceinline__ bf16x8 cat8(s16x4 lo, s16x4 hi) { return (bf16x8){lo[0], lo[1], lo[2], lo[3], hi[0], hi[1], hi[2], hi[3]}; }
__device__ __forceinline__ f32x4 mfma16(bf16x8 a, bf16x8 b, f32x4 c) { return __builtin_amdgcn_mfma_f32_16x16x32_bf16(a, b, c, 0, 0, 0); }
__device__ __forceinline__ float ex2(float x) { return __builtin_amdgcn_exp2f(x); }
__device__ __forceinline__ unsigned pk2f(float lo, float hi) { return pg8::cvt_pk_bf16(lo, hi); }
constexpr int RSV = 288;
constexpr int RSK = 160;
__device__ __forceinline__ bf16x8 tr_frag(const LAS unsigned char* tile, int rs, int r0, int cb, int fr, int fq) {
    const LAS unsigned char* p = tile + (r0 + 4 * fq + (fr >> 2)) * rs + cb + 8 * (fr & 3);
    return cat8(vtr(p), vtr(p + 16 * rs));
}

__device__ __forceinline__ void ret_kv_item(Frame& F, const bf16* PROJ, float* KVT, int cc, int h, float lf2, float lb2) {
    const int lane = F.lane, fr = lane & 15, fq = lane >> 4, w = F.wave, tid = F.tid;
    const int row0 = cc < 2 ? L + 128 * cc : 128 * (cc - 2);
    LAS unsigned char* Vl = F.lds; LAS unsigned char* Kf = F.lds + 128 * RSV; LAS unsigned char* Kb = Kf + 128 * RSK;
    __syncthreads();
#pragma unroll
    for (int p = 0; p < 4; ++p) { const int idx = p * 512 + tid, row = idx >> 4, ch = idx & 15;
        const v4u v = *(const GAS v4u*)(PROJ + (size_t)(row0 + row) * NPROJ + C_RV + h * 128 + ch * 8); *(LAS v4u*)(Vl + row * RSV + ch * 16) = v; }
#pragma unroll
    for (int p = 0; p < 2; ++p) { const int idx = p * 512 + tid, row = idx >> 3, ch = idx & 7;
        const v4u v = *(const GAS v4u*)(PROJ + (size_t)(row0 + row) * NPROJ + C_RK + h * 64 + ch * 8);
        const float wf = ex2(lf2 * (float)(127 - row)), wb = ex2(lb2 * (float)row);
        v4u of, ob;
#pragma unroll
        for (int e = 0; e < 4; ++e) { const float lo = __uint_as_float(v[e] << 16), hi = __uint_as_float(v[e] & 0xffff0000u); of[e] = pk2f(lo * wf, hi * wf); ob[e] = pk2f(lo * wb, hi * wb); }
        *(LAS v4u*)(Kf + row * RSK + ch * 16) = of; *(LAS v4u*)(Kb + row * RSK + ch * 16) = ob; }
    __syncthreads();
    bf16x8 aV[4];
#pragma unroll
    for (int st = 0; st < 4; ++st) aV[st] = tr_frag(Vl, RSV, 32 * st, 32 * w, fr, fq);
#pragma unroll
    for (int dir = 0; dir < 2; ++dir) { const LAS unsigned char* Kx = dir ? Kb : Kf;
        float* outp = KVT + (((size_t)dir * 66 + cc) * 8 + h) * 8192 + (16 * w + 4 * fq) * 64 + fr;
#pragma unroll
        for (int dt = 0; dt < 4; ++dt) { f32x4 acc = {0.f, 0.f, 0.f, 0.f};
#pragma unroll
            for (int st = 0; st < 4; ++st) acc = mfma16(aV[st], tr_frag(Kx, RSK, 32 * st, 32 * dt, fr, fq), acc);
#pragma unroll
            for (int r = 0; r < 4; ++r) outp[r * 64 + 16 * dt] = acc[r]; } }
}
__device__ __forceinline__ void ret_scan_phase(Frame& F, const float* KVT, bf16* SPT, const float* ret_decay) {
    const int nthr = F.G * 512;
    for (int e = F.vcu * 512 + F.tid; e < 2 * 8 * 8192; e += nthr) {
        const int dir = e >> 16, h = (e >> 13) & 7, vd = e & 8191;
        const float g = __expf(-128.f * __expf(ret_decay[dir * 8 + h]));
        const float* kv = KVT + ((size_t)dir * 66 * 8 + h) * 8192 + vd;
        bf16* sp = SPT + ((size_t)dir * 64 * 8 + h) * 8192 + vd;
        float S = 0.f;
        if (dir == 0) { S = kv[0]; S = g * S + kv[65536];
#pragma unroll 8
            for (int c = 0; c < 64; ++c) { sp[(size_t)c * 65536] = (bf16)f2bf(S); S = g * S + kv[(size_t)(2 + c) * 65536]; } }
        else { S = kv[65536]; S = g * S + kv[0];
#pragma unroll 8
            for (int c = 63; c >= 0; --c) { sp[(size_t)c * 65536] = (bf16)f2bf(S); S = g * S + kv[(size_t)(2 + c) * 65536]; } }
    }
}
__device__ __forceinline__ void ret_out_item(Frame& F, const bf16* PROJ, const bf16* SPT, bf16* Y, int c, int h, float lf2, float lb2) {
    const int lane = F.lane, fr = lane & 15, fq = lane >> 4, w = F.wave, tid = F.tid;
    const int t0 = c * 128;
    LAS unsigned char* Vl = F.lds;
    __syncthreads();
#pragma unroll
    for (int p = 0; p < 4; ++p) { const int idx = p * 512 + tid, row = idx >> 4, ch = idx & 15;
        const v4u v = *(const GAS v4u*)(PROJ + (size_t)(t0 + row) * NPROJ + C_RV + h * 128 + ch * 8); *(LAS v4u*)(Vl + row * RSV + ch * 16) = v; }
    const int il = 16 * w + fr;
    const bf16* qrow = PROJ + (size_t)(t0 + il) * NPROJ + C_RQ + h * 64 + 8 * fq;
    bf16x8 qB[2]; qB[0] = *(const GAS bf16x8*)(qrow); qB[1] = *(const GAS bf16x8*)(qrow + 32);
    const float wf = ex2(lf2 * (float)(il + 1)), wb = ex2(lb2 * (float)(128 - il));
    const bf16* Sf = SPT + ((size_t)(0 * 64 + c) * 8 + h) * 8192 + fr * 64 + 8 * fq;
    const bf16* Sb = SPT + ((size_t)(1 * 64 + c) * 8 + h) * 8192 + fr * 64 + 8 * fq;
    f32x4 O[8];
#pragma unroll
    for (int vt = 0; vt < 8; ++vt) { f32x4 xf = {0.f, 0.f, 0.f, 0.f}, xb = {0.f, 0.f, 0.f, 0.f};
#pragma unroll
        for (int s = 0; s < 2; ++s) { xf = mfma16(*(const GAS bf16x8*)(Sf + vt * 1024 + 32 * s), qB[s], xf); xb = mfma16(*(const GAS bf16x8*)(Sb + vt * 1024 + 32 * s), qB[s], xb); }
        O[vt] = xf * wf + xb * wb; }
    unsigned pt[8][2];
    const bf16* krow = PROJ + (size_t)(t0 + fr) * NPROJ + C_RK + h * 64 + 8 * fq;
#pragma unroll
    for (int T = 0; T < 8; ++T) { f32x4 st = {0.f, 0.f, 0.f, 0.f};
#pragma unroll
        for (int s = 0; s < 2; ++s) st = mfma16(*(const GAS bf16x8*)(krow + (size_t)(16 * T) * NPROJ + 32 * s), qB[s], st);
#pragma unroll
        for (int r = 0; r < 4; ++r) { const int diff = il - (16 * T + 4 * fq + r); st[r] *= diff >= 0 ? ex2(lf2 * (float)diff) : ex2(lb2 * (float)(-diff)); }
        pt[T][0] = pk2f(st[0], st[1]); pt[T][1] = pk2f(st[2], st[3]); }
    __syncthreads();
#pragma unroll
    for (int st = 0; st < 4; ++st) { const v4u pw = {pt[2 * st][0], pt[2 * st][1], pt[2 * st + 1][0], pt[2 * st + 1][1]}; const bf16x8 pb = __builtin_bit_cast(bf16x8, pw);
#pragma unroll
        for (int vt = 0; vt < 8; ++vt) O[vt] = mfma16(tr_frag(Vl, RSV, 32 * st, 32 * vt, fr, fq), pb, O[vt]); }
    float ss = 0.f;
#pragma unroll
    for (int vt = 0; vt < 8; ++vt) ss += (O[vt][0] * O[vt][0] + O[vt][1] * O[vt][1]) + (O[vt][2] * O[vt][2] + O[vt][3] * O[vt][3]);
    ss += __shfl_xor(ss, 16); ss += __shfl_xor(ss, 32);
    const float r = rsqrtf(ss * (1.f / 128.f) + EPS);
    const bf16* grow = PROJ + (size_t)(t0 + il) * NPROJ + C_RG + h * 128 + 4 * fq;
    bf16* yrow = Y + (size_t)(t0 + il) * D + h * 128 + 4 * fq;
#pragma unroll
    for (int vt = 0; vt < 8; ++vt) { const unsigned long long gw = *(const GAS unsigned long long*)(grow + 16 * vt); const unsigned g0 = (unsigned)gw, g1 = (unsigned)(gw >> 32);
        const float y0 = O[vt][0] * r * __uint_as_float(g0 << 16), y1 = O[vt][1] * r * __uint_as_float(g0 & 0xffff0000u), y2 = O[vt][2] * r * __uint_as_float(g1 << 16), y3 = O[vt][3] * r * __uint_as_float(g1 & 0xffff0000u);
        *(GAS unsigned long long*)(yrow + 16 * vt) = (unsigned long long)pk2f(y0, y1) | ((unsigned long long)pk2f(y2, y3) << 32); }
}
constexpr int ATT_ROWS = 640;
__device__ __forceinline__ void attn_item(Frame& F, const bf16* PROJ, const float* sink, bf16* Y, int b, int kvh) {
    const int lane = F.lane, fr = lane & 15, fq = lane >> 4, w = F.wave, tid = F.tid;
    LAS unsigned char* Vl = F.lds;
    __syncthreads();
#pragma unroll
    for (int p = 0; p < 10; ++p) { const int idx = p * 512 + tid, row = idx >> 3, ch = idx & 7;
        int src; bool ok = true;
        if (row < 384) { const int key = 128 * b - 128 + row; ok = key >= 0 && key < L; src = ok ? key : 0; } else src = L + (row - 384);
        v4u v = *(const GAS v4u*)(PROJ + (size_t)src * NPROJ + C_AV + kvh * 64 + ch * 8);
        if (!ok) v = (v4u){0u, 0u, 0u, 0u};
        *(LAS v4u*)(Vl + row * RSK + ch * 16) = v; }
    const int iq = 128 * b + 16 * w + fr;
    bf16x8 qB[4][2]; float m[4], l[4]; f32x4 O[4][4];
#pragma unroll
    for (int g = 0; g < 4; ++g) { const bf16* qrow = PROJ + (size_t)iq * NPROJ + C_AQ + (4 * kvh + g) * 64 + 8 * fq;
        qB[g][0] = *(const GAS bf16x8*)(qrow); qB[g][1] = *(const GAS bf16x8*)(qrow + 32);
        m[g] = sink[4 * kvh + g] * LOG2E; l[g] = fq == 0 ? 1.f : 0.f;
#pragma unroll
        for (int dt = 0; dt < 4; ++dt) O[g][dt] = (f32x4){0.f, 0.f, 0.f, 0.f}; }
    __syncthreads();
    const bf16* kbase = PROJ + C_AK + kvh * 64 + 8 * fq;
#define ATT_KLOAD(dst, stp) do { const bool il_ = (stp) < 9; const int lr_ = il_ ? 32 * ((w >> 1) + (stp)) : 384 + 32 * ((stp) - 9); \
        _Pragma("unroll") for (int tt = 0; tt < 2; ++tt) { int kr; \
            if (il_) { kr = 128 * b - 128 + lr_ + 16 * tt + fr; kr = kr < 0 ? 0 : (kr > L - 1 ? L - 1 : kr); } else kr = L + (lr_ - 384) + 16 * tt + fr; \
            const bf16* kp = kbase + (size_t)kr * NPROJ; dst[tt][0] = *(const GAS bf16x8*)(kp); dst[tt][1] = *(const GAS bf16x8*)(kp + 32); } } while (0)
    bf16x8 kA[2][2], kN[2][2];
    ATT_KLOAD(kA, 0);
    for (int step = 0; step < 17; ++step) {
        const bool isloc = step < 9;
        const int ldsrow0 = isloc ? 32 * ((w >> 1) + step) : 384 + 32 * (step - 9);
        const int key0 = 128 * b - 128 + ldsrow0;
        { const int nstep = step < 16 ? step + 1 : 16; ATT_KLOAD(kN, nstep); }
        bf16x8 vA[4];
#pragma unroll
        for (int dt = 0; dt < 4; ++dt) vA[dt] = tr_frag(Vl, RSK, ldsrow0, 32 * dt, fr, fq);
#pragma unroll
        for (int g = 0; g < 4; ++g) {
            f32x4 s0 = {0.f, 0.f, 0.f, 0.f}, s1 = {0.f, 0.f, 0.f, 0.f};
            s0 = mfma16(kA[0][0], qB[g][0], s0); s0 = mfma16(kA[0][1], qB[g][1], s0);
            s1 = mfma16(kA[1][0], qB[g][0], s1); s1 = mfma16(kA[1][1], qB[g][1], s1);
            if (isloc) {
#pragma unroll
                for (int r = 0; r < 4; ++r) { const int k0 = key0 + 4 * fq + r, k1 = k0 + 16; const int d0 = iq - k0, d1 = iq - k1;
                    if (!(k0 >= 0 && k0 < L && d0 <= WIN && d0 >= -WIN)) s0[r] = -INFINITY;
                    if (!(k1 >= 0 && k1 < L && d1 <= WIN && d1 >= -WIN)) s1[r] = -INFINITY; } }
            float mx = fmaxf(fmaxf(fmaxf(s0[0], s0[1]), fmaxf(s0[2], s0[3])), fmaxf(fmaxf(s1[0], s1[1]), fmaxf(s1[2], s1[3])));
            mx = fmaxf(mx, __shfl_xor(mx, 16)); mx = fmaxf(mx, __shfl_xor(mx, 32));
            const float mn = fmaxf(m[g], mx), alpha = ex2(m[g] - mn); m[g] = mn;
            float ps = 0.f;
#pragma unroll
            for (int r = 0; r < 4; ++r) { s0[r] = ex2(s0[r] - mn); s1[r] = ex2(s1[r] - mn); ps += s0[r] + s1[r]; }
            l[g] = l[g] * alpha + ps;
            const v4u pw = {pk2f(s0[0], s0[1]), pk2f(s0[2], s0[3]), pk2f(s1[0], s1[1]), pk2f(s1[2], s1[3])}; const bf16x8 pb = __builtin_bit_cast(bf16x8, pw);
#pragma unroll
            for (int dt = 0; dt < 4; ++dt) { O[g][dt] *= alpha; O[g][dt] = mfma16(vA[dt], pb, O[g][dt]); }
        }
#pragma unroll
        for (int tt = 0; tt < 2; ++tt) { kA[tt][0] = kN[tt][0]; kA[tt][1] = kN[tt][1]; }
    }
#undef ATT_KLOAD
#pragma unroll
    for (int g = 0; g < 4; ++g) { float lt = l[g]; lt += __shfl_xor(lt, 16); lt += __shfl_xor(lt, 32); const float inv = 1.f / lt;
        bf16* yrow = Y + (size_t)iq * D + 1024 + (4 * kvh + g) * 64 + 4 * fq;
#pragma unroll
        for (int dt = 0; dt < 4; ++dt) *(GAS unsigned long long*)(yrow + 16 * dt) = (unsigned long long)pk2f(O[g][dt][0] * inv, O[g][dt][1] * inv) | ((unsigned long long)pk2f(O[g][dt][2] * inv, O[g][dt][3] * inv) << 32); }
}
__global__ void __launch_bounds__(NWAVES * 64, 2) mk_fwd(Args args) {
    extern __shared__ __attribute__((aligned(16))) unsigned char lds[];
    Frame F;
    F.lds = (LAS unsigned char*)lds;
    F.MISC = (volatile LAS unsigned*)(F.lds + MISC_OFF);
    F.tid = threadIdx.x; F.lane = F.tid & 63; F.wave = __builtin_amdgcn_readfirstlane(F.tid >> 6);
    F.G = gridDim.x; { const int bx = blockIdx.x; F.vcu = (F.G % 8 == 0) ? (bx % 8) * (F.G / 8) + bx / 8 : bx; }
    unsigned char* ws = args.ws;
    F.ctl = (gu32*)(ws + WS_CTL);
    for (int u = F.tid; u < (LDS_BYTES - LDSCTL_OFF) / 4; u += NWAVES * 64) ((LAS unsigned*)(F.lds + LDSCTL_OFF))[u] = 0u;
    __syncthreads();
    XcdBarrier bar = xcd_barrier_post((unsigned*)(F.ctl + CW_BAR) + args.li * XCD_BAR_WORDS, F.MISC + 8);
    const int lo = args.ph_lo, hi = args.ph_hi;
#define IN(k) (lo <= (k) && (k) < hi)
#define BOTH(k) (IN(k) && IN((k) + 1))
#define REP(k) for (int rep_ = 0; rep_ < 1 + ((PROBE_DBL >> (k)) & 1); ++rep_)
#define DUMMY(k) (((PROBE_DBL >> (k)) & 1) && rep_ == 0)
    const float* mod = (const float*)(ws + WS_MODACC);
    bf16* HX = (bf16*)(ws + WS_HX); bf16* PROJ = (bf16*)(ws + WS_PROJ); bf16* Y = (bf16*)(ws + WS_Y); bf16* ACT = (bf16*)(ws + WS_ACT);
    const int gw = F.vcu * NWAVES + F.wave, NGW = F.G * NWAVES;

    if (IN(0)) REP(0) { p0_prologue(F, args, rep_ == 0); if (BOTH(0)) xcd_barrier(bar); }
    if (IN(1)) REP(1) {
        for (int m = gw; m < MROWS; m += 2 * NGW) {
            const int m2 = m + NGW < MROWS ? m + NGW : m;
            const float* src = m < L ? args.in[0] + (size_t)m * D : args.in[2] + (size_t)(m - L) * D; const float* mb = m < L ? mod : mod + 6 * D;
            const float* src2 = m2 < L ? args.in[0] + (size_t)m2 * D : args.in[2] + (size_t)(m2 - L) * D; const float* mb2 = m2 < L ? mod : mod + 6 * D;
            modulate_row2(src, src2, args.in[6], mb, mb + D, mb2, mb2 + D, HX + (size_t)m * D, HX + (size_t)m2 * D, F.lane); }
        if (BOTH(1)) xcd_barrier(bar);
    }
    if (IN(2)) REP(2) {
        pg8::Gemm g{HX, (const bf16*)(ws + WS_WIN), MROWS, NPROJ, D}; pg8::StaticOrder S; S.init(MROWS, NPROJ, F.G, (int)blockIdx.x);
        pg8::EpiProj E{PROJ, (const float*)(ws + WS_RT), (const float*)(ws + WS_RT + MiB), (const float*)(ws + WS_AXT), (const float*)(ws + WS_AXT + 8192)};
        pg8::gemm_phase<pg8::EpiProj, pg8::StaticOrder, true, true>(F.lds + RING_OFF, g, S, E);
        if (BOTH(2)) xcd_barrier(bar);
    }
    if (IN(3)) REP(3) {
        const float* rd = args.in[9];
        for (int it = F.vcu; it < 256; it += F.G) attn_item(F, PROJ, args.in[10], Y, it >> 2, it & 3);
        for (int it = F.vcu; it < 528; it += F.G) { const int cc = it >> 3, h = it & 7;
            ret_kv_item(F, PROJ, (float*)(ws + WS_KVT), cc, h, -__expf(rd[h]) * LOG2E, -__expf(rd[8 + h]) * LOG2E); }
        if (BOTH(3)) xcd_barrier(bar);
    }
    if (IN(4)) REP(4) { ret_scan_phase(F, (const float*)(ws + WS_KVT), (bf16*)(ws + WS_SPT), args.in[9]); if (BOTH(4)) xcd_barrier(bar); }
    if (IN(5)) REP(5) {
        const float* rd = args.in[9];
        for (int it = F.vcu; it < 512; it += F.G) { const int c = it >> 3, h = it & 7;
            ret_out_item(F, PROJ, (const bf16*)(ws + WS_SPT), Y, c, h, -__expf(rd[h]) * LOG2E, -__expf(rd[8 + h]) * LOG2E); }
        if (BOTH(5)) xcd_barrier(bar);
    }
    if (IN(6)) REP(6) {
        pg8::Gemm g{Y, (const bf16*)(ws + WS_WOUT), L, D, D}; pg8::StaticOrder S; S.init(L, D, F.G, (int)blockIdx.x);
        pg8::EpiResid E{args.in[0], args.out, mod + 2 * D, D};
        pg8::gemm_phase<pg8::EpiResid, pg8::StaticOrder, true, true>(F.lds + RING_OFF, g, S, E);
        if (BOTH(6)) xcd_barrier(bar);
    }
    if (IN(7)) REP(7) {
        for (int m = gw; m < L; m += 2 * NGW) { const int m2 = m + NGW < L ? m + NGW : m;
            modulate_row2(args.out + (size_t)m * D, args.out + (size_t)m2 * D, args.in[7], mod + 3 * D, mod + 4 * D, mod + 3 * D, mod + 4 * D, HX + (size_t)m * D, HX + (size_t)m2 * D, F.lane); }
        if (BOTH(7)) xcd_barrier(bar);
    }
    if (IN(8)) REP(8) {
        pg8::Gemm g{HX, (const bf16*)(ws + WS_WGU), L, 2 * DFF, D}; pg8::StaticOrder S; S.init(L, 2 * DFF, F.G, (int)blockIdx.x);
        pg8::EpiSwiglu E{ACT, DFF};
        pg8::gemm_phase<pg8::EpiSwiglu, pg8::StaticOrder, true, true>(F.lds + RING_OFF, g, S, E);
        if (BOTH(8)) xcd_barrier(bar);
    }
    if (IN(9)) REP(9) {
        pg8::Gemm g{ACT, (const bf16*)(ws + WS_WDN), L, D, DFF}; pg8::StaticOrder S; S.init(L, D, F.G, (int)blockIdx.x);
        pg8::EpiResid E{args.out, DUMMY(9) ? (float*)(ws + WS_PROJ) : args.out, mod + 5 * D, D};
        pg8::gemm_phase<pg8::EpiResid, pg8::StaticOrder, true, true>(F.lds + RING_OFF, g, S, E);
        if (BOTH(9)) xcd_barrier(bar);
    }
    if (IN(10)) REP(10) { float* dst = DUMMY(10) ? (float*)(ws + WS_PROJ) : args.out; for (int m = gw; m < L; m += NGW) final_norm_row(args.out + (size_t)m * D, dst + (size_t)m * D, args.in[15], F.lane); }
#undef IN
#undef REP
#undef DUMMY
#undef BOTH
}

extern "C" void kernel_launch(void* const* d_in, const int* in_sizes, int n_in, void* d_out, int out_size, void* d_ws, size_t ws_size, hipStream_t stream) {
    static int grid = 0;
    if (grid == 0) {
        if (n_in != 16 || in_sizes[0] != L * D || out_size != L * D || ws_size < WS_END) { fprintf(stderr, "kernel_launch: unexpected shapes (n_in %d, in0 %d, out %d, ws %zu)\n", n_in, n_in > 0 ? in_sizes[0] : -1, out_size, ws_size); grid = -1; return; }
        int dev = 0, cus = 0, per_cu = 0;
        if (hipGetDevice(&dev) != hipSuccess || hipDeviceGetAttribute(&cus, hipDeviceAttributeMultiprocessorCount, dev) != hipSuccess) { grid = -1; return; }
        if (hipFuncSetAttribute((const void*)mk_fwd, hipFuncAttributeMaxDynamicSharedMemorySize, LDS_BYTES) != hipSuccess) { fprintf(stderr, "kernel_launch: hipFuncSetAttribute failed\n"); grid = -1; return; }
        if (hipOccupancyMaxActiveBlocksPerMultiprocessor(&per_cu, (const void*)mk_fwd, NWAVES * 64, LDS_BYTES) != hipSuccess || per_cu < 1) { fprintf(stderr, "kernel_launch: occupancy query says %d blocks per CU\n", per_cu); grid = -1; (void)hipGetLastError(); return; }
        (void)hipGetLastError();
        grid = cus;
    }
    if (grid < 0) return;
    unsigned char* ws = (unsigned char*)d_ws;
    hipMemsetAsync(ws + WS_CTL, 0, CTL_BYTES, stream);
    Args a{};
    for (int i = 0; i < 16; ++i) a.in[i] = (const float*)d_in[i];
    a.out = (float*)d_out; a.ws = ws;
    a.ph_lo = 0; a.ph_hi = 11; a.li = 0;
    hipLaunchKernelGGL(mk_fwd, dim3(grid), dim3(NWAVES * 64), LDS_BYTES, stream, a);
}
```

```cpp
#ifndef PROBE_DBL
#define PROBE_DBL 0
#endif
#include <hip/hip_runtime.h>
#include <cstdio>
#include <cstdint>
#include <cmath>

typedef unsigned short bf16;
typedef unsigned u32x4 __attribute__((ext_vector_type(4)));
typedef float f32x4 __attribute__((ext_vector_type(4)));

constexpr int D = 2048, L = 8192, LC = 256, MROWS = L + LC;
constexpr int NPROJ = 4608, DFF = 5632;
constexpr int RH = 8, RDK = 64, RDV = 128, CH = 128, NCH = L / CH;
constexpr int AH = 16, AKV = 4, ADH = 64, WIN = 128;
constexpr float EPS = 1e-6f;
constexpr float LOG2E = 1.4426950408889634f;
constexpr int C_RQ = 0, C_RK = 512, C_RV = 1024, C_RG = 2048, C_AQ = 3072, C_AK = 4096, C_AV = 4352;

constexpr size_t MiB = 1u << 20;
constexpr size_t WS_CTL = 0, CTL_BYTES = 1 * MiB;
constexpr size_t WS_MOD = 1 * MiB;
constexpr size_t WS_HX = 100 * MiB;
constexpr size_t WS_PROJ = 134 * MiB;
constexpr size_t WS_Y = 209 * MiB;
constexpr size_t WS_ACT = 290 * MiB;
constexpr size_t WS_TMP = 209 * MiB;
constexpr size_t WS_OFB = 290 * MiB;
constexpr size_t WS_END = 384 * MiB;

__device__ __forceinline__ float bf2f(bf16 v) { return __uint_as_float((unsigned)v << 16); }
__device__ __forceinline__ bf16 f2bf_n(float f) { unsigned u = __float_as_uint(f); return (bf16)((u + 0x7fffu + ((u >> 16) & 1u)) >> 16); }
__device__ __forceinline__ float silu_f(float x) { return x / (1.f + __expf(-x)); }

__global__ __launch_bounds__(256) void nv_mod(const float* c, const float* cctx, const float* w_mod, const float* b_mod, float* mod) {
    __shared__ float s[2][D];
    for (int i = threadIdx.x; i < D; i += 256) { s[0][i] = silu_f(c[i]); s[1][i] = silu_f(cctx[i]); }
    __syncthreads();
    const int n = blockIdx.x * 256 + threadIdx.x;
    float a0 = 0.f, a1 = 0.f;
    for (int k = 0; k < D; ++k) { const float w = w_mod[(size_t)k * (6 * D) + n]; a0 += s[0][k] * w; a1 += s[1][k] * w; }
    mod[n] = a0 + b_mod[n]; mod[6 * D + n] = a1 + b_mod[n];
}
__global__ __launch_bounds__(256) void nv_modulate(const float* src, const float* g, const float* shift, const float* scale, bf16* out) {
    __shared__ float red[4];
    const int row = blockIdx.x; const float* x = src + (size_t)row * D;
    float v[8]; float ss = 0.f;
#pragma unroll
    for (int i = 0; i < 8; ++i) { v[i] = x[threadIdx.x + 256 * i]; ss += v[i] * v[i]; }
#pragma unroll
    for (int o = 1; o < 64; o <<= 1) ss += __shfl_xor(ss, o);
    if ((threadIdx.x & 63) == 0) red[threadIdx.x >> 6] = ss;
    __syncthreads();
    const float r = rsqrtf((red[0] + red[1] + red[2] + red[3]) * (1.f / D) + EPS);
#pragma unroll
    for (int i = 0; i < 8; ++i) { const int cidx = threadIdx.x + 256 * i; out[(size_t)row * D + cidx] = f2bf_n(v[i] * r * g[cidx] * (1.f + scale[cidx]) + shift[cidx]); }
}
template <int MODE> __global__ __launch_bounds__(256) void nv_gemm(const bf16* A, int lda, const float* B, const float* B2, int ldb, int K,
                                                                     float* Cf, bf16* Cb, int ldc, const float* R, const float* gate) {
    __shared__ float As[16][132]; __shared__ float Bs[16][64]; __shared__ float Bs2[16][64];
    const int tid = threadIdx.x, tx = tid & 15, ty = tid >> 4;
    const int m0 = blockIdx.y * 128, n0 = blockIdx.x * 64;
    float acc[8][4], acc2[8][4];
#pragma unroll
    for (int i = 0; i < 8; ++i)
#pragma unroll
        for (int j = 0; j < 4; ++j) { acc[i][j] = 0.f; acc2[i][j] = 0.f; }
    const int arow = tid >> 1, akh = (tid & 1) * 8, bk = tid >> 4, bn4 = (tid & 15) * 4;
    for (int k0 = 0; k0 < K; k0 += 16) {
        const u32x4 av = *(const u32x4*)(A + (size_t)(m0 + arow) * lda + k0 + akh);
        const f32x4 bv = *(const f32x4*)(B + (size_t)(k0 + bk) * ldb + n0 + bn4);
        f32x4 bv2 = bv; if (MODE == 1) bv2 = *(const f32x4*)(B2 + (size_t)(k0 + bk) * ldb + n0 + bn4);
#pragma unroll
        for (int i = 0; i < 4; ++i) { As[akh + 2 * i][arow] = __uint_as_float(av[i] << 16); As[akh + 2 * i + 1][arow] = __uint_as_float(av[i] & 0xffff0000u); }
        *(f32x4*)&Bs[bk][bn4] = bv; if (MODE == 1) *(f32x4*)&Bs2[bk][bn4] = bv2;
        __syncthreads();
#pragma unroll
        for (int k = 0; k < 16; ++k) {
            float a[8], b[4], b2[4];
#pragma unroll
            for (int i = 0; i < 8; ++i) a[i] = As[k][ty * 8 + i];
#pragma unroll
            for (int j = 0; j < 4; ++j) { b[j] = Bs[k][tx * 4 + j]; b2[j] = (MODE == 1) ? Bs2[k][tx * 4 + j] : 0.f; }
#pragma unroll
            for (int i = 0; i < 8; ++i)
#pragma unroll
                for (int j = 0; j < 4; ++j) { acc[i][j] += a[i] * b[j]; if (MODE == 1) acc2[i][j] += a[i] * b2[j]; }
        }
        __syncthreads();
    }
#pragma unroll
    for (int i = 0; i < 8; ++i)
#pragma unroll
        for (int j = 0; j < 4; ++j) {
            const size_t r = m0 + ty * 8 + i; const int cidx = n0 + tx * 4 + j;
            if (MODE == 0) Cf[r * ldc + cidx] = acc[i][j];
            if (MODE == 1) Cb[r * ldc + cidx] = f2bf_n(silu_f(acc[i][j]) * acc2[i][j]);
            if (MODE == 2) Cf[r * ldc + cidx] = R[r * ldc + cidx] + gate[cidx] * acc[i][j];
        }
}
__global__ __launch_bounds__(256) void nv_proj_epi(const float* tmp, bf16* proj) {
    const size_t idx = (size_t)blockIdx.x * 256 + threadIdx.x;
    const int row = (int)(idx / NPROJ), col = (int)(idx % NPROJ);
    const bool isctx = row >= L; const int t = row;
    const float* tr = tmp + (size_t)row * NPROJ;
    const float v = tr[col]; float o = v;
    if (col < C_RV) {
        if (!isctx) {
            const int d = col & 63, j = d & 31;
            const float inv = powf(10000.f, -(float)j / 32.f), ang = (float)t * inv; float sn, cs; sincosf(ang, &sn, &cs);
            if (d < 32) o = v * cs - tr[col + 32] * sn; else o = tr[col - 32] * sn + v * cs;
        }
        if (col >= C_RK) o *= 0.125f;
    } else if (col < C_RG) {
    } else if (col < C_AQ) { o = silu_f(v);
    } else if (col < C_AV) {
        if (!isctx) {
            const int d = (col - C_AQ) & 63, hf = d >> 5, dd = d & 31, j = dd & 15;
            const int pos = hf == 0 ? (t >> 6) : (t & 63);
            const float inv = powf(10000.f, -(float)j / 16.f), ang = (float)pos * inv; float sn, cs; sincosf(ang, &sn, &cs);
            if (dd < 16) o = v * cs - tr[col + 16] * sn; else o = tr[col - 16] * sn + v * cs;
        }
        if (col < C_AK) o *= 0.125f * LOG2E;
    }
    proj[idx] = f2bf_n(o);
}
__global__ __launch_bounds__(128) void nv_ret_scan(const bf16* proj, const float* ret_decay, float* ofb) {
    const int h = blockIdx.x & 7, dir = blockIdx.x >> 3, v = threadIdx.x;
    const float gam = __expf(-__expf(ret_decay[dir * RH + h]));
    float S[64];
#pragma unroll
    for (int d = 0; d < 64; ++d) S[d] = 0.f;
    float* out = ofb + (size_t)dir * L * 1024 + h * 128 + v;
    for (int step = 0; step < LC + L; ++step) {
        int row; bool lat;
        if (dir == 0) { lat = step >= LC; row = lat ? step - LC : L + step; }
        else { lat = step >= LC; row = lat ? (L - 1 - (step - LC)) : (L + LC - 1 - step); }
        const bf16* pr = proj + (size_t)row * NPROJ;
        const float vv = bf2f(pr[C_RV + h * 128 + v]);
        float kf[64], qf[64];
#pragma unroll
        for (int i = 0; i < 8; ++i) { const u32x4 kk = *(const u32x4*)(pr + C_RK + h * 64 + i * 8); const u32x4 qq = *(const u32x4*)(pr + C_RQ + h * 64 + i * 8);
#pragma unroll
            for (int e = 0; e < 4; ++e) { kf[i * 8 + 2 * e] = __uint_as_float(kk[e] << 16); kf[i * 8 + 2 * e + 1] = __uint_as_float(kk[e] & 0xffff0000u);
                                          qf[i * 8 + 2 * e] = __uint_as_float(qq[e] << 16); qf[i * 8 + 2 * e + 1] = __uint_as_float(qq[e] & 0xffff0000u); } }
        if (dir == 0) {
            float o = 0.f;
#pragma unroll
            for (int d = 0; d < 64; ++d) { S[d] = gam * S[d] + kf[d] * vv; o += qf[d] * S[d]; }
            if (lat) out[(size_t)row * 1024] = o;
        } else {
            float o = 0.f;
#pragma unroll
            for (int d = 0; d < 64; ++d) { o += qf[d] * S[d]; S[d] = gam * S[d] + kf[d] * vv; }
            if (lat) out[(size_t)row * 1024] = gam * o;
        }
    }
}
__global__ __launch_bounds__(128) void nv_ret_out(const float* ofb, const bf16* proj, bf16* Y) {
    __shared__ float red[2];
    const int t = blockIdx.x >> 3, h = blockIdx.x & 7, v = threadIdx.x;
    const size_t i = (size_t)t * 1024 + h * 128 + v;
    const float o = ofb[i] + ofb[(size_t)L * 1024 + i];
    float ss = o * o;
#pragma unroll
    for (int k = 1; k < 64; k <<= 1) ss += __shfl_xor(ss, k);
    if ((v & 63) == 0) red[v >> 6] = ss;
    __syncthreads();
    const float r = rsqrtf((red[0] + red[1]) * (1.f / 128.f) + EPS);
    Y[(size_t)t * D + h * 128 + v] = f2bf_n(o * r * bf2f(proj[(size_t)t * NPROJ + C_RG + h * 128 + v]));
}
__global__ __launch_bounds__(64) void nv_attn(const bf16* proj, const float* sink, bf16* Y) {
    const int idx = blockIdx.x * 64 + threadIdx.x; const int hq = idx / L, t = idx % L, kvh = hq >> 2;
    float q[64], acc[64];
    const bf16* qp = proj + (size_t)t * NPROJ + C_AQ + hq * 64;
#pragma unroll
    for (int d = 0; d < 64; ++d) { q[d] = bf2f(qp[d]); acc[d] = 0.f; }
    float m = sink[hq] * LOG2E, l = 1.f;
    const int lo = t - WIN < 0 ? 0 : t - WIN, hi = t + WIN > L - 1 ? L - 1 : t + WIN;
    const int nloc = hi - lo + 1;
    for (int s = 0; s < nloc + LC; ++s) {
        const int row = s < nloc ? lo + s : L + (s - nloc);
        const bf16* kp = proj + (size_t)row * NPROJ + C_AK + kvh * 64; const bf16* vp = proj + (size_t)row * NPROJ + C_AV + kvh * 64;
        float sc = 0.f;
#pragma unroll
        for (int d = 0; d < 64; ++d) sc += q[d] * bf2f(kp[d]);
        float p;
        if (sc > m) { const float f = exp2f(m - sc); l *= f;
#pragma unroll
            for (int d = 0; d < 64; ++d) acc[d] *= f;
            m = sc; p = 1.f; }
        else p = exp2f(sc - m);
        l += p;
#pragma unroll
        for (int d = 0; d < 64; ++d) acc[d] += p * bf2f(vp[d]);
    }
    const float rl = 1.f / l;
    bf16* yp = Y + (size_t)t * D + 1024 + hq * 64;
#pragma unroll
    for (int d = 0; d < 64; ++d) yp[d] = f2bf_n(acc[d] * rl);
}
__global__ __launch_bounds__(256) void nv_final_norm(float* xio, const float* g) {
    __shared__ float red[4];
    float* x = xio + (size_t)blockIdx.x * D;
    float v[8]; float ss = 0.f;
#pragma unroll
    for (int i = 0; i < 8; ++i) { v[i] = x[threadIdx.x + 256 * i]; ss += v[i] * v[i]; }
#pragma unroll
    for (int o = 1; o < 64; o <<= 1) ss += __shfl_xor(ss, o);
    if ((threadIdx.x & 63) == 0) red[threadIdx.x >> 6] = ss;
    __syncthreads();
    const float r = rsqrtf((red[0] + red[1] + red[2] + red[3]) * (1.f / D) + EPS);
#pragma unroll
    for (int i = 0; i < 8; ++i) { const int c = threadIdx.x + 256 * i; x[c] = v[i] * r * g[c]; }
}

namespace pg8 {
#define PG8_LAS __attribute__((address_space(3)))
typedef unsigned short bf16_t;
typedef short bf16x8 __attribute__((ext_vector_type(8)));
typedef float f32x4 __attribute__((ext_vector_type(4)));
typedef unsigned u32x4 __attribute__((ext_vector_type(4)));
constexpr int BM = 256, BK = 64, HALF = 128, HTB = HALF * BK * 2  , STAGE_BYTES = 8 * HTB, NXCD = 8, WGM = 8;

__host__ __device__ __forceinline__ int lds_byte(int r, int c) { const int st = (r >> 4) * 2 + (c >> 5), rr = r & 15, cc = c & 31, ob = rr * 64 + cc * 2; return st * 1024 + (ob ^ (((ob >> 9) & 1) << 5)); }
__host__ __device__ __forceinline__ void stage_rc(int b, int& R, int& C) { const int st = b / 1024, sb = b % 1024, swz = sb ^ (((sb >> 9) & 1) << 5); R = (st >> 1) * 16 + swz / 64; C = (st & 1) * 32 + (swz % 64) / 2; }
__host__ __device__ __forceinline__ int perm32(int rho) { const int n = rho >> 4, i = rho & 15; return 8 * (i >> 2) + 4 * n + (i & 3); }

struct Unit { int pm, pn; };
struct Gemm { const bf16_t* A; const bf16_t* Bt; int M, N, K; };

struct StaticOrder {
    int nM, nN, nwg, G, c;
    __host__ __device__ void init(int M, int N, int G_, int c_) { nM = M / BM; nN = N / BM; nwg = nM * nN; G = G_; c = c_; }
    __host__ __device__ bool next(int i, Unit& u) const {
        const long L = (long)i * G + c; if (L >= nwg) return false;
        int wgid = (int)L; { const int q = nwg / NXCD, r = nwg % NXCD, xcd = wgid % NXCD, off = wgid / NXCD; wgid = (xcd < r ? xcd * (q + 1) : r * (q + 1) + (xcd - r) * q) + off; }
        const int nig = WGM * nN, gid = wgid / nig, fm = gid * WGM, gsz = (nM - fm) < WGM ? (nM - fm) : WGM;
        u.pm = fm + ((wgid % nig) % gsz); u.pn = (wgid % nig) / gsz; return true;
    }
    __device__ __forceinline__ void a_ready(const Unit&) const {}
    __device__ __forceinline__ void done(const Unit&) const {}
};
__device__ __forceinline__ unsigned cvt_pk_bf16(float lo, float hi) { unsigned r; asm volatile("v_cvt_pk_bf16_f32 %0, %1, %2" : "=v"(r) : "v"(lo), "v"(hi)); return r; }
typedef float f32x2 __attribute__((ext_vector_type(2)));
template <class Epi, class Sched, bool ALIGN_EPI = false, bool SP2 = false>
__device__ __forceinline__ void gemm_phase(PG8_LAS unsigned char* lds, const Gemm g, const Sched& S, const Epi& E) {
    const int tid = threadIdx.x, wid = __builtin_amdgcn_readfirstlane(tid >> 6), lane = tid & 63, wr = wid >> 2, wc = wid & 3, fr = lane & 15, fq = lane >> 4;
    const int K = g.K, nt = K / BK;
    unsigned voffA[2], voffB[2];
#pragma unroll
    for (int i = 0; i < 2; ++i) { int R, C; stage_rc(tid * 16 + i * 8192, R, C); const int Rb = Epi::PERM ? ((R & ~31) + perm32(R & 31)) : R;
        voffA[i] = (unsigned)(R * K + C) * 2u; voffB[i] = (unsigned)(Rb * K + C) * 2u; }
    const size_t kstep = (size_t)(BK * 2);
    const size_t hstep = (size_t)HALF * K * 2;
    const size_t tstep = 2 * hstep;
    const unsigned ldsw = (unsigned)wid * 1024u;
    const int aoff = lds_byte(wr * 64 + fr, fq * 8), boff = lds_byte(wc * 32 + fr, fq * 8);
#define PG8_SA(b, h) (((b) * 2 + (h)) * HTB)
#define PG8_SB(b, h) ((4 + (b) * 2 + (h)) * HTB)
#define PG8_STAGE(bufoff, gbase, voff) do { _Pragma("unroll") for (int _i = 0; _i < 2; ++_i) \
        __builtin_amdgcn_global_load_lds((const unsigned*)((const char*)(gbase) + (voff)[_i]), (PG8_LAS unsigned*)(lds + (bufoff) + ldsw + _i * 8192), 16, 0, 0); } while (0)
#define PG8_LDA(dst, b, h) do { _Pragma("unroll") for (int m = 0; m < 4; ++m) _Pragma("unroll") for (int k = 0; k < 2; ++k) dst[m][k] = *(const PG8_LAS bf16x8*)(lds + PG8_SA(b, h) + aoff + m * 2048 + k * 1024); } while (0)
#define PG8_LDB(dst, b, h) do { _Pragma("unroll") for (int n = 0; n < 2; ++n) _Pragma("unroll") for (int k = 0; k < 2; ++k) dst[n][k] = *(const PG8_LAS bf16x8*)(lds + PG8_SB(b, h) + boff + n * 2048 + k * 1024); } while (0)
#define PG8_MMA(ai, bj, At, Bt) do { __builtin_amdgcn_s_setprio(1); _Pragma("unroll") for (int m = 0; m < 4; ++m) _Pragma("unroll") for (int n = 0; n < 2; ++n) _Pragma("unroll") for (int k = 0; k < 2; ++k) \
        acc[ai][bj][m][n] = __builtin_amdgcn_mfma_f32_16x16x32_bf16(Bt[n][k], At[m][k], acc[ai][bj][m][n], 0, 0, 0); __builtin_amdgcn_s_setprio(0); } while (0)
#define PG8_WAIT_V(n) asm volatile("s_waitcnt vmcnt(" #n ")" ::: "memory")
#define PG8_WAIT_L(n) asm volatile("s_waitcnt lgkmcnt(" #n ")" ::: "memory")
#define PG8_BAR __builtin_amdgcn_s_barrier()
#define PG8_SCHED __builtin_amdgcn_sched_barrier(0)
    Unit cur, nxt; int ui = 0;
    if (!S.next(0, cur)) return;
    f32x4 acc[2][2][4][2];
#pragma unroll
    for (int a = 0; a < 2; ++a)
#pragma unroll
        for (int b = 0; b < 2; ++b)
#pragma unroll
            for (int m = 0; m < 4; ++m)
#pragma unroll
                for (int n = 0; n < 2; ++n) acc[a][b][m][n] = (f32x4){0.f, 0.f, 0.f, 0.f};
    bf16x8 At[4][2], B0[2][2], B1[2][2];
    const char* cA = (const char*)g.A + (size_t)cur.pm * tstep; const char* cB = (const char*)g.Bt + (size_t)cur.pn * tstep;
    S.a_ready(cur);
    if constexpr (SP2) {
        PG8_STAGE(PG8_SB(0, 0), cB, voffB); PG8_STAGE(PG8_SB(0, 1), cB + hstep, voffB); PG8_STAGE(PG8_SA(0, 0), cA, voffA); PG8_STAGE(PG8_SA(0, 1), cA + hstep, voffA);
        if (wr == 1) PG8_BAR;
        PG8_WAIT_V(2); PG8_BAR;
        PG8_STAGE(PG8_SB(1, 0), cB + kstep, voffB); PG8_STAGE(PG8_SA(1, 0), cA + kstep, voffA); PG8_STAGE(PG8_SB(1, 1), cB + hstep + kstep, voffB);
        PG8_WAIT_V(6); PG8_BAR;
    } else {
        PG8_STAGE(PG8_SB(0, 0), cB, voffB); PG8_STAGE(PG8_SA(0, 0), cA, voffA); PG8_STAGE(PG8_SB(0, 1), cB + hstep, voffB); PG8_STAGE(PG8_SA(0, 1), cA + hstep, voffA);
        if (wr == 1) PG8_BAR;
        PG8_WAIT_V(4); PG8_BAR;
        PG8_STAGE(PG8_SB(1, 0), cB + kstep, voffB); PG8_STAGE(PG8_SA(1, 0), cA + kstep, voffA); PG8_STAGE(PG8_SB(1, 1), cB + hstep + kstep, voffB);
        PG8_WAIT_V(6); PG8_BAR;
    }
    for (;;) {
        const bool has_next = S.next(ui + 1, nxt);
        const char* nA = has_next ? (const char*)g.A + (size_t)nxt.pm * tstep : cA; const char* nB = has_next ? (const char*)g.Bt + (size_t)nxt.pn * tstep : cB;
        for (int t = 0; t < nt; t += 2) {
            const bool last = (t == nt - 2);
            const char* a1 = cA + (size_t)(t + 1) * kstep;
            const char* a2 = last ? nA : cA + (size_t)(t + 2) * kstep; const char* b2 = last ? nB : cB + (size_t)(t + 2) * kstep;
            const char* a3 = a2 + kstep; const char* b3 = b2 + kstep;
            if (last && has_next) S.a_ready(nxt);
            if constexpr (SP2) {
            PG8_LDB(B0, 0, 0); PG8_LDB(B1, 0, 1); PG8_SCHED; PG8_LDA(At, 0, 0); PG8_STAGE(PG8_SA(1, 1), a1 + hstep, voffA);
            PG8_WAIT_V(8); PG8_WAIT_L(0); PG8_BAR; PG8_MMA(0, 0, At, B0); PG8_MMA(0, 1, At, B1); PG8_BAR; PG8_SCHED;
            PG8_LDA(At, 0, 1); PG8_STAGE(PG8_SB(0, 0), b2, voffB); PG8_STAGE(PG8_SB(0, 1), b2 + hstep, voffB); PG8_STAGE(PG8_SA(0, 0), a2, voffA);
            PG8_WAIT_V(8); PG8_WAIT_L(0); PG8_BAR; PG8_MMA(1, 0, At, B0); PG8_MMA(1, 1, At, B1); PG8_BAR; PG8_SCHED;
            PG8_LDB(B0, 1, 0); PG8_LDB(B1, 1, 1); PG8_SCHED; PG8_LDA(At, 1, 0); PG8_STAGE(PG8_SA(0, 1), a2 + hstep, voffA);
            PG8_WAIT_V(8); PG8_WAIT_L(0); PG8_BAR; PG8_MMA(0, 0, At, B0); PG8_MMA(0, 1, At, B1); PG8_BAR; PG8_SCHED;
            PG8_LDA(At, 1, 1); PG8_STAGE(PG8_SB(1, 0), b3, voffB); PG8_STAGE(PG8_SB(1, 1), b3 + hstep, voffB); PG8_STAGE(PG8_SA(1, 0), a3, voffA);
            PG8_WAIT_V(8); PG8_WAIT_L(0); PG8_BAR; PG8_MMA(1, 0, At, B0); PG8_MMA(1, 1, At, B1); PG8_BAR; PG8_SCHED;
            } else {
            PG8_LDB(B0, 0, 0); PG8_SCHED; PG8_LDA(At, 0, 0); PG8_STAGE(PG8_SA(1, 1), a1 + hstep, voffA);
            PG8_WAIT_L(8); PG8_BAR; PG8_WAIT_L(0); PG8_MMA(0, 0, At, B0); PG8_BAR; PG8_SCHED;
            PG8_LDB(B1, 0, 1); PG8_STAGE(PG8_SB(0, 0), b2, voffB);
            PG8_BAR; PG8_WAIT_L(0); PG8_MMA(0, 1, At, B1); PG8_BAR;
            PG8_LDA(At, 0, 1); PG8_STAGE(PG8_SA(0, 0), a2, voffA);
            PG8_BAR; PG8_WAIT_L(0); PG8_MMA(1, 0, At, B0); PG8_BAR; PG8_SCHED;
            PG8_STAGE(PG8_SB(0, 1), b2 + hstep, voffB);
            PG8_WAIT_V(6); PG8_BAR; PG8_MMA(1, 1, At, B1); PG8_BAR;
            PG8_LDB(B0, 1, 0); PG8_SCHED; PG8_LDA(At, 1, 0); PG8_STAGE(PG8_SA(0, 1), a2 + hstep, voffA);
            PG8_WAIT_L(8); PG8_BAR; PG8_WAIT_L(0); PG8_MMA(0, 0, At, B0); PG8_BAR; PG8_SCHED;
            PG8_LDB(B1, 1, 1); PG8_STAGE(PG8_SB(1, 0), b3, voffB);
            PG8_BAR; PG8_WAIT_L(0); PG8_MMA(0, 1, At, B1); PG8_BAR;
            PG8_LDA(At, 1, 1); PG8_STAGE(PG8_SA(1, 0), a3, voffA);
            PG8_BAR; PG8_WAIT_L(0); PG8_MMA(1, 0, At, B0); PG8_BAR; PG8_SCHED;
            PG8_STAGE(PG8_SB(1, 1), b3 + hstep, voffB);
            PG8_WAIT_V(6); PG8_BAR; PG8_MMA(1, 1, At, B1); PG8_BAR;
            }
        }
        if constexpr (ALIGN_EPI) { if (wr == 0) PG8_BAR; }
        if constexpr (!Epi::AFTER_DRAIN) { E(acc, cur, wr, wc, fr, fq); S.done(cur); }
        if (!has_next) break;
#pragma unroll
        for (int a = 0; a < 2; ++a)
#pragma unroll
            for (int b = 0; b < 2; ++b)
#pragma unroll
                for (int m = 0; m < 4; ++m)
#pragma unroll
                    for (int n = 0; n < 2; ++n) acc[a][b][m][n] = (f32x4){0.f, 0.f, 0.f, 0.f};
        cur = nxt; cA = nA; cB = nB; ++ui;
        if constexpr (ALIGN_EPI) { if (wr == 1) PG8_BAR; }
    }
    PG8_WAIT_V(0);
    if constexpr (!ALIGN_EPI) { if (wr == 0) PG8_BAR; }
    PG8_BAR;
    if constexpr (Epi::AFTER_DRAIN) { E.fused(acc, cur, wr, wc, fr, fq, lds, wid, lane); S.done(cur); }
#undef PG8_SA
#undef PG8_SB
#undef PG8_STAGE
#undef PG8_LDA
#undef PG8_LDB
#undef PG8_MMA
#undef PG8_WAIT_V
#undef PG8_WAIT_L
#undef PG8_BAR
#undef PG8_SCHED
}
}
namespace pg8 {
__device__ __forceinline__ float silu_fast(float x) { return x * __builtin_amdgcn_rcpf(1.f + __expf(-x)); }
struct EpiProj {
    static constexpr bool PERM = true, AFTER_DRAIN = false;
    bf16_t* P; const float* rtc; const float* rts; const float* axc; const float* axs;
    __device__ __forceinline__ void operator()(const f32x4 (&acc)[2][2][4][2], const Unit& u, int wr, int wc, int fr, int fq) const {
        const int pn = u.pn; const bool isctx = (u.pm == 32);
        const int row0 = u.pm * BM + wr * 64 + fr;
        int type = 0; float sc = 1.f;
        if (pn < 4) { type = 2; if (pn >= 2) sc = 0.125f; }
        else if (pn < 8) type = 0;
        else if (pn < 12) type = 1;
        else if (pn < 17) { type = 3; if (pn < 16) sc = 0.125f * 1.4426950408889634f; }
        if (type < 2) {
#pragma unroll
            for (int ai = 0; ai < 2; ++ai)
#pragma unroll
                for (int m = 0; m < 4; ++m) { bf16_t* rowp = P + (size_t)(row0 + ai * HALF + m * 16) * 4608 + pn * BM + wc * 32 + 8 * fq;
#pragma unroll
                    for (int bj = 0; bj < 2; ++bj) { f32x4 v0 = acc[ai][bj][m][0], v1 = acc[ai][bj][m][1];
                        if (type == 1) {
#pragma unroll
                            for (int e = 0; e < 4; ++e) { v0[e] = silu_fast(v0[e]); v1[e] = silu_fast(v1[e]); } }
                        u32x4 w; w.x = cvt_pk_bf16(v0[0], v0[1]); w.y = cvt_pk_bf16(v0[2], v0[3]); w.z = cvt_pk_bf16(v1[0], v1[1]); w.w = cvt_pk_bf16(v1[2], v1[3]);
                        *(u32x4*)(rowp + bj * HALF) = w; } }
        } else {
            const int hf = fq >> 1;
#pragma unroll
            for (int ai = 0; ai < 2; ++ai)
#pragma unroll
                for (int m = 0; m < 4; ++m) { const int r = row0 + ai * HALF + m * 16;
                    f32x4 cs[2], sn[2];
                    if (isctx) { cs[0] = cs[1] = (f32x4){1.f, 1.f, 1.f, 1.f}; sn[0] = sn[1] = (f32x4){0.f, 0.f, 0.f, 0.f}; }
                    else if (type == 2) { const size_t o = (size_t)r * 32 + 8 * fq; cs[0] = *(const f32x4*)(rtc + o); cs[1] = *(const f32x4*)(rtc + o + 4); sn[0] = *(const f32x4*)(rts + o); sn[1] = *(const f32x4*)(rts + o + 4); }
                    else { const int pos = hf ? (r & 63) : (r >> 6); const int o = pos * 16 + 8 * (fq & 1); cs[0] = *(const f32x4*)(axc + o); cs[1] = *(const f32x4*)(axc + o + 4); sn[0] = *(const f32x4*)(axs + o); sn[1] = *(const f32x4*)(axs + o + 4); }
                    f32x4 o1[2], o2[2];
#pragma unroll
                    for (int n = 0; n < 2; ++n) { const f32x4 x1 = acc[ai][0][m][n], x2 = acc[ai][1][m][n]; o1[n] = (x1 * cs[n] - x2 * sn[n]) * sc; o2[n] = (x1 * sn[n] + x2 * cs[n]) * sc; }
                    u32x4 w1, w2; w1.x = cvt_pk_bf16(o1[0][0], o1[0][1]); w1.y = cvt_pk_bf16(o1[0][2], o1[0][3]); w1.z = cvt_pk_bf16(o1[1][0], o1[1][1]); w1.w = cvt_pk_bf16(o1[1][2], o1[1][3]);
                    w2.x = cvt_pk_bf16(o2[0][0], o2[0][1]); w2.y = cvt_pk_bf16(o2[0][2], o2[0][3]); w2.z = cvt_pk_bf16(o2[1][0], o2[1][1]); w2.w = cvt_pk_bf16(o2[1][2], o2[1][3]);
                    bf16_t* rowp = P + (size_t)r * 4608 + pn * BM + wc * 64;
                    if (type == 2) { *(u32x4*)(rowp + 8 * fq) = w1; *(u32x4*)(rowp + 32 + 8 * fq) = w2; }
                    else { *(u32x4*)(rowp + 32 * hf + 8 * (fq & 1)) = w1; *(u32x4*)(rowp + 32 * hf + 16 + 8 * (fq & 1)) = w2; } }
        }
    }
};
struct EpiResid {
    static constexpr bool PERM = false, AFTER_DRAIN = false;
    const float* R; float* out; const float* gate; int ldc;
    __device__ __forceinline__ void operator()(const f32x4 (&acc)[2][2][4][2], const Unit& u, int wr, int wc, int fr, int fq) const {
        const int row0 = u.pm * BM + wr * 64 + fr, col0 = u.pn * BM + wc * 32 + 4 * fq;
        f32x4 gv[2][2];
#pragma unroll
        for (int bj = 0; bj < 2; ++bj)
#pragma unroll
            for (int n = 0; n < 2; ++n) gv[bj][n] = *(const f32x4*)(gate + col0 + bj * HALF + n * 16);
#pragma unroll
        for (int ai = 0; ai < 2; ++ai)
#pragma unroll
            for (int m = 0; m < 4; ++m) { const size_t off = (size_t)(row0 + ai * HALF + m * 16) * ldc + col0;
#pragma unroll
                for (int bj = 0; bj < 2; ++bj)
#pragma unroll
                    for (int n = 0; n < 2; ++n) { const f32x4 rs = *(const f32x4*)(R + off + bj * HALF + n * 16); *(f32x4*)(out + off + bj * HALF + n * 16) = rs + gv[bj][n] * acc[ai][bj][m][n]; } }
    }
};
struct EpiSwiglu {
    static constexpr bool PERM = true, AFTER_DRAIN = false;
    bf16_t* O; int ldc;
    __device__ __forceinline__ void operator()(const f32x4 (&acc)[2][2][4][2], const Unit& u, int wr, int wc, int fr, int fq) const {
        const int row0 = u.pm * BM + wr * 64 + fr, col0 = u.pn * HALF + wc * 32 + 8 * fq;
#pragma unroll
        for (int ai = 0; ai < 2; ++ai)
#pragma unroll
            for (int m = 0; m < 4; ++m) { f32x4 v[2];
#pragma unroll
                for (int n = 0; n < 2; ++n) { const f32x4 g = acc[ai][0][m][n], up = acc[ai][1][m][n];
#pragma unroll
                    for (int e = 0; e < 4; ++e) v[n][e] = silu_fast(g[e]) * up[e]; }
                u32x4 w; w.x = cvt_pk_bf16(v[0][0], v[0][1]); w.y = cvt_pk_bf16(v[0][2], v[0][3]); w.z = cvt_pk_bf16(v[1][0], v[1][1]); w.w = cvt_pk_bf16(v[1][2], v[1][3]);
                *(u32x4*)(O + (size_t)(row0 + ai * HALF + m * 16) * ldc + col0) = w; }
    }
};
}
#define GAS __attribute__((address_space(1)))
#define LAS __attribute__((address_space(3)))
typedef unsigned short bf16;
typedef unsigned v4u __attribute__((ext_vector_type(4)));
typedef float f32x4 __attribute__((ext_vector_type(4)));
typedef short bf16x8 __attribute__((ext_vector_type(8)));
typedef GAS unsigned gu32;
typedef GAS unsigned long long gu64;
#define RLX_AGENT __ATOMIC_RELAXED, __HIP_MEMORY_SCOPE_AGENT
#define LDS_WAIT() asm volatile("s_waitcnt lgkmcnt(0)" ::: "memory")
#define VM_WAIT() asm volatile("s_waitcnt vmcnt(0)" ::: "memory")
__device__ __forceinline__ unsigned long long rt() { return __builtin_amdgcn_s_memrealtime(); }
__device__ __forceinline__ unsigned f2bf(float f) { unsigned u = __builtin_bit_cast(unsigned, f); return (u + 0x7fffu + ((u >> 16) & 1u)) >> 16; }
__device__ __forceinline__ unsigned pk2(float lo, float hi) { return f2bf(lo) | (f2bf(hi) << 16); }
#define XB_TMO      128
#define XB_XCNT(j)  (256  + 64 * (j))
#define XB_XSUB(j)  (1280 + 64 * (j))
#define XB_XGEN(j)  (2304 + 64 * (j))
#define XB_TOP      3328
#define XB_TOPGEN   3392
#define XCD_BAR_WORDS 3456
#define XB_SPIN_CAP (1u << 18)

__device__ __forceinline__ unsigned xb_ld(unsigned* p)              { return __hip_atomic_load(p, __ATOMIC_RELAXED, __HIP_MEMORY_SCOPE_AGENT); }
__device__ __forceinline__ unsigned xb_add(unsigned* p, unsigned v) { return __hip_atomic_fetch_add(p, v, __ATOMIC_RELAXED, __HIP_MEMORY_SCOPE_AGENT); }
__device__ __forceinline__ unsigned xb_xcc_id() { return (unsigned)__builtin_amdgcn_s_getreg((3 << 11) | 20) & 0xFu; }
#define XB_SPIN(cond, bar) do { unsigned _sp = 0; while (cond) { __builtin_amdgcn_s_sleep(1); \
    if ((++_sp & 255u) == 0u) { if (xb_ld(&(bar)[XB_TMO])) break; if (_sp > XB_SPIN_CAP) { atomicAdd(&(bar)[XB_TMO], 1u); break; } } } } while (0)

struct XcdBarrier {
    unsigned* bar; unsigned x;
    volatile LAS unsigned* st;
};

__device__ __forceinline__ XcdBarrier xcd_barrier_post(unsigned* bar, volatile LAS unsigned* st) {
    XcdBarrier b; b.bar = bar; b.x = xb_xcc_id(); b.st = st;
    if (threadIdx.x == 0) (void)xb_add(&bar[XB_XCNT(b.x)], 1u);
    return b;
}
__device__ __forceinline__ void xcd_barrier_complete(unsigned* bar, unsigned x, unsigned& nloc, unsigned& nx) {
    const unsigned G = gridDim.x * gridDim.y * gridDim.z;
    unsigned sum, cnt, mine, sp = 0u;
    for (;;) {
        sum = 0u; cnt = 0u; mine = 0u;
#pragma unroll
        for (unsigned j = 0; j < 16; ++j) { const unsigned c = xb_ld(&bar[XB_XCNT(j)]); sum += c; cnt += (c > 0u) ? 1u : 0u; mine = (j == x) ? c : mine; }
        if (sum == G) break;
        __builtin_amdgcn_s_sleep(1);
        if ((++sp & 255u) == 0u) { if (xb_ld(&bar[XB_TMO])) break; if (sp > XB_SPIN_CAP) { atomicAdd(&bar[XB_TMO], 1u); break; } }
    }
    nloc = mine > 0u ? mine : 1u; nx = cnt > 0u ? cnt : 1u;
}

__device__ __forceinline__ void xcd_barrier(const XcdBarrier& b) {
    asm volatile("s_waitcnt vmcnt(0)" ::: "memory");
    __syncthreads();
    if (threadIdx.x == 0) {
        unsigned* bar = b.bar;
        __builtin_amdgcn_s_waitcnt(0);
        unsigned nloc = b.st[0], nx = b.st[1];
        if (nloc == 0u) { xcd_barrier_complete(bar, b.x, nloc, nx); b.st[0] = nloc; b.st[1] = nx; }
        const unsigned old = xb_add(&bar[XB_XSUB(b.x)], 1u);
        const unsigned gen = old / nloc;
        if (old + 1u == (gen + 1u) * nloc) {
            __builtin_amdgcn_fence(__ATOMIC_RELEASE, "agent");
            asm volatile("s_waitcnt vmcnt(0)" ::: "memory");
            const unsigned og = xb_add(&bar[XB_TOP], 1u);
            const unsigned tg = og / nx;
            if (og + 1u == (tg + 1u) * nx) xb_add(&bar[XB_TOPGEN], 1u);
            else XB_SPIN(xb_ld(&bar[XB_TOPGEN]) == tg, bar);
            __builtin_amdgcn_fence(__ATOMIC_ACQUIRE, "agent");
            xb_add(&bar[XB_XGEN(b.x)], 1u);
            asm volatile("s_waitcnt vmcnt(0)" ::: "memory");
        } else {
            XB_SPIN(xb_ld(&bar[XB_XGEN(b.x)]) == gen, bar);
            __builtin_amdgcn_fence(__ATOMIC_ACQUIRE, "agent");
            asm volatile("s_waitcnt vmcnt(0)" ::: "memory");
        }
    }
    __syncthreads();
}
constexpr int NWAVES = 8;
constexpr int RING_OFF = 0, RING_BYTES = 131072;
constexpr int LDSCTL_OFF = RING_BYTES, MISC_OFF = LDSCTL_OFF + 320;
constexpr int LDS_BYTES = 147456;
constexpr size_t WS_MODACC = 512 * 1024;
constexpr size_t WS_RT = 2 * MiB;
constexpr size_t WS_AXT = 4 * MiB;
constexpr size_t WS_WIN = 8 * MiB, WS_WOUT = 26 * MiB, WS_WGU = 34 * MiB, WS_WDN = 78 * MiB;
constexpr size_t WS_KVT = 241 * MiB;
constexpr size_t WS_SPT = 274 * MiB;
constexpr int CW_TMO = 0, CW_CODE = 1, CW_BAR = 4096;

typedef short s16x4 __attribute__((ext_vector_type(4)));
typedef short v4i16_t __attribute__((ext_vector_type(4)));
__device__ __forceinline__ s16x4 vtr(const LAS unsigned char* p) { return __builtin_bit_cast(s16x4, __builtin_amdgcn_ds_read_tr16_b64_v4i16((LAS v4i16_t*)p)); }
__device__ __forceinline__ bf16x8 cat8(s16x4 lo, s16x4 hi) { return (bf16x8){lo[0], lo[1], lo[2], lo[3], hi[0], hi[1], hi[2], hi[3]}; }
struct Frame {
    LAS unsigned char* lds; volatile LAS unsigned* MISC; gu32* ctl;
    int tid, lane, wave, vcu, G;
};
__device__ __forceinline__ float wave_sum(float v) {
#pragma unroll
    for (int o = 1; o < 64; o <<= 1) v += __shfl_xor(v, o);
    return v;
}
__device__ __forceinline__ int sigma_in(int p) {
    const int pn = p >> 8, q = p & 255, bj = q >> 7, wc = (q >> 5) & 3, off = q & 31;
    if (pn < 4) return pn * 256 + wc * 64 + bj * 32 + off;
    if (pn >= 12 && pn < 17) return pn * 256 + wc * 64 + (off >> 4) * 32 + bj * 16 + (off & 15);
    return p;
}
__device__ __forceinline__ void tr64_item(const float* W, int K, int N, bf16* WT, int p0, int k0, int srccol4, LAS unsigned char* scr, int lane) {
    const int fr = lane & 15, fq = lane >> 4;
    f32x4 t[16];
#pragma unroll
    for (int i = 0; i < 16; ++i) t[i] = *(const GAS f32x4*)(W + (size_t)(k0 + 4 * i + fq) * N + srccol4);
#pragma unroll
    for (int i = 0; i < 16; ++i) *(LAS unsigned long long*)(scr + (4 * i + fq) * 160 + fr * 8) = (unsigned long long)pg8::cvt_pk_bf16(t[i].x, t[i].y) | ((unsigned long long)pg8::cvt_pk_bf16(t[i].z, t[i].w) << 32);
    LDS_WAIT(); asm volatile("" ::: "memory");
#pragma unroll
    for (int ng = 0; ng < 4; ++ng)
#pragma unroll
        for (int kh = 0; kh < 2; ++kh) { const LAS unsigned char* p = scr + (32 * kh + 8 * fq + (fr >> 2)) * 160 + 32 * ng + 8 * (fr & 3);
            const bf16x8 o = cat8(vtr(p), vtr(p + 4 * 160));
            *(GAS bf16x8*)(WT + (size_t)(p0 + 16 * ng + fr) * K + k0 + 32 * kh + 8 * fq) = o; }
    LDS_WAIT(); asm volatile("" ::: "memory");
}
struct Args { const float* in[16]; float* out; unsigned char* ws; int ph_lo, ph_hi, li, pad; };

__device__ __forceinline__ void p0_prologue(Frame& F, const Args& a, bool do_atomics) {
    LAS unsigned char* scr = F.lds + RING_OFF + F.wave * 16384;
    const int gw = F.vcu * NWAVES + F.wave, NGW = F.G * NWAVES, lane = F.lane;
    const float* w_mod = a.in[4]; const float* w_in = a.in[8];
    float* modacc = (float*)(a.ws + WS_MODACC);
    constexpr int I_GEMV = 48 * 32, I_RT = 128, I_AX = 1, I_IN = 72 * 32;
    constexpr int NITEMS = I_GEMV + I_RT + I_AX + I_IN;
    for (int it = gw; it < NITEMS; it += NGW) {
        int r = it;
        if (r < I_GEMV) {
            const int strip = r % 48, ks = r / 48; const int n = strip * 256 + 4 * lane;
            f32x4 a0 = {0.f, 0.f, 0.f, 0.f}, a1 = {0.f, 0.f, 0.f, 0.f};
            const float cv = a.in[1][ks * 64 + lane], cc = a.in[3][ks * 64 + lane];
            const float s0 = cv / (1.f + __expf(-cv)), s1 = cc / (1.f + __expf(-cc));
#pragma unroll 16
            for (int k = 0; k < 64; ++k) { const f32x4 w = *(const GAS f32x4*)(w_mod + (size_t)(ks * 64 + k) * (6 * D) + n);
                const float t0 = __shfl(s0, k), t1 = __shfl(s1, k); a0 += w * t0; a1 += w * t1; }
            if (ks == 0) { const f32x4 b = *(const f32x4*)(a.in[5] + n); a0 += b; a1 += b; }
#pragma unroll
            for (int e = 0; e < 4; ++e) { if (do_atomics) { unsafeAtomicAdd(modacc + n + e, a0[e]); unsafeAtomicAdd(modacc + 6 * D + n + e, a1[e]); } else asm volatile("" :: "v"(a0[e]), "v"(a1[e])); }
            continue; }
        r -= I_GEMV;
        if (r < I_RT) {
            const int t = r * 64 + lane; float* rc = (float*)(a.ws + WS_RT); float* rs = (float*)(a.ws + WS_RT + MiB);
            for (int j = 0; j < 32; ++j) { const float inv = powf(10000.f, -(float)j / 32.f), ang = (float)t * inv; float sn, cs; sincosf(ang, &sn, &cs); rc[t * 32 + j] = cs; rs[t * 32 + j] = sn; }
            continue; }
        r -= I_RT;
        if (r < I_AX) {
            float* ac = (float*)(a.ws + WS_AXT); float* as = (float*)(a.ws + WS_AXT + 8192);
            for (int i = lane; i < 128 * 16; i += 64) { const int pos = i >> 4, j = i & 15; const float inv = powf(10000.f, -(float)j / 16.f), ang = (float)pos * inv; float sn, cs; sincosf(ang, &sn, &cs); ac[i] = cs; as[i] = sn; }
            continue; }
        r -= I_AX;
        { const int grp = r % 72, kb = r / 72; tr64_item(w_in, D, NPROJ, (bf16*)(a.ws + WS_WIN), grp * 64, kb * 64, sigma_in(grp * 64 + 4 * (lane & 15)), scr, lane); }
    }
}
__device__ __forceinline__ void p0_deferred(Frame& F, const Args& a, int gwf, int ngwf) {
    LAS unsigned char* scr = F.lds + RING_OFF + F.wave * 16384; const int lane = F.lane;
    const float* w_out = a.in[11]; const float* w_gate = a.in[12]; const float* w_up = a.in[13]; const float* w_down = a.in[14];
    constexpr int I_OUT = 32 * 32, I_GU = 176 * 32, I_DN = 32 * 88;
    for (int it = gwf; it < I_OUT + I_GU + I_DN; it += ngwf) {
        int r = it;
        if (r < I_GU) { const int grp = r % 176, kb = r / 176; const int pn = grp >> 2, gg = grp & 3;
            tr64_item((gg >> 1) ? w_up : w_gate, D, DFF, (bf16*)(a.ws + WS_WGU), grp * 64, kb * 64, pn * 128 + (gg & 1) * 64 + 4 * (lane & 15), scr, lane); continue; }
        r -= I_GU;
        if (r < I_DN) { const int grp = r % 32, kb = r / 32; tr64_item(w_down, DFF, D, (bf16*)(a.ws + WS_WDN), grp * 64, kb * 64, grp * 64 + 4 * (lane & 15), scr, lane); continue; }
        r -= I_DN;
        { const int grp = r % 32, kb = r / 32; tr64_item(w_out, D, D, (bf16*)(a.ws + WS_WOUT), grp * 64, kb * 64, grp * 64 + 4 * (lane & 15), scr, lane); }
    }
}
__device__ __forceinline__ void modulate_row(const float* xrow, const float* g, const float* shift, const float* scale, bf16* orow, int lane) {
    const GAS f32x4* xr = (const GAS f32x4*)xrow + lane;
    f32x4 v[8]; float s = 0.f;
#pragma unroll
    for (int j = 0; j < 8; ++j) { v[j] = xr[64 * j]; s += (v[j].x * v[j].x + v[j].y * v[j].y) + (v[j].z * v[j].z + v[j].w * v[j].w); }
    const float r = rsqrtf(wave_sum(s) * (1.f / D) + EPS);
    GAS unsigned long long* o8 = (GAS unsigned long long*)orow + lane;
#pragma unroll
    for (int j = 0; j < 8; ++j) { const int c = 4 * lane + 256 * j; const f32x4 gg = *(const f32x4*)(g + c), sh = *(const f32x4*)(shift + c), sc = *(const f32x4*)(scale + c);
        const f32x4 y = v[j] * r * gg * (sc + 1.f) + sh;
        o8[64 * j] = (unsigned long long)pk2(y.x, y.y) | ((unsigned long long)pk2(y.z, y.w) << 32); }
}
__device__ __forceinline__ void modulate_row2(const float* x1, const float* x2, const float* g, const float* sh1, const float* sc1, const float* sh2, const float* sc2, bf16* o1, bf16* o2, int lane) {
    const GAS f32x4* xr1 = (const GAS f32x4*)x1 + lane; const GAS f32x4* xr2 = (const GAS f32x4*)x2 + lane;
    f32x4 v[8], u[8]; float s = 0.f, t = 0.f;
#pragma unroll
    for (int j = 0; j < 8; ++j) { v[j] = xr1[64 * j]; u[j] = xr2[64 * j]; }
#pragma unroll
    for (int j = 0; j < 8; ++j) { s += (v[j].x * v[j].x + v[j].y * v[j].y) + (v[j].z * v[j].z + v[j].w * v[j].w); t += (u[j].x * u[j].x + u[j].y * u[j].y) + (u[j].z * u[j].z + u[j].w * u[j].w); }
    const float r1 = rsqrtf(wave_sum(s) * (1.f / D) + EPS), r2 = rsqrtf(wave_sum(t) * (1.f / D) + EPS);
    GAS unsigned long long* p1 = (GAS unsigned long long*)o1 + lane; GAS unsigned long long* p2 = (GAS unsigned long long*)o2 + lane;
#pragma unroll
    for (int j = 0; j < 8; ++j) { const int c = 4 * lane + 256 * j; const f32x4 gg = *(const f32x4*)(g + c);
        const f32x4 y = v[j] * r1 * gg * (*(const f32x4*)(sc1 + c) + 1.f) + *(const f32x4*)(sh1 + c);
        const f32x4 z = u[j] * r2 * gg * (*(const f32x4*)(sc2 + c) + 1.f) + *(const f32x4*)(sh2 + c);
        p1[64 * j] = (unsigned long long)pk2(y.x, y.y) | ((unsigned long long)pk2(y.z, y.w) << 32);
        p2[64 * j] = (unsigned long long)pk2(z.x, z.y) | ((unsigned long long)pk2(z.z, z.w) << 32); }
}
__device__ __forceinline__ void final_norm_row(const float* xrow, float* orow, const float* g, int lane) {
    const GAS f32x4* xr = (const GAS f32x4*)xrow + lane; GAS f32x4* xo = (GAS f32x4*)orow + lane;
    f32x4 v[8]; float s = 0.f;
#pragma unroll
    for (int j = 0; j < 8; ++j) { v[j] = xr[64 * j]; s += (v[j].x * v[j].x + v[j].y * v[j].y) + (v[j].z * v[j].z + v[j].w * v[j].w); }
    const float r = rsqrtf(wave_sum(s) * (1.f / D) + EPS);
#pragma unroll
    for (int j = 0; j < 8; ++j) { const f32x4 gg = *(const f32x4*)(g + 4 * lane + 256 * j); xo[64 * j] = v[j] * r * gg; }
}

__device__ __forceinline__ f32x4 mfma16(bf16x8 a, bf16x8 b, f32x4 c) { return __builtin_amdgcn_mfma_f32_16x16x32_bf16(a, b, c, 0, 0, 0); }
__device__ __forceinline__ float ex2(float x) { return __builtin_amdgcn_exp2f(x); }
__device__ __forceinline__ unsigned pk2f(float lo, float hi) { return pg8::cvt_pk_bf16(lo, hi); }
constexpr int RSV = 288;
constexpr int RSK = 160;
__device__ __forceinline__ bf16x8 tr_frag(const LAS unsigned char* tile, int rs, int r0, int cb, int fr, int fq) {
    const LAS unsigned char* p = tile + (r0 + 4 * fq + (fr >> 2)) * rs + cb + 8 * (fr & 3);
    return cat8(vtr(p), vtr(p + 16 * rs));
}

__device__ __forceinline__ void ret_kv_item(Frame& F, const bf16* PROJ, float* KVT, int cc, int h, float lf2, float lb2) {
    const int lane = F.lane, fr = lane & 15, fq = lane >> 4, w = F.wave, tid = F.tid;
    const int row0 = cc < 2 ? L + 128 * cc : 128 * (cc - 2);
    LAS unsigned char* Vl = F.lds; LAS unsigned char* Kf = F.lds + 128 * RSV; LAS unsigned char* Kb = Kf + 128 * RSK;
    __syncthreads();
#pragma unroll
    for (int p = 0; p < 4; ++p) { const int idx = p * 512 + tid, row = idx >> 4, ch = idx & 15;
        const v4u v = *(const GAS v4u*)(PROJ + (size_t)(row0 + row) * NPROJ + C_RV + h * 128 + ch * 8); *(LAS v4u*)(Vl + row * RSV + ch * 16) = v; }
#pragma unroll
    for (int p = 0; p < 2; ++p) { const int idx = p * 512 + tid, row = idx >> 3, ch = idx & 7;
        const v4u v = *(const GAS v4u*)(PROJ + (size_t)(row0 + row) * NPROJ + C_RK + h * 64 + ch * 8);
        const float wf = ex2(lf2 * (float)(127 - row)), wb = ex2(lb2 * (float)row);
        v4u of, ob;
#pragma unroll
        for (int e = 0; e < 4; ++e) { const float lo = __uint_as_float(v[e] << 16), hi = __uint_as_float(v[e] & 0xffff0000u); of[e] = pk2f(lo * wf, hi * wf); ob[e] = pk2f(lo * wb, hi * wb); }
        *(LAS v4u*)(Kf + row * RSK + ch * 16) = of; *(LAS v4u*)(Kb + row * RSK + ch * 16) = ob; }
    __syncthreads();
    bf16x8 aV[4];
#pragma unroll
    for (int st = 0; st < 4; ++st) aV[st] = tr_frag(Vl, RSV, 32 * st, 32 * w, fr, fq);
#pragma unroll
    for (int dir = 0; dir < 2; ++dir) { const LAS unsigned char* Kx = dir ? Kb : Kf;
        float* outp = KVT + (((size_t)dir * 66 + cc) * 8 + h) * 8192 + (16 * w + 4 * fq) * 64 + fr;
#pragma unroll
        for (int dt = 0; dt < 4; ++dt) { f32x4 acc = {0.f, 0.f, 0.f, 0.f};
#pragma unroll
            for (int st = 0; st < 4; ++st) acc = mfma16(aV[st], tr_frag(Kx, RSK, 32 * st, 32 * dt, fr, fq), acc);
#pragma unroll
            for (int r = 0; r < 4; ++r) outp[r * 64 + 16 * dt] = acc[r]; } }
}
__device__ __forceinline__ void ret_scan_phase(Frame& F, const float* KVT, bf16* SPT, const float* ret_decay) {
    const int nthr = F.G * 512;
    for (int e = F.vcu * 512 + F.tid; e < 2 * 8 * 8192; e += nthr) {
        const int dir = e >> 16, h = (e >> 13) & 7, vd = e & 8191;
        const float g = __expf(-128.f * __expf(ret_decay[dir * 8 + h]));
        const float* kv = KVT + ((size_t)dir * 66 * 8 + h) * 8192 + vd;
        bf16* sp = SPT + ((size_t)dir * 64 * 8 + h) * 8192 + vd;
        float S = 0.f;
        if (dir == 0) { S = kv[0]; S = g * S + kv[65536];
#pragma unroll 8
            for (int c = 0; c < 64; ++c) { sp[(size_t)c * 65536] = (bf16)f2bf(S); S = g * S + kv[(size_t)(2 + c) * 65536]; } }
        else { S = kv[65536]; S = g * S + kv[0];
#pragma unroll 8
            for (int c = 63; c >= 0; --c) { sp[(size_t)c * 65536] = (bf16)f2bf(S); S = g * S + kv[(size_t)(2 + c) * 65536]; } }
    }
}
__device__ __forceinline__ void ret_out_item(Frame& F, const bf16* PROJ, const bf16* SPT, bf16* Y, int c, int h, float lf2, float lb2) {
    const int lane = F.lane, fr = lane & 15, fq = lane >> 4, w = F.wave, tid = F.tid;
    const int t0 = c * 128;
    LAS unsigned char* Vl = F.lds;
    __syncthreads();
#pragma unroll
    for (int p = 0; p < 4; ++p) { const int idx = p * 512 + tid, row = idx >> 4, ch = idx & 15;
        const v4u v = *(const GAS v4u*)(PROJ + (size_t)(t0 + row) * NPROJ + C_RV + h * 128 + ch * 8); *(LAS v4u*)(Vl + row * RSV + ch * 16) = v; }
    const int il = 16 * w + fr;
    const bf16* qrow = PROJ + (size_t)(t0 + il) * NPROJ + C_RQ + h * 64 + 8 * fq;
    bf16x8 qB[2]; qB[0] = *(const GAS bf16x8*)(qrow); qB[1] = *(const GAS bf16x8*)(qrow + 32);
    const float wf = ex2(lf2 * (float)(il + 1)), wb = ex2(lb2 * (float)(128 - il));
    const bf16* Sf = SPT + ((size_t)(0 * 64 + c) * 8 + h) * 8192 + fr * 64 + 8 * fq;
    const bf16* Sb = SPT + ((size_t)(1 * 64 + c) * 8 + h) * 8192 + fr * 64 + 8 * fq;
    f32x4 O[8];
#pragma unroll
    for (int vt = 0; vt < 8; ++vt) { f32x4 xf = {0.f, 0.f, 0.f, 0.f}, xb = {0.f, 0.f, 0.f, 0.f};
#pragma unroll
        for (int s = 0; s < 2; ++s) { xf = mfma16(*(const GAS bf16x8*)(Sf + vt * 1024 + 32 * s), qB[s], xf); xb = mfma16(*(const GAS bf16x8*)(Sb + vt * 1024 + 32 * s), qB[s], xb); }
        O[vt] = xf * wf + xb * wb; }
    unsigned pt[8][2];
    const bf16* krow = PROJ + (size_t)(t0 + fr) * NPROJ + C_RK + h * 64 + 8 * fq;
#pragma unroll
    for (int T = 0; T < 8; ++T) { f32x4 st = {0.f, 0.f, 0.f, 0.f};
#pragma unroll
        for (int s = 0; s < 2; ++s) st = mfma16(*(const GAS bf16x8*)(krow + (size_t)(16 * T) * NPROJ + 32 * s), qB[s], st);
#pragma unroll
        for (int r = 0; r < 4; ++r) { const int diff = il - (16 * T + 4 * fq + r); st[r] *= diff >= 0 ? ex2(lf2 * (float)diff) : ex2(lb2 * (float)(-diff)); }
        pt[T][0] = pk2f(st[0], st[1]); pt[T][1] = pk2f(st[2], st[3]); }
    __syncthreads();
#pragma unroll
    for (int st = 0; st < 4; ++st) { const v4u pw = {pt[2 * st][0], pt[2 * st][1], pt[2 * st + 1][0], pt[2 * st + 1][1]}; const bf16x8 pb = __builtin_bit_cast(bf16x8, pw);
#pragma unroll
        for (int vt = 0; vt < 8; ++vt) O[vt] = mfma16(tr_frag(Vl, RSV, 32 * st, 32 * vt, fr, fq), pb, O[vt]); }
    float ss = 0.f;
#pragma unroll
    for (int vt = 0; vt < 8; ++vt) ss += (O[vt][0] * O[vt][0] + O[vt][1] * O[vt][1]) + (O[vt][2] * O[vt][2] + O[vt][3] * O[vt][3]);
    ss += __shfl_xor(ss, 16); ss += __shfl_xor(ss, 32);
    const float r = rsqrtf(ss * (1.f / 128.f) + EPS);
    const bf16* grow = PROJ + (size_t)(t0 + il) * NPROJ + C_RG + h * 128 + 4 * fq;
    bf16* yrow = Y + (size_t)(t0 + il) * D + h * 128 + 4 * fq;
#pragma unroll
    for (int vt = 0; vt < 8; ++vt) { const unsigned long long gw = *(const GAS unsigned long long*)(grow + 16 * vt); const unsigned g0 = (unsigned)gw, g1 = (unsigned)(gw >> 32);
        const float y0 = O[vt][0] * r * __uint_as_float(g0 << 16), y1 = O[vt][1] * r * __uint_as_float(g0 & 0xffff0000u), y2 = O[vt][2] * r * __uint_as_float(g1 << 16), y3 = O[vt][3] * r * __uint_as_float(g1 & 0xffff0000u);
        *(GAS unsigned long long*)(yrow + 16 * vt) = (unsigned long long)pk2f(y0, y1) | ((unsigned long long)pk2f(y2, y3) << 32); }
}
constexpr int ATT_ROWS = 640;
__device__ __forceinline__ void attn_item(Frame& F, const bf16* PROJ, const float* sink, bf16* Y, int b, int kvh) {
    const int lane = F.lane, fr = lane & 15, fq = lane >> 4, w = F.wave, tid = F.tid;
    LAS unsigned char* Vl = F.lds;
    __syncthreads();
#pragma unroll
    for (int p = 0; p < 10; ++p) { const int idx = p * 512 + tid, row = idx >> 3, ch = idx & 7;
        int src; bool ok = true;
        if (row < 384) { const int key = 128 * b - 128 + row; ok = key >= 0 && key < L; src = ok ? key : 0; } else src = L + (row - 384);
        v4u v = *(const GAS v4u*)(PROJ + (size_t)src * NPROJ + C_AV + kvh * 64 + ch * 8);
        if (!ok) v = (v4u){0u, 0u, 0u, 0u};
        *(LAS v4u*)(Vl + row * RSK + ch * 16) = v; }
    const int iq = 128 * b + 16 * w + fr;
    bf16x8 qB[4][2]; float m[4], l[4]; f32x4 O[4][4];
#pragma unroll
    for (int g = 0; g < 4; ++g) { const bf16* qrow = PROJ + (size_t)iq * NPROJ + C_AQ + (4 * kvh + g) * 64 + 8 * fq;
        qB[g][0] = *(const GAS bf16x8*)(qrow); qB[g][1] = *(const GAS bf16x8*)(qrow + 32);
        m[g] = sink[4 * kvh + g] * LOG2E; l[g] = fq == 0 ? 1.f : 0.f;
#pragma unroll
        for (int dt = 0; dt < 4; ++dt) O[g][dt] = (f32x4){0.f, 0.f, 0.f, 0.f}; }
    __syncthreads();
    const bf16* kbase = PROJ + C_AK + kvh * 64 + 8 * fq;
#define ATT_KLOAD(dst, stp) do { const bool il_ = (stp) < 9; const int lr_ = il_ ? 32 * ((w >> 1) + (stp)) : 384 + 32 * ((stp) - 9); \
        _Pragma("unroll") for (int tt = 0; tt < 2; ++tt) { int kr; \
            if (il_) { kr = 128 * b - 128 + lr_ + 16 * tt + fr; kr = kr < 0 ? 0 : (kr > L - 1 ? L - 1 : kr); } else kr = L + (lr_ - 384) + 16 * tt + fr; \
            const bf16* kp = kbase + (size_t)kr * NPROJ; dst[tt][0] = *(const GAS bf16x8*)(kp); dst[tt][1] = *(const GAS bf16x8*)(kp + 32); } } while (0)
    bf16x8 kA[2][2], kN[2][2];
    ATT_KLOAD(kA, 0);
    for (int step = 0; step < 17; ++step) {
        const bool isloc = step < 9;
        const int ldsrow0 = isloc ? 32 * ((w >> 1) + step) : 384 + 32 * (step - 9);
        const int key0 = 128 * b - 128 + ldsrow0;
        { const int nstep = step < 16 ? step + 1 : 16; ATT_KLOAD(kN, nstep); }
        bf16x8 vA[4];
#pragma unroll
        for (int dt = 0; dt < 4; ++dt) vA[dt] = tr_frag(Vl, RSK, ldsrow0, 32 * dt, fr, fq);
#pragma unroll
        for (int g = 0; g < 4; ++g) {
            f32x4 s0 = {0.f, 0.f, 0.f, 0.f}, s1 = {0.f, 0.f, 0.f, 0.f};
            s0 = mfma16(kA[0][0], qB[g][0], s0); s0 = mfma16(kA[0][1], qB[g][1], s0);
            s1 = mfma16(kA[1][0], qB[g][0], s1); s1 = mfma16(kA[1][1], qB[g][1], s1);
            if (isloc) {
#pragma unroll
                for (int r = 0; r < 4; ++r) { const int k0 = key0 + 4 * fq + r, k1 = k0 + 16; const int d0 = iq - k0, d1 = iq - k1;
                    if (!(k0 >= 0 && k0 < L && d0 <= WIN && d0 >= -WIN)) s0[r] = -INFINITY;
                    if (!(k1 >= 0 && k1 < L && d1 <= WIN && d1 >= -WIN)) s1[r] = -INFINITY; } }
            float mx = fmaxf(fmaxf(fmaxf(s0[0], s0[1]), fmaxf(s0[2], s0[3])), fmaxf(fmaxf(s1[0], s1[1]), fmaxf(s1[2], s1[3])));
            mx = fmaxf(mx, __shfl_xor(mx, 16)); mx = fmaxf(mx, __shfl_xor(mx, 32));
            const float mn = fmaxf(m[g], mx), alpha = ex2(m[g] - mn); m[g] = mn;
            float ps = 0.f;
#pragma unroll
            for (int r = 0; r < 4; ++r) { s0[r] = ex2(s0[r] - mn); s1[r] = ex2(s1[r] - mn); ps += s0[r] + s1[r]; }
            l[g] = l[g] * alpha + ps;
            const v4u pw = {pk2f(s0[0], s0[1]), pk2f(s0[2], s0[3]), pk2f(s1[0], s1[1]), pk2f(s1[2], s1[3])}; const bf16x8 pb = __builtin_bit_cast(bf16x8, pw);
#pragma unroll
            for (int dt = 0; dt < 4; ++dt) { O[g][dt] *= alpha; O[g][dt] = mfma16(vA[dt], pb, O[g][dt]); }
        }
#pragma unroll
        for (int tt = 0; tt < 2; ++tt) { kA[tt][0] = kN[tt][0]; kA[tt][1] = kN[tt][1]; }
    }
#undef ATT_KLOAD
#pragma unroll
    for (int g = 0; g < 4; ++g) { float lt = l[g]; lt += __shfl_xor(lt, 16); lt += __shfl_xor(lt, 32); const float inv = 1.f / lt;
        bf16* yrow = Y + (size_t)iq * D + 1024 + (4 * kvh + g) * 64 + 4 * fq;
#pragma unroll
        for (int dt = 0; dt < 4; ++dt) *(GAS unsigned long long*)(yrow + 16 * dt) = (unsigned long long)pk2f(O[g][dt][0] * inv, O[g][dt][1] * inv) | ((unsigned long long)pk2f(O[g][dt][2] * inv, O[g][dt][3] * inv) << 32); }
}
__global__ void __launch_bounds__(NWAVES * 64, 2) mk_fwd(Args args) {
    extern __shared__ __attribute__((aligned(16))) unsigned char lds[];
    Frame F;
    F.lds = (LAS unsigned char*)lds;
    F.MISC = (volatile LAS unsigned*)(F.lds + MISC_OFF);
    F.tid = threadIdx.x; F.lane = F.tid & 63; F.wave = __builtin_amdgcn_readfirstlane(F.tid >> 6);
    F.G = gridDim.x; { const int bx = blockIdx.x; F.vcu = (F.G % 8 == 0) ? (bx % 8) * (F.G / 8) + bx / 8 : bx; }
    unsigned char* ws = args.ws;
    F.ctl = (gu32*)(ws + WS_CTL);
    for (int u = F.tid; u < (LDS_BYTES - LDSCTL_OFF) / 4; u += NWAVES * 64) ((LAS unsigned*)(F.lds + LDSCTL_OFF))[u] = 0u;
    __syncthreads();
    XcdBarrier bar = xcd_barrier_post((unsigned*)(F.ctl + CW_BAR) + args.li * XCD_BAR_WORDS, F.MISC + 8);
    const int lo = args.ph_lo, hi = args.ph_hi;
#define IN(k) (lo <= (k) && (k) < hi)
#define BOTH(k) (IN(k) && IN((k) + 1))
#define REP(k) for (int rep_ = 0; rep_ < 1 + ((PROBE_DBL >> (k)) & 1); ++rep_)
#define DUMMY(k) (((PROBE_DBL >> (k)) & 1) && rep_ == 0)
    const float* mod = (const float*)(ws + WS_MODACC);
    bf16* HX = (bf16*)(ws + WS_HX); bf16* PROJ = (bf16*)(ws + WS_PROJ); bf16* Y = (bf16*)(ws + WS_Y); bf16* ACT = (bf16*)(ws + WS_ACT);
    const int gw = F.vcu * NWAVES + F.wave, NGW = F.G * NWAVES;

    if (IN(0)) REP(0) { p0_prologue(F, args, rep_ == 0); if (BOTH(0)) xcd_barrier(bar); }
    if (IN(1)) REP(1) {
        for (int m = gw; m < MROWS; m += 2 * NGW) {
            const int m2 = m + NGW < MROWS ? m + NGW : m;
            const float* src = m < L ? args.in[0] + (size_t)m * D : args.in[2] + (size_t)(m - L) * D; const float* mb = m < L ? mod : mod + 6 * D;
            const float* src2 = m2 < L ? args.in[0] + (size_t)m2 * D : args.in[2] + (size_t)(m2 - L) * D; const float* mb2 = m2 < L ? mod : mod + 6 * D;
            modulate_row2(src, src2, args.in[6], mb, mb + D, mb2, mb2 + D, HX + (size_t)m * D, HX + (size_t)m2 * D, F.lane); }
        if (BOTH(1)) xcd_barrier(bar);
    }
    if (IN(2)) REP(2) {
        pg8::Gemm g{HX, (const bf16*)(ws + WS_WIN), MROWS, NPROJ, D}; pg8::StaticOrder S; S.init(MROWS, NPROJ, F.G, (int)blockIdx.x);
        pg8::EpiProj E{PROJ, (const float*)(ws + WS_RT), (const float*)(ws + WS_RT + MiB), (const float*)(ws + WS_AXT), (const float*)(ws + WS_AXT + 8192)};
        pg8::gemm_phase<pg8::EpiProj, pg8::StaticOrder, true, true>(F.lds + RING_OFF, g, S, E);
        { const int extra = S.nwg % F.G; const int c = (int)blockIdx.x;
            if (extra == 0) p0_deferred(F, args, c * NWAVES + F.wave, F.G * NWAVES);
            else if (c >= extra) p0_deferred(F, args, (c - extra) * NWAVES + F.wave, (F.G - extra) * NWAVES); }
        if (BOTH(2)) xcd_barrier(bar);
    }
    if (IN(3)) REP(3) {
        const float* rd = args.in[9];
        for (int it = F.vcu; it < 256; it += F.G) attn_item(F, PROJ, args.in[10], Y, it >> 2, it & 3);
        for (int it = F.vcu; it < 528; it += F.G) { const int cc = it >> 3, h = it & 7;
            ret_kv_item(F, PROJ, (float*)(ws + WS_KVT), cc, h, -__expf(rd[h]) * LOG2E, -__expf(rd[8 + h]) * LOG2E); }
        if (BOTH(3)) xcd_barrier(bar);
    }
    if (IN(4)) REP(4) { ret_scan_phase(F, (const float*)(ws + WS_KVT), (bf16*)(ws + WS_SPT), args.in[9]); if (BOTH(4)) xcd_barrier(bar); }
    if (IN(5)) REP(5) {
        const float* rd = args.in[9];
        for (int it = F.vcu; it < 512; it += F.G) { const int c = it >> 3, h = it & 7;
            ret_out_item(F, PROJ, (const bf16*)(ws + WS_SPT), Y, c, h, -__expf(rd[h]) * LOG2E, -__expf(rd[8 + h]) * LOG2E); }
        if (BOTH(5)) xcd_barrier(bar);
    }
    if (IN(6)) REP(6) {
        pg8::Gemm g{Y, (const bf16*)(ws + WS_WOUT), L, D, D}; pg8::StaticOrder S; S.init(L, D, F.G, (int)blockIdx.x);
        pg8::EpiResid E{args.in[0], args.out, mod + 2 * D, D};
        pg8::gemm_phase<pg8::EpiResid, pg8::StaticOrder, true, true>(F.lds + RING_OFF, g, S, E);
        if (BOTH(6)) xcd_barrier(bar);
    }
    if (IN(7)) REP(7) {
        for (int m = gw; m < L; m += 2 * NGW) { const int m2 = m + NGW < L ? m + NGW : m;
            modulate_row2(args.out + (size_t)m * D, args.out + (size_t)m2 * D, args.in[7], mod + 3 * D, mod + 4 * D, mod + 3 * D, mod + 4 * D, HX + (size_t)m * D, HX + (size_t)m2 * D, F.lane); }
        if (BOTH(7)) xcd_barrier(bar);
    }
    if (IN(8)) REP(8) {
        pg8::Gemm g{HX, (const bf16*)(ws + WS_WGU), L, 2 * DFF, D}; pg8::StaticOrder S; S.init(L, 2 * DFF, F.G, (int)blockIdx.x);
        pg8::EpiSwiglu E{ACT, DFF};
        pg8::gemm_phase<pg8::EpiSwiglu, pg8::StaticOrder, true, true>(F.lds + RING_OFF, g, S, E);
        if (BOTH(8)) xcd_barrier(bar);
    }
    if (IN(9)) REP(9) {
        pg8::Gemm g{ACT, (const bf16*)(ws + WS_WDN), L, D, DFF}; pg8::StaticOrder S; S.init(L, D, F.G, (int)blockIdx.x);
        pg8::EpiResid E{args.out, DUMMY(9) ? (float*)(ws + WS_PROJ) : args.out, mod + 5 * D, D};
        pg8::gemm_phase<pg8::EpiResid, pg8::StaticOrder, true, true>(F.lds + RING_OFF, g, S, E);
        if (BOTH(9)) xcd_barrier(bar);
    }
    if (IN(10)) REP(10) { float* dst = DUMMY(10) ? (float*)(ws + WS_PROJ) : args.out; for (int m = gw; m < L; m += NGW) final_norm_row(args.out + (size_t)m * D, dst + (size_t)m * D, args.in[15], F.lane); }
#undef IN
#undef REP
#undef DUMMY
#undef BOTH
}

extern "C" void kernel_launch(void* const* d_in, const int* in_sizes, int n_in, void* d_out, int out_size, void* d_ws, size_t ws_size, hipStream_t stream) {
    static int grid = 0;
    if (grid == 0) {
        if (n_in != 16 || in_sizes[0] != L * D || out_size != L * D || ws_size < WS_END) { fprintf(stderr, "kernel_launch: unexpected shapes (n_in %d, in0 %d, out %d, ws %zu)\n", n_in, n_in > 0 ? in_sizes[0] : -1, out_size, ws_size); grid = -1; return; }
        int dev = 0, cus = 0, per_cu = 0;
        if (hipGetDevice(&dev) != hipSuccess || hipDeviceGetAttribute(&cus, hipDeviceAttributeMultiprocessorCount, dev) != hipSuccess) { grid = -1; return; }
        if (hipFuncSetAttribute((const void*)mk_fwd, hipFuncAttributeMaxDynamicSharedMemorySize, LDS_BYTES) != hipSuccess) { fprintf(stderr, "kernel_launch: hipFuncSetAttribute failed\n"); grid = -1; return; }
        if (hipOccupancyMaxActiveBlocksPerMultiprocessor(&per_cu, (const void*)mk_fwd, NWAVES * 64, LDS_BYTES) != hipSuccess || per_cu < 1) { fprintf(stderr, "kernel_launch: occupancy query says %d blocks per CU\n", per_cu); grid = -1; (void)hipGetLastError(); return; }
        (void)hipGetLastError();
        grid = cus;
    }
    if (grid < 0) return;
    unsigned char* ws = (unsigned char*)d_ws;
    hipMemsetAsync(ws + WS_CTL, 0, CTL_BYTES, stream);
    Args a{};
    for (int i = 0; i < 16; ++i) a.in[i] = (const float*)d_in[i];
    a.out = (float*)d_out; a.ws = ws;
    a.ph_lo = 0; a.ph_hi = 11; a.li = 0;
    hipLaunchKernelGGL(mk_fwd, dim3(grid), dim3(NWAVES * 64), LDS_BYTES, stream, a);
}
```

```cpp
#ifndef PROBE_DBL
#define PROBE_DBL 0
#endif
#include <hip/hip_runtime.h>
#include <cstdio>
#include <cstdint>
#include <cmath>

typedef unsigned short bf16;
typedef unsigned u32x4 __attribute__((ext_vector_type(4)));
typedef float f32x4 __attribute__((ext_vector_type(4)));

constexpr int D = 2048, L = 8192, LC = 256, MROWS = L + LC;
constexpr int NPROJ = 4608, DFF = 5632;
constexpr int RH = 8, RDK = 64, RDV = 128, CH = 128, NCH = L / CH;
constexpr int AH = 16, AKV = 4, ADH = 64, WIN = 128;
constexpr float EPS = 1e-6f;
constexpr float LOG2E = 1.4426950408889634f;
constexpr int C_RQ = 0, C_RK = 512, C_RV = 1024, C_RG = 2048, C_AQ = 3072, C_AK = 4096, C_AV = 4352;

constexpr size_t MiB = 1u << 20;
constexpr size_t WS_CTL = 0, CTL_BYTES = 1 * MiB;
constexpr size_t WS_MOD = 1 * MiB;
constexpr size_t WS_HX = 100 * MiB;
constexpr size_t WS_PROJ = 134 * MiB;
constexpr size_t WS_Y = 209 * MiB;
constexpr size_t WS_ACT = 290 * MiB;
constexpr size_t WS_TMP = 209 * MiB;
constexpr size_t WS_OFB = 290 * MiB;
constexpr size_t WS_END = 384 * MiB;

__device__ __forceinline__ float bf2f(bf16 v) { return __uint_as_float((unsigned)v << 16); }
__device__ __forceinline__ bf16 f2bf_n(float f) { unsigned u = __float_as_uint(f); return (bf16)((u + 0x7fffu + ((u >> 16) & 1u)) >> 16); }
__device__ __forceinline__ float silu_f(float x) { return x / (1.f + __expf(-x)); }

__global__ __launch_bounds__(256) void nv_mod(const float* c, const float* cctx, const float* w_mod, const float* b_mod, float* mod) {
    __shared__ float s[2][D];
    for (int i = threadIdx.x; i < D; i += 256) { s[0][i] = silu_f(c[i]); s[1][i] = silu_f(cctx[i]); }
    __syncthreads();
    const int n = blockIdx.x * 256 + threadIdx.x;
    float a0 = 0.f, a1 = 0.f;
    for (int k = 0; k < D; ++k) { const float w = w_mod[(size_t)k * (6 * D) + n]; a0 += s[0][k] * w; a1 += s[1][k] * w; }
    mod[n] = a0 + b_mod[n]; mod[6 * D + n] = a1 + b_mod[n];
}
__global__ __launch_bounds__(256) void nv_modulate(const float* src, const float* g, const float* shift, const float* scale, bf16* out) {
    __shared__ float red[4];
    const int row = blockIdx.x; const float* x = src + (size_t)row * D;
    float v[8]; float ss = 0.f;
#pragma unroll
    for (int i = 0; i < 8; ++i) { v[i] = x[threadIdx.x + 256 * i]; ss += v[i] * v[i]; }
#pragma unroll
    for (int o = 1; o < 64; o <<= 1) ss += __shfl_xor(ss, o);
    if ((threadIdx.x & 63) == 0) red[threadIdx.x >> 6] = ss;
    __syncthreads();
    const float r = rsqrtf((red[0] + red[1] + red[2] + red[3]) * (1.f / D) + EPS);
#pragma unroll
    for (int i = 0; i < 8; ++i) { const int cidx = threadIdx.x + 256 * i; out[(size_t)row * D + cidx] = f2bf_n(v[i] * r * g[cidx] * (1.f + scale[cidx]) + shift[cidx]); }
}
template <int MODE> __global__ __launch_bounds__(256) void nv_gemm(const bf16* A, int lda, const float* B, const float* B2, int ldb, int K,
                                                                     float* Cf, bf16* Cb, int ldc, const float* R, const float* gate) {
    __shared__ float As[16][132]; __shared__ float Bs[16][64]; __shared__ float Bs2[16][64];
    const int tid = threadIdx.x, tx = tid & 15, ty = tid >> 4;
    const int m0 = blockIdx.y * 128, n0 = blockIdx.x * 64;
    float acc[8][4], acc2[8][4];
#pragma unroll
    for (int i = 0; i < 8; ++i)
#pragma unroll
        for (int j = 0; j < 4; ++j) { acc[i][j] = 0.f; acc2[i][j] = 0.f; }
    const int arow = tid >> 1, akh = (tid & 1) * 8, bk = tid >> 4, bn4 = (tid & 15) * 4;
    for (int k0 = 0; k0 < K; k0 += 16) {
        const u32x4 av = *(const u32x4*)(A + (size_t)(m0 + arow) * lda + k0 + akh);
        const f32x4 bv = *(const f32x4*)(B + (size_t)(k0 + bk) * ldb + n0 + bn4);
        f32x4 bv2 = bv; if (MODE == 1) bv2 = *(const f32x4*)(B2 + (size_t)(k0 + bk) * ldb + n0 + bn4);
#pragma unroll
        for (int i = 0; i < 4; ++i) { As[akh + 2 * i][arow] = __uint_as_float(av[i] << 16); As[akh + 2 * i + 1][arow] = __uint_as_float(av[i] & 0xffff0000u); }
        *(f32x4*)&Bs[bk][bn4] = bv; if (MODE == 1) *(f32x4*)&Bs2[bk][bn4] = bv2;
        __syncthreads();
#pragma unroll
        for (int k = 0; k < 16; ++k) {
            float a[8], b[4], b2[4];
#pragma unroll
            for (int i = 0; i < 8; ++i) a[i] = As[k][ty * 8 + i];
#pragma unroll
            for (int j = 0; j < 4; ++j) { b[j] = Bs[k][tx * 4 + j]; b2[j] = (MODE == 1) ? Bs2[k][tx * 4 + j] : 0.f; }
#pragma unroll
            for (int i = 0; i < 8; ++i)
#pragma unroll
                for (int j = 0; j < 4; ++j) { acc[i][j] += a[i] * b[j]; if (MODE == 1) acc2[i][j] += a[i] * b2[j]; }
        }
        __syncthreads();
    }
#pragma unroll
    for (int i = 0; i < 8; ++i)
#pragma unroll
        for (int j = 0; j < 4; ++j) {
            const size_t r = m0 + ty * 8 + i; const int cidx = n0 + tx * 4 + j;
            if (MODE == 0) Cf[r * ldc + cidx] = acc[i][j];
            if (MODE == 1) Cb[r * ldc + cidx] = f2bf_n(silu_f(acc[i][j]) * acc2[i][j]);
            if (MODE == 2) Cf[r * ldc + cidx] = R[r * ldc + cidx] + gate[cidx] * acc[i][j];
        }
}
__global__ __launch_bounds__(256) void nv_proj_epi(const float* tmp, bf16* proj) {
    const size_t idx = (size_t)blockIdx.x * 256 + threadIdx.x;
    const int row = (int)(idx / NPROJ), col = (int)(idx % NPROJ);
    const bool isctx = row >= L; const int t = row;
    const float* tr = tmp + (size_t)row * NPROJ;
    const float v = tr[col]; float o = v;
    if (col < C_RV) {
        if (!isctx) {
            const int d = col & 63, j = d & 31;
            const float inv = powf(10000.f, -(float)j / 32.f), ang = (float)t * inv; float sn, cs; sincosf(ang, &sn, &cs);
            if (d < 32) o = v * cs - tr[col + 32] * sn; else o = tr[col - 32] * sn + v * cs;
        }
        if (col >= C_RK) o *= 0.125f;
    } else if (col < C_RG) {
    } else if (col < C_AQ) { o = silu_f(v);
    } else if (col < C_AV) {
        if (!isctx) {
            const int d = (col - C_AQ) & 63, hf = d >> 5, dd = d & 31, j = dd & 15;
            const int pos = hf == 0 ? (t >> 6) : (t & 63);
            const float inv = powf(10000.f, -(float)j / 16.f), ang = (float)pos * inv; float sn, cs; sincosf(ang, &sn, &cs);
            if (dd < 16) o = v * cs - tr[col + 16] * sn; else o = tr[col - 16] * sn + v * cs;
        }
        if (col < C_AK) o *= 0.125f * LOG2E;
    }
    proj[idx] = f2bf_n(o);
}
__global__ __launch_bounds__(128) void nv_ret_scan(const bf16* proj, const float* ret_decay, float* ofb) {
    const int h = blockIdx.x & 7, dir = blockIdx.x >> 3, v = threadIdx.x;
    const float gam = __expf(-__expf(ret_decay[dir * RH + h]));
    float S[64];
#pragma unroll
    for (int d = 0; d < 64; ++d) S[d] = 0.f;
    float* out = ofb + (size_t)dir * L * 1024 + h * 128 + v;
    for (int step = 0; step < LC + L; ++step) {
        int row; bool lat;
        if (dir == 0) { lat = step >= LC; row = lat ? step - LC : L + step; }
        else { lat = step >= LC; row = lat ? (L - 1 - (step - LC)) : (L + LC - 1 - step); }
        const bf16* pr = proj + (size_t)row * NPROJ;
        const float vv = bf2f(pr[C_RV + h * 128 + v]);
        float kf[64], qf[64];
#pragma unroll
        for (int i = 0; i < 8; ++i) { const u32x4 kk = *(const u32x4*)(pr + C_RK + h * 64 + i * 8); const u32x4 qq = *(const u32x4*)(pr + C_RQ + h * 64 + i * 8);
#pragma unroll
            for (int e = 0; e < 4; ++e) { kf[i * 8 + 2 * e] = __uint_as_float(kk[e] << 16); kf[i * 8 + 2 * e + 1] = __uint_as_float(kk[e] & 0xffff0000u);
                                          qf[i * 8 + 2 * e] = __uint_as_float(qq[e] << 16); qf[i * 8 + 2 * e + 1] = __uint_as_float(qq[e] & 0xffff0000u); } }
        if (dir == 0) {
            float o = 0.f;
#pragma unroll
            for (int d = 0; d < 64; ++d) { S[d] = gam * S[d] + kf[d] * vv; o += qf[d] * S[d]; }
            if (lat) out[(size_t)row * 1024] = o;
        } else {
            float o = 0.f;
#pragma unroll
            for (int d = 0; d < 64; ++d) { o += qf[d] * S[d]; S[d] = gam * S[d] + kf[d] * vv; }
            if (lat) out[(size_t)row * 1024] = gam * o;
        }
    }
}
__global__ __launch_bounds__(128) void nv_ret_out(const float* ofb, const bf16* proj, bf16* Y) {
    __shared__ float red[2];
    const int t = blockIdx.x >> 3, h = blockIdx.x & 7, v = threadIdx.x;
    const size_t i = (size_t)t * 1024 + h * 128 + v;
    const float o = ofb[i] + ofb[(size_t)L * 1024 + i];
    float ss = o * o;
#pragma unroll
    for (int k = 1; k < 64; k <<= 1) ss += __shfl_xor(ss, k);
    if ((v & 63) == 0) red[v >> 6] = ss;
    __syncthreads();
    const float r = rsqrtf((red[0] + red[1]) * (1.f / 128.f) + EPS);
    Y[(size_t)t * D + h * 128 + v] = f2bf_n(o * r * bf2f(proj[(size_t)t * NPROJ + C_RG + h * 128 + v]));
}
__global__ __launch_bounds__(64) void nv_attn(const bf16* proj, const float* sink, bf16* Y) {
    const int idx = blockIdx.x * 64 + threadIdx.x; const int hq = idx / L, t = idx % L, kvh = hq >> 2;
    float q[64], acc[64];
    const bf16* qp = proj + (size_t)t * NPROJ + C_AQ + hq * 64;
#pragma unroll
    for (int d = 0; d < 64; ++d) { q[d] = bf2f(qp[d]); acc[d] = 0.f; }
    float m = sink[hq] * LOG2E, l = 1.f;
    const int lo = t - WIN < 0 ? 0 : t - WIN, hi = t + WIN > L - 1 ? L - 1 : t + WIN;
    const int nloc = hi - lo + 1;
    for (int s = 0; s < nloc + LC; ++s) {
        const int row = s < nloc ? lo + s : L + (s - nloc);
        const bf16* kp = proj + (size_t)row * NPROJ + C_AK + kvh * 64; const bf16* vp = proj + (size_t)row * NPROJ + C_AV + kvh * 64;
        float sc = 0.f;
#pragma unroll
        for (int d = 0; d < 64; ++d) sc += q[d] * bf2f(kp[d]);
        float p;
        if (sc > m) { const float f = exp2f(m - sc); l *= f;
#pragma unroll
            for (int d = 0; d < 64; ++d) acc[d] *= f;
            m = sc; p = 1.f; }
        else p = exp2f(sc - m);
        l += p;
#pragma unroll
        for (int d = 0; d < 64; ++d) acc[d] += p * bf2f(vp[d]);
    }
    const float rl = 1.f / l;
    bf16* yp = Y + (size_t)t * D + 1024 + hq * 64;
#pragma unroll
    for (int d = 0; d < 64; ++d) yp[d] = f2bf_n(acc[d] * rl);
}
__global__ __launch_bounds__(256) void nv_final_norm(float* xio, const float* g) {
    __shared__ float red[4];
    float* x = xio + (size_t)blockIdx.x * D;
    float v[8]; float ss = 0.f;
#pragma unroll
    for (int i = 0; i < 8; ++i) { v[i] = x[threadIdx.x + 256 * i]; ss += v[i] * v[i]; }
#pragma unroll
    for (int o = 1; o < 64; o <<= 1) ss += __shfl_xor(ss, o);
    if ((threadIdx.x & 63) == 0) red[threadIdx.x >> 6] = ss;
    __syncthreads();
    const float r = rsqrtf((red[0] + red[1] + red[2] + red[3]) * (1.f / D) + EPS);
#pragma unroll
    for (int i = 0; i < 8; ++i) { const int c = threadIdx.x + 256 * i; x[c] = v[i] * r * g[c]; }
}

namespace pg8 {
#define PG8_LAS __attribute__((address_space(3)))
typedef unsigned short bf16_t;
typedef short bf16x8 __attribute__((ext_vector_type(8)));
typedef float f32x4 __attribute__((ext_vector_type(4)));
typedef unsigned u32x4 __attribute__((ext_vector_type(4)));
constexpr int BM = 256, BK = 64, HALF = 128, HTB = HALF * BK * 2  , STAGE_BYTES = 8 * HTB, NXCD = 8, WGM = 8;

__host__ __device__ __forceinline__ int lds_byte(int r, int c) { const int st = (r >> 4) * 2 + (c >> 5), rr = r & 15, cc = c & 31, ob = rr * 64 + cc * 2; return st * 1024 + (ob ^ (((ob >> 9) & 1) << 5)); }
__host__ __device__ __forceinline__ void stage_rc(int b, int& R, int& C) { const int st = b / 1024, sb = b % 1024, swz = sb ^ (((sb >> 9) & 1) << 5); R = (st >> 1) * 16 + swz / 64; C = (st & 1) * 32 + (swz % 64) / 2; }
__host__ __device__ __forceinline__ int perm32(int rho) { const int n = rho >> 4, i = rho & 15; return 8 * (i >> 2) + 4 * n + (i & 3); }

struct Unit { int pm, pn; };
struct Gemm { const bf16_t* A; const bf16_t* Bt; int M, N, K; };

struct StaticOrder {
    int nM, nN, nwg, G, c;
    __host__ __device__ void init(int M, int N, int G_, int c_) { nM = M / BM; nN = N / BM; nwg = nM * nN; G = G_; c = c_; }
    __host__ __device__ bool next(int i, Unit& u) const {
        const long L = (long)i * G + c; if (L >= nwg) return false;
        int wgid = (int)L; { const int q = nwg / NXCD, r = nwg % NXCD, xcd = wgid % NXCD, off = wgid / NXCD; wgid = (xcd < r ? xcd * (q + 1) : r * (q + 1) + (xcd - r) * q) + off; }
        const int nig = WGM * nN, gid = wgid / nig, fm = gid * WGM, gsz = (nM - fm) < WGM ? (nM - fm) : WGM;
        u.pm = fm + ((wgid % nig) % gsz); u.pn = (wgid % nig) / gsz; return true;
    }
    __device__ __forceinline__ void a_ready(const Unit&) const {}
    __device__ __forceinline__ void done(const Unit&) const {}
};
__device__ __forceinline__ unsigned cvt_pk_bf16(float lo, float hi) { unsigned r; asm volatile("v_cvt_pk_bf16_f32 %0, %1, %2" : "=v"(r) : "v"(lo), "v"(hi)); return r; }
typedef float f32x2 __attribute__((ext_vector_type(2)));
template <class Epi, class Sched, bool ALIGN_EPI = false, bool SP2 = false>
__device__ __forceinline__ void gemm_phase(PG8_LAS unsigned char* lds, const Gemm g, const Sched& S, const Epi& E) {
    const int tid = threadIdx.x, wid = __builtin_amdgcn_readfirstlane(tid >> 6), lane = tid & 63, wr = wid >> 2, wc = wid & 3, fr = lane & 15, fq = lane >> 4;
    const int K = g.K, nt = K / BK;
    unsigned voffA[2], voffB[2];
#pragma unroll
    for (int i = 0; i < 2; ++i) { int R, C; stage_rc(tid * 16 + i * 8192, R, C); const int Rb = Epi::PERM ? ((R & ~31) + perm32(R & 31)) : R;
        voffA[i] = (unsigned)(R * K + C) * 2u; voffB[i] = (unsigned)(Rb * K + C) * 2u; }
    const size_t kstep = (size_t)(BK * 2);
    const size_t hstep = (size_t)HALF * K * 2;
    const size_t tstep = 2 * hstep;
    const unsigned ldsw = (unsigned)wid * 1024u;
    const int aoff = lds_byte(wr * 64 + fr, fq * 8), boff = lds_byte(wc * 32 + fr, fq * 8);
#define PG8_SA(b, h) (((b) * 2 + (h)) * HTB)
#define PG8_SB(b, h) ((4 + (b) * 2 + (h)) * HTB)
#define PG8_STAGE(bufoff, gbase, voff) do { _Pragma("unroll") for (int _i = 0; _i < 2; ++_i) \
        __builtin_amdgcn_global_load_lds((const unsigned*)((const char*)(gbase) + (voff)[_i]), (PG8_LAS unsigned*)(lds + (bufoff) + ldsw + _i * 8192), 16, 0, 0); } while (0)
#define PG8_LDA(dst, b, h) do { _Pragma("unroll") for (int m = 0; m < 4; ++m) _Pragma("unroll") for (int k = 0; k < 2; ++k) dst[m][k] = *(const PG8_LAS bf16x8*)(lds + PG8_SA(b, h) + aoff + m * 2048 + k * 1024); } while (0)
#define PG8_LDB(dst, b, h) do { _Pragma("unroll") for (int n = 0; n < 2; ++n) _Pragma("unroll") for (int k = 0; k < 2; ++k) dst[n][k] = *(const PG8_LAS bf16x8*)(lds + PG8_SB(b, h) + boff + n * 2048 + k * 1024); } while (0)
#define PG8_MMA(ai, bj, At, Bt) do { __builtin_amdgcn_s_setprio(1); _Pragma("unroll") for (int m = 0; m < 4; ++m) _Pragma("unroll") for (int n = 0; n < 2; ++n) _Pragma("unroll") for (int k = 0; k < 2; ++k) \
        acc[ai][bj][m][n] = __builtin_amdgcn_mfma_f32_16x16x32_bf16(Bt[n][k], At[m][k], acc[ai][bj][m][n], 0, 0, 0); __builtin_amdgcn_s_setprio(0); } while (0)
#define PG8_WAIT_V(n) asm volatile("s_waitcnt vmcnt(" #n ")" ::: "memory")
#define PG8_WAIT_L(n) asm volatile("s_waitcnt lgkmcnt(" #n ")" ::: "memory")
#define PG8_BAR __builtin_amdgcn_s_barrier()
#define PG8_SCHED __builtin_amdgcn_sched_barrier(0)
    Unit cur, nxt; int ui = 0;
    if (!S.next(0, cur)) return;
    f32x4 acc[2][2][4][2];
#pragma unroll
    for (int a = 0; a < 2; ++a)
#pragma unroll
        for (int b = 0; b < 2; ++b)
#pragma unroll
            for (int m = 0; m < 4; ++m)
#pragma unroll
                for (int n = 0; n < 2; ++n) acc[a][b][m][n] = (f32x4){0.f, 0.f, 0.f, 0.f};
    bf16x8 At[4][2], B0[2][2], B1[2][2];
    const char* cA = (const char*)g.A + (size_t)cur.pm * tstep; const char* cB = (const char*)g.Bt + (size_t)cur.pn * tstep;
    S.a_ready(cur);
    if constexpr (SP2) {
        PG8_STAGE(PG8_SB(0, 0), cB, voffB); PG8_STAGE(PG8_SB(0, 1), cB + hstep, voffB); PG8_STAGE(PG8_SA(0, 0), cA, voffA); PG8_STAGE(PG8_SA(0, 1), cA + hstep, voffA);
        if (wr == 1) PG8_BAR;
        PG8_WAIT_V(2); PG8_BAR;
        PG8_STAGE(PG8_SB(1, 0), cB + kstep, voffB); PG8_STAGE(PG8_SA(1, 0), cA + kstep, voffA); PG8_STAGE(PG8_SB(1, 1), cB + hstep + kstep, voffB);
        PG8_WAIT_V(6); PG8_BAR;
    } else {
        PG8_STAGE(PG8_SB(0, 0), cB, voffB); PG8_STAGE(PG8_SA(0, 0), cA, voffA); PG8_STAGE(PG8_SB(0, 1), cB + hstep, voffB); PG8_STAGE(PG8_SA(0, 1), cA + hstep, voffA);
        if (wr == 1) PG8_BAR;
        PG8_WAIT_V(4); PG8_BAR;
        PG8_STAGE(PG8_SB(1, 0), cB + kstep, voffB); PG8_STAGE(PG8_SA(1, 0), cA + kstep, voffA); PG8_STAGE(PG8_SB(1, 1), cB + hstep + kstep, voffB);
        PG8_WAIT_V(6); PG8_BAR;
    }
    for (;;) {
        const bool has_next = S.next(ui + 1, nxt);
        const char* nA = has_next ? (const char*)g.A + (size_t)nxt.pm * tstep : cA; const char* nB = has_next ? (const char*)g.Bt + (size_t)nxt.pn * tstep : cB;
        for (int t = 0; t < nt; t += 2) {
            const bool last = (t == nt - 2);
            const char* a1 = cA + (size_t)(t + 1) * kstep;
            const char* a2 = last ? nA : cA + (size_t)(t + 2) * kstep; const char* b2 = last ? nB : cB + (size_t)(t + 2) * kstep;
            const char* a3 = a2 + kstep; const char* b3 = b2 + kstep;
            if (last && has_next) S.a_ready(nxt);
            if constexpr (SP2) {
            PG8_LDB(B0, 0, 0); PG8_LDB(B1, 0, 1); PG8_SCHED; PG8_LDA(At, 0, 0); PG8_STAGE(PG8_SA(1, 1), a1 + hstep, voffA);
            PG8_WAIT_V(8); PG8_WAIT_L(0); PG8_BAR; PG8_MMA(0, 0, At, B0); PG8_MMA(0, 1, At, B1); PG8_BAR; PG8_SCHED;
            PG8_LDA(At, 0, 1); PG8_STAGE(PG8_SB(0, 0), b2, voffB); PG8_STAGE(PG8_SB(0, 1), b2 + hstep, voffB); PG8_STAGE(PG8_SA(0, 0), a2, voffA);
            PG8_WAIT_V(8); PG8_WAIT_L(0); PG8_BAR; PG8_MMA(1, 0, At, B0); PG8_MMA(1, 1, At, B1); PG8_BAR; PG8_SCHED;
            PG8_LDB(B0, 1, 0); PG8_LDB(B1, 1, 1); PG8_SCHED; PG8_LDA(At, 1, 0); PG8_STAGE(PG8_SA(0, 1), a2 + hstep, voffA);
            PG8_WAIT_V(8); PG8_WAIT_L(0); PG8_BAR; PG8_MMA(0, 0, At, B0); PG8_MMA(0, 1, At, B1); PG8_BAR; PG8_SCHED;
            PG8_LDA(At, 1, 1); PG8_STAGE(PG8_SB(1, 0), b3, voffB); PG8_STAGE(PG8_SB(1, 1), b3 + hstep, voffB); PG8_STAGE(PG8_SA(1, 0), a3, voffA);
            PG8_WAIT_V(8); PG8_WAIT_L(0); PG8_BAR; PG8_MMA(1, 0, At, B0); PG8_MMA(1, 1, At, B1); PG8_BAR; PG8_SCHED;
            } else {
            PG8_LDB(B0, 0, 0); PG8_SCHED; PG8_LDA(At, 0, 0); PG8_STAGE(PG8_SA(1, 1), a1 + hstep, voffA);
            PG8_WAIT_L(8); PG8_BAR; PG8_WAIT_L(0); PG8_MMA(0, 0, At, B0); PG8_BAR; PG8_SCHED;
            PG8_LDB(B1, 0, 1); PG8_STAGE(PG8_SB(0, 0), b2, voffB);
            PG8_BAR; PG8_WAIT_L(0); PG8_MMA(0, 1, At, B1); PG8_BAR;
            PG8_LDA(At, 0, 1); PG8_STAGE(PG8_SA(0, 0), a2, voffA);
            PG8_BAR; PG8_WAIT_L(0); PG8_MMA(1, 0, At, B0); PG8_BAR; PG8_SCHED;
            PG8_STAGE(PG8_SB(0, 1), b2 + hstep, voffB);
            PG8_WAIT_V(6); PG8_BAR; PG8_MMA(1, 1, At, B1); PG8_BAR;
            PG8_LDB(B0, 1, 0); PG8_SCHED; PG8_LDA(At, 1, 0); PG8_STAGE(PG8_SA(0, 1), a2 + hstep, voffA);
            PG8_WAIT_L(8); PG8_BAR; PG8_WAIT_L(0); PG8_MMA(0, 0, At, B0); PG8_BAR; PG8_SCHED;
            PG8_LDB(B1, 1, 1); PG8_STAGE(PG8_SB(1, 0), b3, voffB);
            PG8_BAR; PG8_WAIT_L(0); PG8_MMA(0, 1, At, B1); PG8_BAR;
            PG8_LDA(At, 1, 1); PG8_STAGE(PG8_SA(1, 0), a3, voffA);
            PG8_BAR; PG8_WAIT_L(0); PG8_MMA(1, 0, At, B0); PG8_BAR; PG8_SCHED;
            PG8_STAGE(PG8_SB(1, 1), b3 + hstep, voffB);
            PG8_WAIT_V(6); PG8_BAR; PG8_MMA(1, 1, At, B1); PG8_BAR;
            }
        }
        if constexpr (ALIGN_EPI) { if (wr == 0) PG8_BAR; }
        if constexpr (!Epi::AFTER_DRAIN) { E(acc, cur, wr, wc, fr, fq); S.done(cur); }
        if (!has_next) break;
#pragma unroll
        for (int a = 0; a < 2; ++a)
#pragma unroll
            for (int b = 0; b < 2; ++b)
#pragma unroll
                for (int m = 0; m < 4; ++m)
#pragma unroll
                    for (int n = 0; n < 2; ++n) acc[a][b][m][n] = (f32x4){0.f, 0.f, 0.f, 0.f};
        cur = nxt; cA = nA; cB = nB; ++ui;
        if constexpr (ALIGN_EPI) { if (wr == 1) PG8_BAR; }
    }
    PG8_WAIT_V(0);
    if constexpr (!ALIGN_EPI) { if (wr == 0) PG8_BAR; }
    PG8_BAR;
    if constexpr (Epi::AFTER_DRAIN) { E.fused(acc, cur, wr, wc, fr, fq, lds, wid, lane); S.done(cur); }
#undef PG8_SA
#undef PG8_SB
#undef PG8_STAGE
#undef PG8_LDA
#undef PG8_LDB
#undef PG8_MMA
#undef PG8_WAIT_V
#undef PG8_WAIT_L
#undef PG8_BAR
#undef PG8_SCHED
}
}
namespace pg8 {
__device__ __forceinline__ float silu_fast(float x) { return x * __builtin_amdgcn_rcpf(1.f + __expf(-x)); }
struct EpiProj {
    static constexpr bool PERM = true, AFTER_DRAIN = false;
    bf16_t* P; const float* rtc; const float* rts; const float* axc; const float* axs;
    __device__ __forceinline__ void operator()(const f32x4 (&acc)[2][2][4][2], const Unit& u, int wr, int wc, int fr, int fq) const {
        const int pn = u.pn; const bool isctx = (u.pm == 32);
        const int row0 = u.pm * BM + wr * 64 + fr;
        int type = 0; float sc = 1.f;
        if (pn < 4) { type = 2; if (pn >= 2) sc = 0.125f; }
        else if (pn < 8) type = 0;
        else if (pn < 12) type = 1;
        else if (pn < 17) { type = 3; if (pn < 16) sc = 0.125f * 1.4426950408889634f; }
        if (type < 2) {
#pragma unroll
            for (int ai = 0; ai < 2; ++ai)
#pragma unroll
                for (int m = 0; m < 4; ++m) { bf16_t* rowp = P + (size_t)(row0 + ai * HALF + m * 16) * 4608 + pn * BM + wc * 32 + 8 * fq;
#pragma unroll
                    for (int bj = 0; bj < 2; ++bj) { f32x4 v0 = acc[ai][bj][m][0], v1 = acc[ai][bj][m][1];
                        if (type == 1) {
#pragma unroll
                            for (int e = 0; e < 4; ++e) { v0[e] = silu_fast(v0[e]); v1[e] = silu_fast(v1[e]); } }
                        u32x4 w; w.x = cvt_pk_bf16(v0[0], v0[1]); w.y = cvt_pk_bf16(v0[2], v0[3]); w.z = cvt_pk_bf16(v1[0], v1[1]); w.w = cvt_pk_bf16(v1[2], v1[3]);
                        *(u32x4*)(rowp + bj * HALF) = w; } }
        } else {
            const int hf = fq >> 1;
#pragma unroll
            for (int ai = 0; ai < 2; ++ai)
#pragma unroll
                for (int m = 0; m < 4; ++m) { const int r = row0 + ai * HALF + m * 16;
                    f32x4 cs[2], sn[2];
                    if (isctx) { cs[0] = cs[1] = (f32x4){1.f, 1.f, 1.f, 1.f}; sn[0] = sn[1] = (f32x4){0.f, 0.f, 0.f, 0.f}; }
                    else if (type == 2) { const size_t o = (size_t)r * 32 + 8 * fq; cs[0] = *(const f32x4*)(rtc + o); cs[1] = *(const f32x4*)(rtc + o + 4); sn[0] = *(const f32x4*)(rts + o); sn[1] = *(const f32x4*)(rts + o + 4); }
                    else { const int pos = hf ? (r & 63) : (r >> 6); const int o = pos * 16 + 8 * (fq & 1); cs[0] = *(const f32x4*)(axc + o); cs[1] = *(const f32x4*)(axc + o + 4); sn[0] = *(const f32x4*)(axs + o); sn[1] = *(const f32x4*)(axs + o + 4); }
                    f32x4 o1[2], o2[2];
#pragma unroll
                    for (int n = 0; n < 2; ++n) { const f32x4 x1 = acc[ai][0][m][n], x2 = acc[ai][1][m][n]; o1[n] = (x1 * cs[n] - x2 * sn[n]) * sc; o2[n] = (x1 * sn[n] + x2 * cs[n]) * sc; }
                    u32x4 w1, w2; w1.x = cvt_pk_bf16(o1[0][0], o1[0][1]); w1.y = cvt_pk_bf16(o1[0][2], o1[0][3]); w1.z = cvt_pk_bf16(o1[1][0], o1[1][1]); w1.w = cvt_pk_bf16(o1[1][2], o1[1][3]);
                    w2.x = cvt_pk_bf16(o2[0][0], o2[0][1]); w2.y = cvt_pk_bf16(o2[0][2], o2[0][3]); w2.z = cvt_pk_bf16(o2[1][0], o2[1][1]); w2.w = cvt_pk_bf16(o2[1][2], o2[1][3]);
                    bf16_t* rowp = P + (size_t)r * 4608 + pn * BM + wc * 64;
                    if (type == 2) { *(u32x4*)(rowp + 8 * fq) = w1; *(u32x4*)(rowp + 32 + 8 * fq) = w2; }
                    else { *(u32x4*)(rowp + 32 * hf + 8 * (fq & 1)) = w1; *(u32x4*)(rowp + 32 * hf + 16 + 8 * (fq & 1)) = w2; } }
        }
    }
};
struct EpiResid {
    static constexpr bool PERM = false, AFTER_DRAIN = false;
    const float* R; float* out; const float* gate; int ldc;
    __device__ __forceinline__ void operator()(const f32x4 (&acc)[2][2][4][2], const Unit& u, int wr, int wc, int fr, int fq) const {
        const int row0 = u.pm * BM + wr * 64 + fr, col0 = u.pn * BM + wc * 32 + 4 * fq;
        f32x4 gv[2][2];
#pragma unroll
        for (int bj = 0; bj < 2; ++bj)
#pragma unroll
            for (int n = 0; n < 2; ++n) gv[bj][n] = *(const f32x4*)(gate + col0 + bj * HALF + n * 16);
#pragma unroll
        for (int ai = 0; ai < 2; ++ai)
#pragma unroll
            for (int m = 0; m < 4; ++m) { const size_t off = (size_t)(row0 + ai * HALF + m * 16) * ldc + col0;
#pragma unroll
                for (int bj = 0; bj < 2; ++bj)
#pragma unroll
                    for (int n = 0; n < 2; ++n) { const f32x4 rs = *(const f32x4*)(R + off + bj * HALF + n * 16); *(f32x4*)(out + off + bj * HALF + n * 16) = rs + gv[bj][n] * acc[ai][bj][m][n]; } }
    }
};
struct EpiSwiglu {
    static constexpr bool PERM = true, AFTER_DRAIN = false;
    bf16_t* O; int ldc;
    __device__ __forceinline__ void operator()(const f32x4 (&acc)[2][2][4][2], const Unit& u, int wr, int wc, int fr, int fq) const {
        const int row0 = u.pm * BM + wr * 64 + fr, col0 = u.pn * HALF + wc * 32 + 8 * fq;
#pragma unroll
        for (int ai = 0; ai < 2; ++ai)
#pragma unroll
            for (int m = 0; m < 4; ++m) { f32x4 v[2];
#pragma unroll
                for (int n = 0; n < 2; ++n) { const f32x4 g = acc[ai][0][m][n], up = acc[ai][1][m][n];
#pragma unroll
                    for (int e = 0; e < 4; ++e) v[n][e] = silu_fast(g[e]) * up[e]; }
                u32x4 w; w.x = cvt_pk_bf16(v[0][0], v[0][1]); w.y = cvt_pk_bf16(v[0][2], v[0][3]); w.z = cvt_pk_bf16(v[1][0], v[1][1]); w.w = cvt_pk_bf16(v[1][2], v[1][3]);
                *(u32x4*)(O + (size_t)(row0 + ai * HALF + m * 16) * ldc + col0) = w; }
    }
};
}
#define GAS __attribute__((address_space(1)))
#define LAS __attribute__((address_space(3)))
typedef unsigned short bf16;
typedef unsigned v4u __attribute__((ext_vector_type(4)));
typedef float f32x4 __attribute__((ext_vector_type(4)));
typedef short bf16x8 __attribute__((ext_vector_type(8)));
typedef GAS unsigned gu32;
typedef GAS unsigned long long gu64;
#define RLX_AGENT __ATOMIC_RELAXED, __HIP_MEMORY_SCOPE_AGENT
#define LDS_WAIT() asm volatile("s_waitcnt lgkmcnt(0)" ::: "memory")
#define VM_WAIT() asm volatile("s_waitcnt vmcnt(0)" ::: "memory")
__device__ __forceinline__ unsigned long long rt() { return __builtin_amdgcn_s_memrealtime(); }
__device__ __forceinline__ unsigned f2bf(float f) { unsigned u = __builtin_bit_cast(unsigned, f); return (u + 0x7fffu + ((u >> 16) & 1u)) >> 16; }
__device__ __forceinline__ unsigned pk2(float lo, float hi) { return f2bf(lo) | (f2bf(hi) << 16); }
#define XB_TMO      128
#define XB_XCNT(j)  (256  + 64 * (j))
#define XB_XSUB(j)  (1280 + 64 * (j))
#define XB_XGEN(j)  (2304 + 64 * (j))
#define XB_TOP      3328
#define XB_TOPGEN   3392
#define XCD_BAR_WORDS 3456
#define XB_SPIN_CAP (1u << 18)

__device__ __forceinline__ unsigned xb_ld(unsigned* p)              { return __hip_atomic_load(p, __ATOMIC_RELAXED, __HIP_MEMORY_SCOPE_AGENT); }
__device__ __forceinline__ unsigned xb_add(unsigned* p, unsigned v) { return __hip_atomic_fetch_add(p, v, __ATOMIC_RELAXED, __HIP_MEMORY_SCOPE_AGENT); }
__device__ __forceinline__ unsigned xb_xcc_id() { return (unsigned)__builtin_amdgcn_s_getreg((3 << 11) | 20) & 0xFu; }
#define XB_SPIN(cond, bar) do { unsigned _sp = 0; while (cond) { __builtin_amdgcn_s_sleep(1); \
    if ((++_sp & 255u) == 0u) { if (xb_ld(&(bar)[XB_TMO])) break; if (_sp > XB_SPIN_CAP) { atomicAdd(&(bar)[XB_TMO], 1u); break; } } } } while (0)

struct XcdBarrier {
    unsigned* bar; unsigned x;
    volatile LAS unsigned* st;
};

__device__ __forceinline__ XcdBarrier xcd_barrier_post(unsigned* bar, volatile LAS unsigned* st) {
    XcdBarrier b; b.bar = bar; b.x = xb_xcc_id(); b.st = st;
    if (threadIdx.x == 0) (void)xb_add(&bar[XB_XCNT(b.x)], 1u);
    return b;
}
__device__ __forceinline__ void xcd_barrier_complete(unsigned* bar, unsigned x, unsigned& nloc, unsigned& nx) {
    const unsigned G = gridDim.x * gridDim.y * gridDim.z;
    unsigned sum, cnt, mine, sp = 0u;
    for (;;) {
        sum = 0u; cnt = 0u; mine = 0u;
#pragma unroll
        for (unsigned j = 0; j < 16; ++j) { const unsigned c = xb_ld(&bar[XB_XCNT(j)]); sum += c; cnt += (c > 0u) ? 1u : 0u; mine = (j == x) ? c : mine; }
        if (sum == G) break;
        __builtin_amdgcn_s_sleep(1);
        if ((++sp & 255u) == 0u) { if (xb_ld(&bar[XB_TMO])) break; if (sp > XB_SPIN_CAP) { atomicAdd(&bar[XB_TMO], 1u); break; } }
    }
    nloc = mine > 0u ? mine : 1u; nx = cnt > 0u ? cnt : 1u;
}

__device__ __forceinline__ void xcd_barrier(const XcdBarrier& b) {
    asm volatile("s_waitcnt vmcnt(0)" ::: "memory");
    __syncthreads();
    if (threadIdx.x == 0) {
        unsigned* bar = b.bar;
        __builtin_amdgcn_s_waitcnt(0);
        unsigned nloc = b.st[0], nx = b.st[1];
        if (nloc == 0u) { xcd_barrier_complete(bar, b.x, nloc, nx); b.st[0] = nloc; b.st[1] = nx; }
        const unsigned old = xb_add(&bar[XB_XSUB(b.x)], 1u);
        const unsigned gen = old / nloc;
        if (old + 1u == (gen + 1u) * nloc) {
            __builtin_amdgcn_fence(__ATOMIC_RELEASE, "agent");
            asm volatile("s_waitcnt vmcnt(0)" ::: "memory");
            const unsigned og = xb_add(&bar[XB_TOP], 1u);
            const unsigned tg = og / nx;
            if (og + 1u == (tg + 1u) * nx) xb_add(&bar[XB_TOPGEN], 1u);
            else XB_SPIN(xb_ld(&bar[XB_TOPGEN]) == tg, bar);
            __builtin_amdgcn_fence(__ATOMIC_ACQUIRE, "agent");
            xb_add(&bar[XB_XGEN(b.x)], 1u);
            asm volatile("s_waitcnt vmcnt(0)" ::: "memory");
        } else {
            XB_SPIN(xb_ld(&bar[XB_XGEN(b.x)]) == gen, bar);
            __builtin_amdgcn_fence(__ATOMIC_ACQUIRE, "agent");
            asm volatile("s_waitcnt vmcnt(0)" ::: "memory");
        }
    }
    __syncthreads();
}
constexpr int NWAVES = 8;
constexpr int RING_OFF = 0, RING_BYTES = 131072;
constexpr int LDSCTL_OFF = RING_BYTES, MISC_OFF = LDSCTL_OFF + 320;
constexpr int LDS_BYTES = 147456;
constexpr size_t WS_MODACC = 512 * 1024;
constexpr size_t WS_RT = 2 * MiB;
constexpr size_t WS_AXT = 4 * MiB;
constexpr size_t WS_WIN = 8 * MiB, WS_WOUT = 26 * MiB, WS_WGU = 34 * MiB, WS_WDN = 78 * MiB;
constexpr size_t WS_KVT = 241 * MiB;
constexpr size_t WS_SPT = 274 * MiB;
constexpr int CW_TMO = 0, CW_CODE = 1, CW_BAR = 4096;

typedef short s16x4 __attribute__((ext_vector_type(4)));
typedef short v4i16_t __attribute__((ext_vector_type(4)));
__device__ __forceinline__ s16x4 vtr(const LAS unsigned char* p) { return __builtin_bit_cast(s16x4, __builtin_amdgcn_ds_read_tr16_b64_v4i16((LAS v4i16_t*)p)); }
__device__ __forceinline__ bf16x8 cat8(s16x4 lo, s16x4 hi) { return (bf16x8){lo[0], lo[1], lo[2], lo[3], hi[0], hi[1], hi[2], hi[3]}; }
struct Frame {
    LAS unsigned char* lds; volatile LAS unsigned* MISC; gu32* ctl;
    int tid, lane, wave, vcu, G;
};
__device__ __forceinline__ float wave_sum(float v) {
#pragma unroll
    for (int o = 1; o < 64; o <<= 1) v += __shfl_xor(v, o);
    return v;
}
__device__ __forceinline__ int sigma_in(int p) {
    const int pn = p >> 8, q = p & 255, bj = q >> 7, wc = (q >> 5) & 3, off = q & 31;
    if (pn < 4) return pn * 256 + wc * 64 + bj * 32 + off;
    if (pn >= 12 && pn < 17) return pn * 256 + wc * 64 + (off >> 4) * 32 + bj * 16 + (off & 15);
    return p;
}
__device__ __forceinline__ void tr64_item(const float* W, int K, int N, bf16* WT, int p0, int k0, int srccol4, LAS unsigned char* scr, int lane) {
    const int fr = lane & 15, fq = lane >> 4;
    f32x4 t[16];
#pragma unroll
    for (int i = 0; i < 16; ++i) t[i] = *(const GAS f32x4*)(W + (size_t)(k0 + 4 * i + fq) * N + srccol4);
#pragma unroll
    for (int i = 0; i < 16; ++i) *(LAS unsigned long long*)(scr + (4 * i + fq) * 160 + fr * 8) = (unsigned long long)pg8::cvt_pk_bf16(t[i].x, t[i].y) | ((unsigned long long)pg8::cvt_pk_bf16(t[i].z, t[i].w) << 32);
    LDS_WAIT(); asm volatile("" ::: "memory");
#pragma unroll
    for (int ng = 0; ng < 4; ++ng)
#pragma unroll
        for (int kh = 0; kh < 2; ++kh) { const LAS unsigned char* p = scr + (32 * kh + 8 * fq + (fr >> 2)) * 160 + 32 * ng + 8 * (fr & 3);
            const bf16x8 o = cat8(vtr(p), vtr(p + 4 * 160));
            *(GAS bf16x8*)(WT + (size_t)(p0 + 16 * ng + fr) * K + k0 + 32 * kh + 8 * fq) = o; }
    LDS_WAIT(); asm volatile("" ::: "memory");
}
struct Args { const float* in[16]; float* out; unsigned char* ws; int ph_lo, ph_hi, li, pad; };

__device__ __forceinline__ void p0_prologue(Frame& F, const Args& a, bool do_atomics) {
    LAS unsigned char* scr = F.lds + RING_OFF + F.wave * 16384;
    const int gw = F.vcu * NWAVES + F.wave, NGW = F.G * NWAVES, lane = F.lane;
    const float* w_mod = a.in[4]; const float* w_in = a.in[8];
    float* modacc = (float*)(a.ws + WS_MODACC);
    constexpr int I_GEMV = 48 * 32, I_RT = 128, I_AX = 1, I_IN = 72 * 32;
    constexpr int NITEMS = I_GEMV + I_RT + I_AX + I_IN;
    for (int it = gw; it < NITEMS; it += NGW) {
        int r = it;
        if (r < I_GEMV) {
            const int strip = r % 48, ks = r / 48; const int n = strip * 256 + 4 * lane;
            f32x4 a0 = {0.f, 0.f, 0.f, 0.f}, a1 = {0.f, 0.f, 0.f, 0.f};
            const float cv = a.in[1][ks * 64 + lane], cc = a.in[3][ks * 64 + lane];
            const float s0 = cv / (1.f + __expf(-cv)), s1 = cc / (1.f + __expf(-cc));
#pragma unroll 16
            for (int k = 0; k < 64; ++k) { const f32x4 w = *(const GAS f32x4*)(w_mod + (size_t)(ks * 64 + k) * (6 * D) + n);
                const float t0 = __shfl(s0, k), t1 = __shfl(s1, k); a0 += w * t0; a1 += w * t1; }
            if (ks == 0) { const f32x4 b = *(const f32x4*)(a.in[5] + n); a0 += b; a1 += b; }
#pragma unroll
            for (int e = 0; e < 4; ++e) { if (do_atomics) { unsafeAtomicAdd(modacc + n + e, a0[e]); unsafeAtomicAdd(modacc + 6 * D + n + e, a1[e]); } else asm volatile("" :: "v"(a0[e]), "v"(a1[e])); }
            continue; }
        r -= I_GEMV;
        if (r < I_RT) {
            const int t = r * 64 + lane; float* rc = (float*)(a.ws + WS_RT); float* rs = (float*)(a.ws + WS_RT + MiB);
            for (int j = 0; j < 32; ++j) { const float inv = powf(10000.f, -(float)j / 32.f), ang = (float)t * inv; float sn, cs; sincosf(ang, &sn, &cs); rc[t * 32 + j] = cs; rs[t * 32 + j] = sn; }
            continue; }
        r -= I_RT;
        if (r < I_AX) {
            float* ac = (float*)(a.ws + WS_AXT); float* as = (float*)(a.ws + WS_AXT + 8192);
            for (int i = lane; i < 128 * 16; i += 64) { const int pos = i >> 4, j = i & 15; const float inv = powf(10000.f, -(float)j / 16.f), ang = (float)pos * inv; float sn, cs; sincosf(ang, &sn, &cs); ac[i] = cs; as[i] = sn; }
            continue; }
        r -= I_AX;
        { const int grp = r % 72, kb = r / 72; tr64_item(w_in, D, NPROJ, (bf16*)(a.ws + WS_WIN), grp * 64, kb * 64, sigma_in(grp * 64 + 4 * (lane & 15)), scr, lane); }
    }
}
__device__ __forceinline__ void p0_deferred(Frame& F, const Args& a, int which, int gwf, int ngwf) {
    LAS unsigned char* scr = F.lds + RING_OFF + F.wave * 16384; const int lane = F.lane;
    const float* w_out = a.in[11]; const float* w_gate = a.in[12]; const float* w_up = a.in[13]; const float* w_down = a.in[14];
    constexpr int I_OUT = 32 * 32, I_GU = 176 * 32, I_DN = 32 * 88;
    if (which == 0) {
        for (int it = gwf; it < I_GU + I_OUT; it += ngwf) {
            int r = it;
            if (r < I_GU) { const int grp = r % 176, kb = r / 176; const int pn = grp >> 2, gg = grp & 3;
                tr64_item((gg >> 1) ? w_up : w_gate, D, DFF, (bf16*)(a.ws + WS_WGU), grp * 64, kb * 64, pn * 128 + (gg & 1) * 64 + 4 * (lane & 15), scr, lane); continue; }
            r -= I_GU;
            { const int grp = r % 32, kb = r / 32; tr64_item(w_out, D, D, (bf16*)(a.ws + WS_WOUT), grp * 64, kb * 64, grp * 64 + 4 * (lane & 15), scr, lane); }
        }
    } else {
        for (int it = gwf; it < I_DN; it += ngwf) { const int grp = it % 32, kb = it / 32; tr64_item(w_down, DFF, D, (bf16*)(a.ws + WS_WDN), grp * 64, kb * 64, grp * 64 + 4 * (lane & 15), scr, lane); }
    }
}
__device__ __forceinline__ void modulate_row(const float* xrow, const float* g, const float* shift, const float* scale, bf16* orow, int lane) {
    const GAS f32x4* xr = (const GAS f32x4*)xrow + lane;
    f32x4 v[8]; float s = 0.f;
#pragma unroll
    for (int j = 0; j < 8; ++j) { v[j] = xr[64 * j]; s += (v[j].x * v[j].x + v[j].y * v[j].y) + (v[j].z * v[j].z + v[j].w * v[j].w); }
    const float r = rsqrtf(wave_sum(s) * (1.f / D) + EPS);
    GAS unsigned long long* o8 = (GAS unsigned long long*)orow + lane;
#pragma unroll
    for (int j = 0; j < 8; ++j) { const int c = 4 * lane + 256 * j; const f32x4 gg = *(const f32x4*)(g + c), sh = *(const f32x4*)(shift + c), sc = *(const f32x4*)(scale + c);
        const f32x4 y = v[j] * r * gg * (sc + 1.f) + sh;
        o8[64 * j] = (unsigned long long)pk2(y.x, y.y) | ((unsigned long long)pk2(y.z, y.w) << 32); }
}
__device__ __forceinline__ void modulate_row2(const float* x1, const float* x2, const float* g, const float* sh1, const float* sc1, const float* sh2, const float* sc2, bf16* o1, bf16* o2, int lane) {
    const GAS f32x4* xr1 = (const GAS f32x4*)x1 + lane; const GAS f32x4* xr2 = (const GAS f32x4*)x2 + lane;
    f32x4 v[8], u[8]; float s = 0.f, t = 0.f;
#pragma unroll
    for (int j = 0; j < 8; ++j) { v[j] = xr1[64 * j]; u[j] = xr2[64 * j]; }
#pragma unroll
    for (int j = 0; j < 8; ++j) { s += (v[j].x * v[j].x + v[j].y * v[j].y) + (v[j].z * v[j].z + v[j].w * v[j].w); t += (u[j].x * u[j].x + u[j].y * u[j].y) + (u[j].z * u[j].z + u[j].w * u[j].w); }
    const float r1 = rsqrtf(wave_sum(s) * (1.f / D) + EPS), r2 = rsqrtf(wave_sum(t) * (1.f / D) + EPS);
    GAS unsigned long long* p1 = (GAS unsigned long long*)o1 + lane; GAS unsigned long long* p2 = (GAS unsigned long long*)o2 + lane;
#pragma unroll
    for (int j = 0; j < 8; ++j) { const int c = 4 * lane + 256 * j; const f32x4 gg = *(const f32x4*)(g + c);
        const f32x4 y = v[j] * r1 * gg * (*(const f32x4*)(sc1 + c) + 1.f) + *(const f32x4*)(sh1 + c);
        const f32x4 z = u[j] * r2 * gg * (*(const f32x4*)(sc2 + c) + 1.f) + *(const f32x4*)(sh2 + c);
        p1[64 * j] = (unsigned long long)pk2(y.x, y.y) | ((unsigned long long)pk2(y.z, y.w) << 32);
        p2[64 * j] = (unsigned long long)pk2(z.x, z.y) | ((unsigned long long)pk2(z.z, z.w) << 32); }
}
__device__ __forceinline__ void final_norm_row(const float* xrow, float* orow, const float* g, int lane) {
    const GAS f32x4* xr = (const GAS f32x4*)xrow + lane; GAS f32x4* xo = (GAS f32x4*)orow + lane;
    f32x4 v[8]; float s = 0.f;
#pragma unroll
    for (int j = 0; j < 8; ++j) { v[j] = xr[64 * j]; s += (v[j].x * v[j].x + v[j].y * v[j].y) + (v[j].z * v[j].z + v[j].w * v[j].w); }
    const float r = rsqrtf(wave_sum(s) * (1.f / D) + EPS);
#pragma unroll
    for (int j = 0; j < 8; ++j) { const f32x4 gg = *(const f32x4*)(g + 4 * lane + 256 * j); xo[64 * j] = v[j] * r * gg; }
}

__device__ __forceinline__ f32x4 mfma16(bf16x8 a, bf16x8 b, f32x4 c) { return __builtin_amdgcn_mfma_f32_16x16x32_bf16(a, b, c, 0, 0, 0); }
__device__ __forceinline__ float ex2(float x) { return __builtin_amdgcn_exp2f(x); }
__device__ __forceinline__ unsigned pk2f(float lo, float hi) { return pg8::cvt_pk_bf16(lo, hi); }
constexpr int RSV = 288;
constexpr int RSK = 160;
__device__ __forceinline__ bf16x8 tr_frag(const LAS unsigned char* tile, int rs, int r0, int cb, int fr, int fq) {
    const LAS unsigned char* p = tile + (r0 + 4 * fq + (fr >> 2)) * rs + cb + 8 * (fr & 3);
    return cat8(vtr(p), vtr(p + 16 * rs));
}

__device__ __forceinline__ void ret_kv_item(Frame& F, const bf16* PROJ, float* KVT, int cc, int h, float lf2, float lb2) {
    const int lane = F.lane, fr = lane & 15, fq = lane >> 4, w = F.wave, tid = F.tid;
    const int row0 = cc < 2 ? L + 128 * cc : 128 * (cc - 2);
    LAS unsigned char* Vl = F.lds; LAS unsigned char* Kf = F.lds + 128 * RSV; LAS unsigned char* Kb = Kf + 128 * RSK;
    __syncthreads();
#pragma unroll
    for (int p = 0; p < 4; ++p) { const int idx = p * 512 + tid, row = idx >> 4, ch = idx & 15;
        const v4u v = *(const GAS v4u*)(PROJ + (size_t)(row0 + row) * NPROJ + C_RV + h * 128 + ch * 8); *(LAS v4u*)(Vl + row * RSV + ch * 16) = v; }
#pragma unroll
    for (int p = 0; p < 2; ++p) { const int idx = p * 512 + tid, row = idx >> 3, ch = idx & 7;
        const v4u v = *(const GAS v4u*)(PROJ + (size_t)(row0 + row) * NPROJ + C_RK + h * 64 + ch * 8);
        const float wf = ex2(lf2 * (float)(127 - row)), wb = ex2(lb2 * (float)row);
        v4u of, ob;
#pragma unroll
        for (int e = 0; e < 4; ++e) { const float lo = __uint_as_float(v[e] << 16), hi = __uint_as_float(v[e] & 0xffff0000u); of[e] = pk2f(lo * wf, hi * wf); ob[e] = pk2f(lo * wb, hi * wb); }
        *(LAS v4u*)(Kf + row * RSK + ch * 16) = of; *(LAS v4u*)(Kb + row * RSK + ch * 16) = ob; }
    __syncthreads();
    bf16x8 aV[4];
#pragma unroll
    for (int st = 0; st < 4; ++st) aV[st] = tr_frag(Vl, RSV, 32 * st, 32 * w, fr, fq);
#pragma unroll
    for (int dir = 0; dir < 2; ++dir) { const LAS unsigned char* Kx = dir ? Kb : Kf;
        float* outp = KVT + (((size_t)dir * 66 + cc) * 8 + h) * 8192 + (16 * w + 4 * fq) * 64 + fr;
#pragma unroll
        for (int dt = 0; dt < 4; ++dt) { f32x4 acc = {0.f, 0.f, 0.f, 0.f};
#pragma unroll
            for (int st = 0; st < 4; ++st) acc = mfma16(aV[st], tr_frag(Kx, RSK, 32 * st, 32 * dt, fr, fq), acc);
#pragma unroll
            for (int r = 0; r < 4; ++r) outp[r * 64 + 16 * dt] = acc[r]; } }
}
__device__ __forceinline__ void ret_scan_phase(Frame& F, const float* KVT, bf16* SPT, const float* ret_decay) {
    const int nthr = F.G * 512;
    for (int e = F.vcu * 512 + F.tid; e < 2 * 8 * 8192; e += nthr) {
        const int dir = e >> 16, h = (e >> 13) & 7, vd = e & 8191;
        const float g = __expf(-128.f * __expf(ret_decay[dir * 8 + h]));
        const float* kv = KVT + ((size_t)dir * 66 * 8 + h) * 8192 + vd;
        bf16* sp = SPT + ((size_t)dir * 64 * 8 + h) * 8192 + vd;
        float S = 0.f;
        if (dir == 0) { S = kv[0]; S = g * S + kv[65536];
#pragma unroll 8
            for (int c = 0; c < 64; ++c) { sp[(size_t)c * 65536] = (bf16)f2bf(S); S = g * S + kv[(size_t)(2 + c) * 65536]; } }
        else { S = kv[65536]; S = g * S + kv[0];
#pragma unroll 8
            for (int c = 63; c >= 0; --c) { sp[(size_t)c * 65536] = (bf16)f2bf(S); S = g * S + kv[(size_t)(2 + c) * 65536]; } }
    }
}
__device__ __forceinline__ void ret_out_item(Frame& F, const bf16* PROJ, const bf16* SPT, bf16* Y, int c, int h, float lf2, float lb2) {
    const int lane = F.lane, fr = lane & 15, fq = lane >> 4, w = F.wave, tid = F.tid;
    const int t0 = c * 128;
    LAS unsigned char* Vl = F.lds;
    __syncthreads();
#pragma unroll
    for (int p = 0; p < 4; ++p) { const int idx = p * 512 + tid, row = idx >> 4, ch = idx & 15;
        const v4u v = *(const GAS v4u*)(PROJ + (size_t)(t0 + row) * NPROJ + C_RV + h * 128 + ch * 8); *(LAS v4u*)(Vl + row * RSV + ch * 16) = v; }
    const int il = 16 * w + fr;
    const bf16* qrow = PROJ + (size_t)(t0 + il) * NPROJ + C_RQ + h * 64 + 8 * fq;
    bf16x8 qB[2]; qB[0] = *(const GAS bf16x8*)(qrow); qB[1] = *(const GAS bf16x8*)(qrow + 32);
    const float wf = ex2(lf2 * (float)(il + 1)), wb = ex2(lb2 * (float)(128 - il));
    const bf16* Sf = SPT + ((size_t)(0 * 64 + c) * 8 + h) * 8192 + fr * 64 + 8 * fq;
    const bf16* Sb = SPT + ((size_t)(1 * 64 + c) * 8 + h) * 8192 + fr * 64 + 8 * fq;
    f32x4 O[8];
#pragma unroll
    for (int vt = 0; vt < 8; ++vt) { f32x4 xf = {0.f, 0.f, 0.f, 0.f}, xb = {0.f, 0.f, 0.f, 0.f};
#pragma unroll
        for (int s = 0; s < 2; ++s) { xf = mfma16(*(const GAS bf16x8*)(Sf + vt * 1024 + 32 * s), qB[s], xf); xb = mfma16(*(const GAS bf16x8*)(Sb + vt * 1024 + 32 * s), qB[s], xb); }
        O[vt] = xf * wf + xb * wb; }
    unsigned pt[8][2];
    const bf16* krow = PROJ + (size_t)(t0 + fr) * NPROJ + C_RK + h * 64 + 8 * fq;
#pragma unroll
    for (int T = 0; T < 8; ++T) { f32x4 st = {0.f, 0.f, 0.f, 0.f};
#pragma unroll
        for (int s = 0; s < 2; ++s) st = mfma16(*(const GAS bf16x8*)(krow + (size_t)(16 * T) * NPROJ + 32 * s), qB[s], st);
#pragma unroll
        for (int r = 0; r < 4; ++r) { const int diff = il - (16 * T + 4 * fq + r); st[r] *= diff >= 0 ? ex2(lf2 * (float)diff) : ex2(lb2 * (float)(-diff)); }
        pt[T][0] = pk2f(st[0], st[1]); pt[T][1] = pk2f(st[2], st[3]); }
    __syncthreads();
#pragma unroll
    for (int st = 0; st < 4; ++st) { const v4u pw = {pt[2 * st][0], pt[2 * st][1], pt[2 * st + 1][0], pt[2 * st + 1][1]}; const bf16x8 pb = __builtin_bit_cast(bf16x8, pw);
#pragma unroll
        for (int vt = 0; vt < 8; ++vt) O[vt] = mfma16(tr_frag(Vl, RSV, 32 * st, 32 * vt, fr, fq), pb, O[vt]); }
    float ss = 0.f;
#pragma unroll
    for (int vt = 0; vt < 8; ++vt) ss += (O[vt][0] * O[vt][0] + O[vt][1] * O[vt][1]) + (O[vt][2] * O[vt][2] + O[vt][3] * O[vt][3]);
    ss += __shfl_xor(ss, 16); ss += __shfl_xor(ss, 32);
    const float r = rsqrtf(ss * (1.f / 128.f) + EPS);
    const bf16* grow = PROJ + (size_t)(t0 + il) * NPROJ + C_RG + h * 128 + 4 * fq;
    bf16* yrow = Y + (size_t)(t0 + il) * D + h * 128 + 4 * fq;
#pragma unroll
    for (int vt = 0; vt < 8; ++vt) { const unsigned long long gw = *(const GAS unsigned long long*)(grow + 16 * vt); const unsigned g0 = (unsigned)gw, g1 = (unsigned)(gw >> 32);
        const float y0 = O[vt][0] * r * __uint_as_float(g0 << 16), y1 = O[vt][1] * r * __uint_as_float(g0 & 0xffff0000u), y2 = O[vt][2] * r * __uint_as_float(g1 << 16), y3 = O[vt][3] * r * __uint_as_float(g1 & 0xffff0000u);
        *(GAS unsigned long long*)(yrow + 16 * vt) = (unsigned long long)pk2f(y0, y1) | ((unsigned long long)pk2f(y2, y3) << 32); }
}
constexpr int ATT_ROWS = 640;
__device__ __forceinline__ void attn_item(Frame& F, const bf16* PROJ, const float* sink, bf16* Y, int b, int kvh) {
    const int lane = F.lane, fr = lane & 15, fq = lane >> 4, w = F.wave, tid = F.tid;
    LAS unsigned char* Vl = F.lds;
    __syncthreads();
#pragma unroll
    for (int p = 0; p < 10; ++p) { const int idx = p * 512 + tid, row = idx >> 3, ch = idx & 7;
        int src; bool ok = true;
        if (row < 384) { const int key = 128 * b - 128 + row; ok = key >= 0 && key < L; src = ok ? key : 0; } else src = L + (row - 384);
        v4u v = *(const GAS v4u*)(PROJ + (size_t)src * NPROJ + C_AV + kvh * 64 + ch * 8);
        if (!ok) v = (v4u){0u, 0u, 0u, 0u};
        *(LAS v4u*)(Vl + row * RSK + ch * 16) = v; }
    const int iq = 128 * b + 16 * w + fr;
    bf16x8 qB[4][2]; float m[4], l[4]; f32x4 O[4][4];
#pragma unroll
    for (int g = 0; g < 4; ++g) { const bf16* qrow = PROJ + (size_t)iq * NPROJ + C_AQ + (4 * kvh + g) * 64 + 8 * fq;
        qB[g][0] = *(const GAS bf16x8*)(qrow); qB[g][1] = *(const GAS bf16x8*)(qrow + 32);
        m[g] = sink[4 * kvh + g] * LOG2E; l[g] = fq == 0 ? 1.f : 0.f;
#pragma unroll
        for (int dt = 0; dt < 4; ++dt) O[g][dt] = (f32x4){0.f, 0.f, 0.f, 0.f}; }
    __syncthreads();
    const bf16* kbase = PROJ + C_AK + kvh * 64 + 8 * fq;
#define ATT_KLOAD(dst, stp) do { const bool il_ = (stp) < 9; const int lr_ = il_ ? 32 * ((w >> 1) + (stp)) : 384 + 32 * ((stp) - 9); \
        _Pragma("unroll") for (int tt = 0; tt < 2; ++tt) { int kr; \
            if (il_) { kr = 128 * b - 128 + lr_ + 16 * tt + fr; kr = kr < 0 ? 0 : (kr > L - 1 ? L - 1 : kr); } else kr = L + (lr_ - 384) + 16 * tt + fr; \
            const bf16* kp = kbase + (size_t)kr * NPROJ; dst[tt][0] = *(const GAS bf16x8*)(kp); dst[tt][1] = *(const GAS bf16x8*)(kp + 32); } } while (0)
    bf16x8 kA[2][2], kN[2][2];
    ATT_KLOAD(kA, 0);
    for (int step = 0; step < 17; ++step) {
        const bool isloc = step < 9;
        const int ldsrow0 = isloc ? 32 * ((w >> 1) + step) : 384 + 32 * (step - 9);
        const int key0 = 128 * b - 128 + ldsrow0;
        { const int nstep = step < 16 ? step + 1 : 16; ATT_KLOAD(kN, nstep); }
        bf16x8 vA[4];
#pragma unroll
        for (int dt = 0; dt < 4; ++dt) vA[dt] = tr_frag(Vl, RSK, ldsrow0, 32 * dt, fr, fq);
#pragma unroll
        for (int g = 0; g < 4; ++g) {
            f32x4 s0 = {0.f, 0.f, 0.f, 0.f}, s1 = {0.f, 0.f, 0.f, 0.f};
            s0 = mfma16(kA[0][0], qB[g][0], s0); s0 = mfma16(kA[0][1], qB[g][1], s0);
            s1 = mfma16(kA[1][0], qB[g][0], s1); s1 = mfma16(kA[1][1], qB[g][1], s1);
            if (isloc) {
#pragma unroll
                for (int r = 0; r < 4; ++r) { const int k0 = key0 + 4 * fq + r, k1 = k0 + 16; const int d0 = iq - k0, d1 = iq - k1;
                    if (!(k0 >= 0 && k0 < L && d0 <= WIN && d0 >= -WIN)) s0[r] = -INFINITY;
                    if (!(k1 >= 0 && k1 < L && d1 <= WIN && d1 >= -WIN)) s1[r] = -INFINITY; } }
            float mx = fmaxf(fmaxf(fmaxf(s0[0], s0[1]), fmaxf(s0[2], s0[3])), fmaxf(fmaxf(s1[0], s1[1]), fmaxf(s1[2], s1[3])));
            mx = fmaxf(mx, __shfl_xor(mx, 16)); mx = fmaxf(mx, __shfl_xor(mx, 32));
            const float mn = fmaxf(m[g], mx), alpha = ex2(m[g] - mn); m[g] = mn;
            float ps = 0.f;
#pragma unroll
            for (int r = 0; r < 4; ++r) { s0[r] = ex2(s0[r] - mn); s1[r] = ex2(s1[r] - mn); ps += s0[r] + s1[r]; }
            l[g] = l[g] * alpha + ps;
            const v4u pw = {pk2f(s0[0], s0[1]), pk2f(s0[2], s0[3]), pk2f(s1[0], s1[1]), pk2f(s1[2], s1[3])}; const bf16x8 pb = __builtin_bit_cast(bf16x8, pw);
#pragma unroll
            for (int dt = 0; dt < 4; ++dt) { O[g][dt] *= alpha; O[g][dt] = mfma16(vA[dt], pb, O[g][dt]); }
        }
#pragma unroll
        for (int tt = 0; tt < 2; ++tt) { kA[tt][0] = kN[tt][0]; kA[tt][1] = kN[tt][1]; }
    }
#undef ATT_KLOAD
#pragma unroll
    for (int g = 0; g < 4; ++g) { float lt = l[g]; lt += __shfl_xor(lt, 16); lt += __shfl_xor(lt, 32); const float inv = 1.f / lt;
        bf16* yrow = Y + (size_t)iq * D + 1024 + (4 * kvh + g) * 64 + 4 * fq;
#pragma unroll
        for (int dt = 0; dt < 4; ++dt) *(GAS unsigned long long*)(yrow + 16 * dt) = (unsigned long long)pk2f(O[g][dt][0] * inv, O[g][dt][1] * inv) | ((unsigned long long)pk2f(O[g][dt][2] * inv, O[g][dt][3] * inv) << 32); }
}
__global__ void __launch_bounds__(NWAVES * 64, 2) mk_fwd(Args args) {
    extern __shared__ __attribute__((aligned(16))) unsigned char lds[];
    Frame F;
    F.lds = (LAS unsigned char*)lds;
    F.MISC = (volatile LAS unsigned*)(F.lds + MISC_OFF);
    F.tid = threadIdx.x; F.lane = F.tid & 63; F.wave = __builtin_amdgcn_readfirstlane(F.tid >> 6);
    F.G = gridDim.x; { const int bx = blockIdx.x; F.vcu = (F.G % 8 == 0) ? (bx % 8) * (F.G / 8) + bx / 8 : bx; }
    unsigned char* ws = args.ws;
    F.ctl = (gu32*)(ws + WS_CTL);
    for (int u = F.tid; u < (LDS_BYTES - LDSCTL_OFF) / 4; u += NWAVES * 64) ((LAS unsigned*)(F.lds + LDSCTL_OFF))[u] = 0u;
    __syncthreads();
    XcdBarrier bar = xcd_barrier_post((unsigned*)(F.ctl + CW_BAR) + args.li * XCD_BAR_WORDS, F.MISC + 8);
    const int lo = args.ph_lo, hi = args.ph_hi;
#define IN(k) (lo <= (k) && (k) < hi)
#define BOTH(k) (IN(k) && IN((k) + 1))
#define REP(k) for (int rep_ = 0; rep_ < 1 + ((PROBE_DBL >> (k)) & 1); ++rep_)
#define DUMMY(k) (((PROBE_DBL >> (k)) & 1) && rep_ == 0)
    const float* mod = (const float*)(ws + WS_MODACC);
    bf16* HX = (bf16*)(ws + WS_HX); bf16* PROJ = (bf16*)(ws + WS_PROJ); bf16* Y = (bf16*)(ws + WS_Y); bf16* ACT = (bf16*)(ws + WS_ACT);
    const int gw = F.vcu * NWAVES + F.wave, NGW = F.G * NWAVES;

    if (IN(0)) REP(0) { p0_prologue(F, args, rep_ == 0); if (BOTH(0)) xcd_barrier(bar); }
    if (IN(1)) REP(1) {
        for (int m = gw; m < MROWS; m += 2 * NGW) {
            const int m2 = m + NGW < MROWS ? m + NGW : m;
            const float* src = m < L ? args.in[0] + (size_t)m * D : args.in[2] + (size_t)(m - L) * D; const float* mb = m < L ? mod : mod + 6 * D;
            const float* src2 = m2 < L ? args.in[0] + (size_t)m2 * D : args.in[2] + (size_t)(m2 - L) * D; const float* mb2 = m2 < L ? mod : mod + 6 * D;
            modulate_row2(src, src2, args.in[6], mb, mb + D, mb2, mb2 + D, HX + (size_t)m * D, HX + (size_t)m2 * D, F.lane); }
        if (BOTH(1)) xcd_barrier(bar);
    }
    if (IN(2)) REP(2) {
        pg8::Gemm g{HX, (const bf16*)(ws + WS_WIN), MROWS, NPROJ, D}; pg8::StaticOrder S; S.init(MROWS, NPROJ, F.G, (int)blockIdx.x);
        pg8::EpiProj E{PROJ, (const float*)(ws + WS_RT), (const float*)(ws + WS_RT + MiB), (const float*)(ws + WS_AXT), (const float*)(ws + WS_AXT + 8192)};
        pg8::gemm_phase<pg8::EpiProj, pg8::StaticOrder, true, true>(F.lds + RING_OFF, g, S, E);
        { const int extra = S.nwg % F.G; const int c = (int)blockIdx.x;
            if (extra == 0) p0_deferred(F, args, 0, c * NWAVES + F.wave, F.G * NWAVES);
            else if (c >= extra) p0_deferred(F, args, 0, (c - extra) * NWAVES + F.wave, (F.G - extra) * NWAVES); }
        if (BOTH(2)) xcd_barrier(bar);
    }
    if (IN(3)) REP(3) {
        const float* rd = args.in[9];
        for (int it = F.vcu; it < 256; it += F.G) attn_item(F, PROJ, args.in[10], Y, it >> 2, it & 3);
        for (int it = F.vcu; it < 528; it += F.G) { const int cc = it >> 3, h = it & 7;
            ret_kv_item(F, PROJ, (float*)(ws + WS_KVT), cc, h, -__expf(rd[h]) * LOG2E, -__expf(rd[8 + h]) * LOG2E); }
        if (BOTH(3)) xcd_barrier(bar);
    }
    if (IN(4)) REP(4) { ret_scan_phase(F, (const float*)(ws + WS_KVT), (bf16*)(ws + WS_SPT), args.in[9]); if (BOTH(4)) xcd_barrier(bar); }
    if (IN(5)) REP(5) {
        const float* rd = args.in[9];
        for (int it = F.vcu; it < 512; it += F.G) { const int c = it >> 3, h = it & 7;
            ret_out_item(F, PROJ, (const bf16*)(ws + WS_SPT), Y, c, h, -__expf(rd[h]) * LOG2E, -__expf(rd[8 + h]) * LOG2E); }
        if (BOTH(5)) xcd_barrier(bar);
    }
    if (IN(6)) REP(6) {
        pg8::Gemm g{Y, (const bf16*)(ws + WS_WOUT), L, D, D}; pg8::StaticOrder S; S.init(L, D, F.G, (int)blockIdx.x);
        pg8::EpiResid E{args.in[0], args.out, mod + 2 * D, D};
        pg8::gemm_phase<pg8::EpiResid, pg8::StaticOrder, true, true>(F.lds + RING_OFF, g, S, E);
        if (BOTH(6)) xcd_barrier(bar);
    }
    if (IN(7)) REP(7) {
        for (int m = gw; m < L; m += 2 * NGW) { const int m2 = m + NGW < L ? m + NGW : m;
            modulate_row2(args.out + (size_t)m * D, args.out + (size_t)m2 * D, args.in[7], mod + 3 * D, mod + 4 * D, mod + 3 * D, mod + 4 * D, HX + (size_t)m * D, HX + (size_t)m2 * D, F.lane); }
        if (BOTH(7)) xcd_barrier(bar);
    }
    if (IN(8)) REP(8) {
        pg8::Gemm g{HX, (const bf16*)(ws + WS_WGU), L, 2 * DFF, D}; pg8::StaticOrder S; S.init(L, 2 * DFF, F.G, (int)blockIdx.x);
        pg8::EpiSwiglu E{ACT, DFF};
        pg8::gemm_phase<pg8::EpiSwiglu, pg8::StaticOrder, true, true>(F.lds + RING_OFF, g, S, E);
        if (!(((PROBE_DBL >> 8) & 1) && rep_ == 1)) { const int extra = S.nwg % F.G; const int c = (int)blockIdx.x;
            if (extra == 0) p0_deferred(F, args, 1, c * NWAVES + F.wave, F.G * NWAVES);
            else if (c >= extra) p0_deferred(F, args, 1, (c - extra) * NWAVES + F.wave, (F.G - extra) * NWAVES); }
        if (BOTH(8)) xcd_barrier(bar);
    }
    if (IN(9)) REP(9) {
        pg8::Gemm g{ACT, (const bf16*)(ws + WS_WDN), L, D, DFF}; pg8::StaticOrder S; S.init(L, D, F.G, (int)blockIdx.x);
        pg8::EpiResid E{args.out, DUMMY(9) ? (float*)(ws + WS_PROJ) : args.out, mod + 5 * D, D};
        pg8::gemm_phase<pg8::EpiResid, pg8::StaticOrder, true, true>(F.lds + RING_OFF, g, S, E);
        if (BOTH(9)) xcd_barrier(bar);
    }
    if (IN(10)) REP(10) { float* dst = DUMMY(10) ? (float*)(ws + WS_PROJ) : args.out; for (int m = gw; m < L; m += NGW) final_norm_row(args.out + (size_t)m * D, dst + (size_t)m * D, args.in[15], F.lane); }
#undef IN
#undef REP
#undef DUMMY
#undef BOTH
}

extern "C" void kernel_launch(void* const* d_in, const int* in_sizes, int n_in, void* d_out, int out_size, void* d_ws, size_t ws_size, hipStream_t stream) {
    static int grid = 0;
    if (grid == 0) {
        if (n_in != 16 || in_sizes[0] != L * D || out_size != L * D || ws_size < WS_END) { fprintf(stderr, "kernel_launch: unexpected shapes (n_in %d, in0 %d, out %d, ws %zu)\n", n_in, n_in > 0 ? in_sizes[0] : -1, out_size, ws_size); grid = -1; return; }
        int dev = 0, cus = 0, per_cu = 0;
        if (hipGetDevice(&dev) != hipSuccess || hipDeviceGetAttribute(&cus, hipDeviceAttributeMultiprocessorCount, dev) != hipSuccess) { grid = -1; return; }
        if (hipFuncSetAttribute((const void*)mk_fwd, hipFuncAttributeMaxDynamicSharedMemorySize, LDS_BYTES) != hipSuccess) { fprintf(stderr, "kernel_launch: hipFuncSetAttribute failed\n"); grid = -1; return; }
        if (hipOccupancyMaxActiveBlocksPerMultiprocessor(&per_cu, (const void*)mk_fwd, NWAVES * 64, LDS_BYTES) != hipSuccess || per_cu < 1) { fprintf(stderr, "kernel_launch: occupancy query says %d blocks per CU\n", per_cu); grid = -1; (void)hipGetLastError(); return; }
        (void)hipGetLastError();
        grid = cus;
    }
    if (grid < 0) return;
    unsigned char* ws = (unsigned char*)d_ws;
    hipMemsetAsync(ws + WS_CTL, 0, CTL_BYTES, stream);
    Args a{};
    for (int i = 0; i < 16; ++i) a.in[i] = (const float*)d_in[i];
    a.out = (float*)d_out; a.ws = ws;
    a.ph_lo = 0; a.ph_hi = 11; a.li = 0;
    hipLaunchKernelGGL(mk_fwd, dim3(grid), dim3(NWAVES * 64), LDS_BYTES, stream, a);
}
```

```cpp
#ifndef PROBE_DBL
#define PROBE_DBL 0
#endif
#include <hip/hip_runtime.h>
#include <cstdio>
#include <cstdint>
#include <cmath>

typedef unsigned short bf16;
typedef unsigned u32x4 __attribute__((ext_vector_type(4)));
typedef float f32x4 __attribute__((ext_vector_type(4)));

constexpr int D = 2048, L = 8192, LC = 256, MROWS = L + LC;
constexpr int NPROJ = 4608, DFF = 5632;
constexpr int RH = 8, RDK = 64, RDV = 128, CH = 128, NCH = L / CH;
constexpr int AH = 16, AKV = 4, ADH = 64, WIN = 128;
constexpr float EPS = 1e-6f;
constexpr float LOG2E = 1.4426950408889634f;
constexpr int C_RQ = 0, C_RK = 512, C_RV = 1024, C_RG = 2048, C_AQ = 3072, C_AK = 4096, C_AV = 4352;

constexpr size_t MiB = 1u << 20;
constexpr size_t WS_CTL = 0, CTL_BYTES = 1 * MiB;
constexpr size_t WS_MOD = 1 * MiB;
constexpr size_t WS_HX = 100 * MiB;
constexpr size_t WS_PROJ = 134 * MiB;
constexpr size_t WS_Y = 209 * MiB;
constexpr size_t WS_ACT = 290 * MiB;
constexpr size_t WS_TMP = 209 * MiB;
constexpr size_t WS_OFB = 290 * MiB;
constexpr size_t WS_END = 384 * MiB;

__device__ __forceinline__ float bf2f(bf16 v) { return __uint_as_float((unsigned)v << 16); }
__device__ __forceinline__ bf16 f2bf_n(float f) { unsigned u = __float_as_uint(f); return (bf16)((u + 0x7fffu + ((u >> 16) & 1u)) >> 16); }
__device__ __forceinline__ float silu_f(float x) { return x / (1.f + __expf(-x)); }

__global__ __launch_bounds__(256) void nv_mod(const float* c, const float* cctx, const float* w_mod, const float* b_mod, float* mod) {
    __shared__ float s[2][D];
    for (int i = threadIdx.x; i < D; i += 256) { s[0][i] = silu_f(c[i]); s[1][i] = silu_f(cctx[i]); }
    __syncthreads();
    const int n = blockIdx.x * 256 + threadIdx.x;
    float a0 = 0.f, a1 = 0.f;
    for (int k = 0; k < D; ++k) { const float w = w_mod[(size_t)k * (6 * D) + n]; a0 += s[0][k] * w; a1 += s[1][k] * w; }
    mod[n] = a0 + b_mod[n]; mod[6 * D + n] = a1 + b_mod[n];
}
__global__ __launch_bounds__(256) void nv_modulate(const float* src, const float* g, const float* shift, const float* scale, bf16* out) {
    __shared__ float red[4];
    const int row = blockIdx.x; const float* x = src + (size_t)row * D;
    float v[8]; float ss = 0.f;
#pragma unroll
    for (int i = 0; i < 8; ++i) { v[i] = x[threadIdx.x + 256 * i]; ss += v[i] * v[i]; }
#pragma unroll
    for (int o = 1; o < 64; o <<= 1) ss += __shfl_xor(ss, o);
    if ((threadIdx.x & 63) == 0) red[threadIdx.x >> 6] = ss;
    __syncthreads();
    const float r = rsqrtf((red[0] + red[1] + red[2] + red[3]) * (1.f / D) + EPS);
#pragma unroll
    for (int i = 0; i < 8; ++i) { const int cidx = threadIdx.x + 256 * i; out[(size_t)row * D + cidx] = f2bf_n(v[i] * r * g[cidx] * (1.f + scale[cidx]) + shift[cidx]); }
}
template <int MODE> __global__ __launch_bounds__(256) void nv_gemm(const bf16* A, int lda, const float* B, const float* B2, int ldb, int K,
                                                                     float* Cf, bf16* Cb, int ldc, const float* R, const float* gate) {
    __shared__ float As[16][132]; __shared__ float Bs[16][64]; __shared__ float Bs2[16][64];
    const int tid = threadIdx.x, tx = tid & 15, ty = tid >> 4;
    const int m0 = blockIdx.y * 128, n0 = blockIdx.x * 64;
    float acc[8][4], acc2[8][4];
#pragma unroll
    for (int i = 0; i < 8; ++i)
#pragma unroll
        for (int j = 0; j < 4; ++j) { acc[i][j] = 0.f; acc2[i][j] = 0.f; }
    const int arow = tid >> 1, akh = (tid & 1) * 8, bk = tid >> 4, bn4 = (tid & 15) * 4;
    for (int k0 = 0; k0 < K; k0 += 16) {
        const u32x4 av = *(const u32x4*)(A + (size_t)(m0 + arow) * lda + k0 + akh);
        const f32x4 bv = *(const f32x4*)(B + (size_t)(k0 + bk) * ldb + n0 + bn4);
        f32x4 bv2 = bv; if (MODE == 1) bv2 = *(const f32x4*)(B2 + (size_t)(k0 + bk) * ldb + n0 + bn4);
#pragma unroll
        for (int i = 0; i < 4; ++i) { As[akh + 2 * i][arow] = __uint_as_float(av[i] << 16); As[akh + 2 * i + 1][arow] = __uint_as_float(av[i] & 0xffff0000u); }
        *(f32x4*)&Bs[bk][bn4] = bv; if (MODE == 1) *(f32x4*)&Bs2[bk][bn4] = bv2;
        __syncthreads();
#pragma unroll
        for (int k = 0; k < 16; ++k) {
            float a[8], b[4], b2[4];
#pragma unroll
            for (int i = 0; i < 8; ++i) a[i] = As[k][ty * 8 + i];
#pragma unroll
            for (int j = 0; j < 4; ++j) { b[j] = Bs[k][tx * 4 + j]; b2[j] = (MODE == 1) ? Bs2[k][tx * 4 + j] : 0.f; }
#pragma unroll
            for (int i = 0; i < 8; ++i)
#pragma unroll
                for (int j = 0; j < 4; ++j) { acc[i][j] += a[i] * b[j]; if (MODE == 1) acc2[i][j] += a[i] * b2[j]; }
        }
        __syncthreads();
    }
#pragma unroll
    for (int i = 0; i < 8; ++i)
#pragma unroll
        for (int j = 0; j < 4; ++j) {
            const size_t r = m0 + ty * 8 + i; const int cidx = n0 + tx * 4 + j;
            if (MODE == 0) Cf[r * ldc + cidx] = acc[i][j];
            if (MODE == 1) Cb[r * ldc + cidx] = f2bf_n(silu_f(acc[i][j]) * acc2[i][j]);
            if (MODE == 2) Cf[r * ldc + cidx] = R[r * ldc + cidx] + gate[cidx] * acc[i][j];
        }
}
__global__ __launch_bounds__(256) void nv_proj_epi(const float* tmp, bf16* proj) {
    const size_t idx = (size_t)blockIdx.x * 256 + threadIdx.x;
    const int row = (int)(idx / NPROJ), col = (int)(idx % NPROJ);
    const bool isctx = row >= L; const int t = row;
    const float* tr = tmp + (size_t)row * NPROJ;
    const float v = tr[col]; float o = v;
    if (col < C_RV) {
        if (!isctx) {
            const int d = col & 63, j = d & 31;
            const float inv = powf(10000.f, -(float)j / 32.f), ang = (float)t * inv; float sn, cs; sincosf(ang, &sn, &cs);
            if (d < 32) o = v * cs - tr[col + 32] * sn; else o = tr[col - 32] * sn + v * cs;
        }
        if (col >= C_RK) o *= 0.125f;
    } else if (col < C_RG) {
    } else if (col < C_AQ) { o = silu_f(v);
    } else if (col < C_AV) {
        if (!isctx) {
            const int d = (col - C_AQ) & 63, hf = d >> 5, dd = d & 31, j = dd & 15;
            const int pos = hf == 0 ? (t >> 6) : (t & 63);
            const float inv = powf(10000.f, -(float)j / 16.f), ang = (float)pos * inv; float sn, cs; sincosf(ang, &sn, &cs);
            if (dd < 16) o = v * cs - tr[col + 16] * sn; else o = tr[col - 16] * sn + v * cs;
        }
        if (col < C_AK) o *= 0.125f * LOG2E;
    }
    proj[idx] = f2bf_n(o);
}
__global__ __launch_bounds__(128) void nv_ret_scan(const bf16* proj, const float* ret_decay, float* ofb) {
    const int h = blockIdx.x & 7, dir = blockIdx.x >> 3, v = threadIdx.x;
    const float gam = __expf(-__expf(ret_decay[dir * RH + h]));
    float S[64];
#pragma unroll
    for (int d = 0; d < 64; ++d) S[d] = 0.f;
    float* out = ofb + (size_t)dir * L * 1024 + h * 128 + v;
    for (int step = 0; step < LC + L; ++step) {
        int row; bool lat;
        if (dir == 0) { lat = step >= LC; row = lat ? step - LC : L + step; }
        else { lat = step >= LC; row = lat ? (L - 1 - (step - LC)) : (L + LC - 1 - step); }
        const bf16* pr = proj + (size_t)row * NPROJ;
        const float vv = bf2f(pr[C_RV + h * 128 + v]);
        float kf[64], qf[64];
#pragma unroll
        for (int i = 0; i < 8; ++i) { const u32x4 kk = *(const u32x4*)(pr + C_RK + h * 64 + i * 8); const u32x4 qq = *(const u32x4*)(pr + C_RQ + h * 64 + i * 8);
#pragma unroll
            for (int e = 0; e < 4; ++e) { kf[i * 8 + 2 * e] = __uint_as_float(kk[e] << 16); kf[i * 8 + 2 * e + 1] = __uint_as_float(kk[e] & 0xffff0000u);
                                          qf[i * 8 + 2 * e] = __uint_as_float(qq[e] << 16); qf[i * 8 + 2 * e + 1] = __uint_as_float(qq[e] & 0xffff0000u); } }
        if (dir == 0) {
            float o = 0.f;
#pragma unroll
            for (int d = 0; d < 64; ++d) { S[d] = gam * S[d] + kf[d] * vv; o += qf[d] * S[d]; }
            if (lat) out[(size_t)row * 1024] = o;
        } else {
            float o = 0.f;
#pragma unroll
            for (int d = 0; d < 64; ++d) { o += qf[d] * S[d]; S[d] = gam * S[d] + kf[d] * vv; }
            if (lat) out[(size_t)row * 1024] = gam * o;
        }
    }
}
__global__ __launch_bounds__(128) void nv_ret_out(const float* ofb, const bf16* proj, bf16* Y) {
    __shared__ float red[2];
    const int t = blockIdx.x >> 3, h = blockIdx.x & 7, v = threadIdx.x;
    const size_t i = (size_t)t * 1024 + h * 128 + v;
    const float o = ofb[i] + ofb[(size_t)L * 1024 + i];
    float ss = o * o;
#pragma unroll
    for (int k = 1; k < 64; k <<= 1) ss += __shfl_xor(ss, k);
    if ((v & 63) == 0) red[v >> 6] = ss;
    __syncthreads();
    const float r = rsqrtf((red[0] + red[1]) * (1.f / 128.f) + EPS);
    Y[(size_t)t * D + h * 128 + v] = f2bf_n(o * r * bf2f(proj[(size_t)t * NPROJ + C_RG + h * 128 + v]));
}
__global__ __launch_bounds__(64) void nv_attn(const bf16* proj, const float* sink, bf16* Y) {
    const int idx = blockIdx.x * 64 + threadIdx.x; const int hq = idx / L, t = idx % L, kvh = hq >> 2;
    float q[64], acc[64];
    const bf16* qp = proj + (size_t)t * NPROJ + C_AQ + hq * 64;
#pragma unroll
    for (int d = 0; d < 64; ++d) { q[d] = bf2f(qp[d]); acc[d] = 0.f; }
    float m = sink[hq] * LOG2E, l = 1.f;
    const int lo = t - WIN < 0 ? 0 : t - WIN, hi = t + WIN > L - 1 ? L - 1 : t + WIN;
    const int nloc = hi - lo + 1;
    for (int s = 0; s < nloc + LC; ++s) {
        const int row = s < nloc ? lo + s : L + (s - nloc);
        const bf16* kp = proj + (size_t)row * NPROJ + C_AK + kvh * 64; const bf16* vp = proj + (size_t)row * NPROJ + C_AV + kvh * 64;
        float sc = 0.f;
#pragma unroll
        for (int d = 0; d < 64; ++d) sc += q[d] * bf2f(kp[d]);
        float p;
        if (sc > m) { const float f = exp2f(m - sc); l *= f;
#pragma unroll
            for (int d = 0; d < 64; ++d) acc[d] *= f;
            m = sc; p = 1.f; }
        else p = exp2f(sc - m);
        l += p;
#pragma unroll
        for (int d = 0; d < 64; ++d) acc[d] += p * bf2f(vp[d]);
    }
    const float rl = 1.f / l;
    bf16* yp = Y + (size_t)t * D + 1024 + hq * 64;
#pragma unroll
    for (int d = 0; d < 64; ++d) yp[d] = f2bf_n(acc[d] * rl);
}
__global__ __launch_bounds__(256) void nv_final_norm(float* xio, const float* g) {
    __shared__ float red[4];
    float* x = xio + (size_t)blockIdx.x * D;
    float v[8]; float ss = 0.f;
#pragma unroll
    for (int i = 0; i < 8; ++i) { v[i] = x[threadIdx.x + 256 * i]; ss += v[i] * v[i]; }
#pragma unroll
    for (int o = 1; o < 64; o <<= 1) ss += __shfl_xor(ss, o);
    if ((threadIdx.x & 63) == 0) red[threadIdx.x >> 6] = ss;
    __syncthreads();
    const float r = rsqrtf((red[0] + red[1] + red[2] + red[3]) * (1.f / D) + EPS);
#pragma unroll
    for (int i = 0; i < 8; ++i) { const int c = threadIdx.x + 256 * i; x[c] = v[i] * r * g[c]; }
}

namespace pg8 {
#define PG8_LAS __attribute__((address_space(3)))
typedef unsigned short bf16_t;
typedef short bf16x8 __attribute__((ext_vector_type(8)));
typedef float f32x4 __attribute__((ext_vector_type(4)));
typedef unsigned u32x4 __attribute__((ext_vector_type(4)));
constexpr int BM = 256, BK = 64, HALF = 128, HTB = HALF * BK * 2  , STAGE_BYTES = 8 * HTB, NXCD = 8, WGM = 8;

__host__ __device__ __forceinline__ int lds_byte(int r, int c) { const int st = (r >> 4) * 2 + (c >> 5), rr = r & 15, cc = c & 31, ob = rr * 64 + cc * 2; return st * 1024 + (ob ^ (((ob >> 9) & 1) << 5)); }
__host__ __device__ __forceinline__ void stage_rc(int b, int& R, int& C) { const int st = b / 1024, sb = b % 1024, swz = sb ^ (((sb >> 9) & 1) << 5); R = (st >> 1) * 16 + swz / 64; C = (st & 1) * 32 + (swz % 64) / 2; }
__host__ __device__ __forceinline__ int perm32(int rho) { const int n = rho >> 4, i = rho & 15; return 8 * (i >> 2) + 4 * n + (i & 3); }

struct Unit { int pm, pn; };
struct Gemm { const bf16_t* A; const bf16_t* Bt; int M, N, K; };

struct StaticOrder {
    int nM, nN, nwg, G, c;
    __host__ __device__ void init(int M, int N, int G_, int c_) { nM = M / BM; nN = N / BM; nwg = nM * nN; G = G_; c = c_; }
    __host__ __device__ bool next(int i, Unit& u) const {
        const long L = (long)i * G + c; if (L >= nwg) return false;
        int wgid = (int)L; { const int q = nwg / NXCD, r = nwg % NXCD, xcd = wgid % NXCD, off = wgid / NXCD; wgid = (xcd < r ? xcd * (q + 1) : r * (q + 1) + (xcd - r) * q) + off; }
        const int nig = WGM * nN, gid = wgid / nig, fm = gid * WGM, gsz = (nM - fm) < WGM ? (nM - fm) : WGM;
        u.pm = fm + ((wgid % nig) % gsz); u.pn = (wgid % nig) / gsz; return true;
    }
    __device__ __forceinline__ void a_ready(const Unit&) const {}
    __device__ __forceinline__ void done(const Unit&) const {}
};
__device__ __forceinline__ unsigned cvt_pk_bf16(float lo, float hi) { unsigned r; asm volatile("v_cvt_pk_bf16_f32 %0, %1, %2" : "=v"(r) : "v"(lo), "v"(hi)); return r; }
typedef float f32x2 __attribute__((ext_vector_type(2)));
template <class Epi, class Sched, bool ALIGN_EPI = false, bool SP2 = false>
__device__ __forceinline__ void gemm_phase(PG8_LAS unsigned char* lds, const Gemm g, const Sched& S, const Epi& E) {
    const int tid = threadIdx.x, wid = __builtin_amdgcn_readfirstlane(tid >> 6), lane = tid & 63, wr = wid >> 2, wc = wid & 3, fr = lane & 15, fq = lane >> 4;
    const int K = g.K, nt = K / BK;
    unsigned voffA[2], voffB[2];
#pragma unroll
    for (int i = 0; i < 2; ++i) { int R, C; stage_rc(tid * 16 + i * 8192, R, C); const int Rb = Epi::PERM ? ((R & ~31) + perm32(R & 31)) : R;
        voffA[i] = (unsigned)(R * K + C) * 2u; voffB[i] = (unsigned)(Rb * K + C) * 2u; }
    const size_t kstep = (size_t)(BK * 2);
    const size_t hstep = (size_t)HALF * K * 2;
    const size_t tstep = 2 * hstep;
    const unsigned ldsw = (unsigned)wid * 1024u;
    const int aoff = lds_byte(wr * 64 + fr, fq * 8), boff = lds_byte(wc * 32 + fr, fq * 8);
#define PG8_SA(b, h) (((b) * 2 + (h)) * HTB)
#define PG8_SB(b, h) ((4 + (b) * 2 + (h)) * HTB)
#define PG8_STAGE(bufoff, gbase, voff) do { _Pragma("unroll") for (int _i = 0; _i < 2; ++_i) \
        __builtin_amdgcn_global_load_lds((const unsigned*)((const char*)(gbase) + (voff)[_i]), (PG8_LAS unsigned*)(lds + (bufoff) + ldsw + _i * 8192), 16, 0, 0); } while (0)
#define PG8_LDA(dst, b, h) do { _Pragma("unroll") for (int m = 0; m < 4; ++m) _Pragma("unroll") for (int k = 0; k < 2; ++k) dst[m][k] = *(const PG8_LAS bf16x8*)(lds + PG8_SA(b, h) + aoff + m * 2048 + k * 1024); } while (0)
#define PG8_LDB(dst, b, h) do { _Pragma("unroll") for (int n = 0; n < 2; ++n) _Pragma("unroll") for (int k = 0; k < 2; ++k) dst[n][k] = *(const PG8_LAS bf16x8*)(lds + PG8_SB(b, h) + boff + n * 2048 + k * 1024); } while (0)
#define PG8_MMA(ai, bj, At, Bt) do { __builtin_amdgcn_s_setprio(1); _Pragma("unroll") for (int m = 0; m < 4; ++m) _Pragma("unroll") for (int n = 0; n < 2; ++n) _Pragma("unroll") for (int k = 0; k < 2; ++k) \
        acc[ai][bj][m][n] = __builtin_amdgcn_mfma_f32_16x16x32_bf16(Bt[n][k], At[m][k], acc[ai][bj][m][n], 0, 0, 0); __builtin_amdgcn_s_setprio(0); } while (0)
#define PG8_WAIT_V(n) asm volatile("s_waitcnt vmcnt(" #n ")" ::: "memory")
#define PG8_WAIT_L(n) asm volatile("s_waitcnt lgkmcnt(" #n ")" ::: "memory")
#define PG8_BAR __builtin_amdgcn_s_barrier()
#define PG8_SCHED __builtin_amdgcn_sched_barrier(0)
    Unit cur, nxt; int ui = 0;
    if (!S.next(0, cur)) return;
    f32x4 acc[2][2][4][2];
#pragma unroll
    for (int a = 0; a < 2; ++a)
#pragma unroll
        for (int b = 0; b < 2; ++b)
#pragma unroll
            for (int m = 0; m < 4; ++m)
#pragma unroll
                for (int n = 0; n < 2; ++n) acc[a][b][m][n] = (f32x4){0.f, 0.f, 0.f, 0.f};
    bf16x8 At[4][2], B0[2][2], B1[2][2];
    const char* cA = (const char*)g.A + (size_t)cur.pm * tstep; const char* cB = (const char*)g.Bt + (size_t)cur.pn * tstep;
    S.a_ready(cur);
    if constexpr (SP2) {
        PG8_STAGE(PG8_SB(0, 0), cB, voffB); PG8_STAGE(PG8_SB(0, 1), cB + hstep, voffB); PG8_STAGE(PG8_SA(0, 0), cA, voffA); PG8_STAGE(PG8_SA(0, 1), cA + hstep, voffA);
        if (wr == 1) PG8_BAR;
        PG8_WAIT_V(2); PG8_BAR;
        PG8_STAGE(PG8_SB(1, 0), cB + kstep, voffB); PG8_STAGE(PG8_SA(1, 0), cA + kstep, voffA); PG8_STAGE(PG8_SB(1, 1), cB + hstep + kstep, voffB);
        PG8_WAIT_V(6); PG8_BAR;
    } else {
        PG8_STAGE(PG8_SB(0, 0), cB, voffB); PG8_STAGE(PG8_SA(0, 0), cA, voffA); PG8_STAGE(PG8_SB(0, 1), cB + hstep, voffB); PG8_STAGE(PG8_SA(0, 1), cA + hstep, voffA);
        if (wr == 1) PG8_BAR;
        PG8_WAIT_V(4); PG8_BAR;
        PG8_STAGE(PG8_SB(1, 0), cB + kstep, voffB); PG8_STAGE(PG8_SA(1, 0), cA + kstep, voffA); PG8_STAGE(PG8_SB(1, 1), cB + hstep + kstep, voffB);
        PG8_WAIT_V(6); PG8_BAR;
    }
    for (;;) {
        const bool has_next = S.next(ui + 1, nxt);
        const char* nA = has_next ? (const char*)g.A + (size_t)nxt.pm * tstep : cA; const char* nB = has_next ? (const char*)g.Bt + (size_t)nxt.pn * tstep : cB;
        for (int t = 0; t < nt; t += 2) {
            const bool last = (t == nt - 2);
            const char* a1 = cA + (size_t)(t + 1) * kstep;
            const char* a2 = last ? nA : cA + (size_t)(t + 2) * kstep; const char* b2 = last ? nB : cB + (size_t)(t + 2) * kstep;
            const char* a3 = a2 + kstep; const char* b3 = b2 + kstep;
            if (last && has_next) S.a_ready(nxt);
            if constexpr (SP2) {
            PG8_LDB(B0, 0, 0); PG8_LDB(B1, 0, 1); PG8_SCHED; PG8_LDA(At, 0, 0); PG8_STAGE(PG8_SA(1, 1), a1 + hstep, voffA);
            PG8_WAIT_V(8); PG8_WAIT_L(0); PG8_BAR; PG8_MMA(0, 0, At, B0); PG8_MMA(0, 1, At, B1); PG8_BAR; PG8_SCHED;
            PG8_LDA(At, 0, 1); PG8_STAGE(PG8_SB(0, 0), b2, voffB); PG8_STAGE(PG8_SB(0, 1), b2 + hstep, voffB); PG8_STAGE(PG8_SA(0, 0), a2, voffA);
            PG8_WAIT_V(8); PG8_WAIT_L(0); PG8_BAR; PG8_MMA(1, 0, At, B0); PG8_MMA(1, 1, At, B1); PG8_BAR; PG8_SCHED;
            PG8_LDB(B0, 1, 0); PG8_LDB(B1, 1, 1); PG8_SCHED; PG8_LDA(At, 1, 0); PG8_STAGE(PG8_SA(0, 1), a2 + hstep, voffA);
            PG8_WAIT_V(8); PG8_WAIT_L(0); PG8_BAR; PG8_MMA(0, 0, At, B0); PG8_MMA(0, 1, At, B1); PG8_BAR; PG8_SCHED;
            PG8_LDA(At, 1, 1); PG8_STAGE(PG8_SB(1, 0), b3, voffB); PG8_STAGE(PG8_SB(1, 1), b3 + hstep, voffB); PG8_STAGE(PG8_SA(1, 0), a3, voffA);
            PG8_WAIT_V(8); PG8_WAIT_L(0); PG8_BAR; PG8_MMA(1, 0, At, B0); PG8_MMA(1, 1, At, B1); PG8_BAR; PG8_SCHED;
            } else {
            PG8_LDB(B0, 0, 0); PG8_SCHED; PG8_LDA(At, 0, 0); PG8_STAGE(PG8_SA(1, 1), a1 + hstep, voffA);
            PG8_WAIT_L(8); PG8_BAR; PG8_WAIT_L(0); PG8_MMA(0, 0, At, B0); PG8_BAR; PG8_SCHED;
            PG8_LDB(B1, 0, 1); PG8_STAGE(PG8_SB(0, 0), b2, voffB);
            PG8_BAR; PG8_WAIT_L(0); PG8_MMA(0, 1, At, B1); PG8_BAR;
            PG8_LDA(At, 0, 1); PG8_STAGE(PG8_SA(0, 0), a2, voffA);
            PG8_BAR; PG8_WAIT_L(0); PG8_MMA(1, 0, At, B0); PG8_BAR; PG8_SCHED;
            PG8_STAGE(PG8_SB(0, 1), b2 + hstep, voffB);
            PG8_WAIT_V(6); PG8_BAR; PG8_MMA(1, 1, At, B1); PG8_BAR;
            PG8_LDB(B0, 1, 0); PG8_SCHED; PG8_LDA(At, 1, 0); PG8_STAGE(PG8_SA(0, 1), a2 + hstep, voffA);
            PG8_WAIT_L(8); PG8_BAR; PG8_WAIT_L(0); PG8_MMA(0, 0, At, B0); PG8_BAR; PG8_SCHED;
            PG8_LDB(B1, 1, 1); PG8_STAGE(PG8_SB(1, 0), b3, voffB);
            PG8_BAR; PG8_WAIT_L(0); PG8_MMA(0, 1, At, B1); PG8_BAR;
            PG8_LDA(At, 1, 1); PG8_STAGE(PG8_SA(1, 0), a3, voffA);
            PG8_BAR; PG8_WAIT_L(0); PG8_MMA(1, 0, At, B0); PG8_BAR; PG8_SCHED;
            PG8_STAGE(PG8_SB(1, 1), b3 + hstep, voffB);
            PG8_WAIT_V(6); PG8_BAR; PG8_MMA(1, 1, At, B1); PG8_BAR;
            }
        }
        if constexpr (ALIGN_EPI) { if (wr == 0) PG8_BAR; }
        if constexpr (!Epi::AFTER_DRAIN) { E(acc, cur, wr, wc, fr, fq); S.done(cur); }
        if (!has_next) break;
#pragma unroll
        for (int a = 0; a < 2; ++a)
#pragma unroll
            for (int b = 0; b < 2; ++b)
#pragma unroll
                for (int m = 0; m < 4; ++m)
#pragma unroll
                    for (int n = 0; n < 2; ++n) acc[a][b][m][n] = (f32x4){0.f, 0.f, 0.f, 0.f};
        cur = nxt; cA = nA; cB = nB; ++ui;
        if constexpr (ALIGN_EPI) { if (wr == 1) PG8_BAR; }
    }
    PG8_WAIT_V(0);
    if constexpr (!ALIGN_EPI) { if (wr == 0) PG8_BAR; }
    PG8_BAR;
    if constexpr (Epi::AFTER_DRAIN) { E.fused(acc, cur, wr, wc, fr, fq, lds, wid, lane); S.done(cur); }
#undef PG8_SA
#undef PG8_SB
#undef PG8_STAGE
#undef PG8_LDA
#undef PG8_LDB
#undef PG8_MMA
#undef PG8_WAIT_V
#undef PG8_WAIT_L
#undef PG8_BAR
#undef PG8_SCHED
}
}
namespace pg8 {
__device__ __forceinline__ float silu_fast(float x) { return x * __builtin_amdgcn_rcpf(1.f + __expf(-x)); }
struct EpiProj {
    static constexpr bool PERM = true, AFTER_DRAIN = false;
    bf16_t* P; const float* rtc; const float* rts; const float* axc; const float* axs;
    __device__ __forceinline__ void operator()(const f32x4 (&acc)[2][2][4][2], const Unit& u, int wr, int wc, int fr, int fq) const {
        const int pn = u.pn; const bool isctx = (u.pm == 32);
        const int row0 = u.pm * BM + wr * 64 + fr;
        int type = 0; float sc = 1.f;
        if (pn < 4) { type = 2; if (pn >= 2) sc = 0.125f; }
        else if (pn < 8) type = 0;
        else if (pn < 12) type = 1;
        else if (pn < 17) { type = 3; if (pn < 16) sc = 0.125f * 1.4426950408889634f; }
        if (type < 2) {
#pragma unroll
            for (int ai = 0; ai < 2; ++ai)
#pragma unroll
                for (int m = 0; m < 4; ++m) { bf16_t* rowp = P + (size_t)(row0 + ai * HALF + m * 16) * 4608 + pn * BM + wc * 32 + 8 * fq;
#pragma unroll
                    for (int bj = 0; bj < 2; ++bj) { f32x4 v0 = acc[ai][bj][m][0], v1 = acc[ai][bj][m][1];
                        if (type == 1) {
#pragma unroll
                            for (int e = 0; e < 4; ++e) { v0[e] = silu_fast(v0[e]); v1[e] = silu_fast(v1[e]); } }
                        u32x4 w; w.x = cvt_pk_bf16(v0[0], v0[1]); w.y = cvt_pk_bf16(v0[2], v0[3]); w.z = cvt_pk_bf16(v1[0], v1[1]); w.w = cvt_pk_bf16(v1[2], v1[3]);
                        *(u32x4*)(rowp + bj * HALF) = w; } }
        } else {
            const int hf = fq >> 1;
#pragma unroll
            for (int ai = 0; ai < 2; ++ai)
#pragma unroll
                for (int m = 0; m < 4; ++m) { const int r = row0 + ai * HALF + m * 16;
                    f32x4 cs[2], sn[2];
                    if (isctx) { cs[0] = cs[1] = (f32x4){1.f, 1.f, 1.f, 1.f}; sn[0] = sn[1] = (f32x4){0.f, 0.f, 0.f, 0.f}; }
                    else if (type == 2) { const size_t o = (size_t)r * 32 + 8 * fq; cs[0] = *(const f32x4*)(rtc + o); cs[1] = *(const f32x4*)(rtc + o + 4); sn[0] = *(const f32x4*)(rts + o); sn[1] = *(const f32x4*)(rts + o + 4); }
                    else { const int pos = hf ? (r & 63) : (r >> 6); const int o = pos * 16 + 8 * (fq & 1); cs[0] = *(const f32x4*)(axc + o); cs[1] = *(const f32x4*)(axc + o + 4); sn[0] = *(const f32x4*)(axs + o); sn[1] = *(const f32x4*)(axs + o + 4); }
                    f32x4 o1[2], o2[2];
#pragma unroll
                    for (int n = 0; n < 2; ++n) { const f32x4 x1 = acc[ai][0][m][n], x2 = acc[ai][1][m][n]; o1[n] = (x1 * cs[n] - x2 * sn[n]) * sc; o2[n] = (x1 * sn[n] + x2 * cs[n]) * sc; }
                    u32x4 w1, w2; w1.x = cvt_pk_bf16(o1[0][0], o1[0][1]); w1.y = cvt_pk_bf16(o1[0][2], o1[0][3]); w1.z = cvt_pk_bf16(o1[1][0], o1[1][1]); w1.w = cvt_pk_bf16(o1[1][2], o1[1][3]);
                    w2.x = cvt_pk_bf16(o2[0][0], o2[0][1]); w2.y = cvt_pk_bf16(o2[0][2], o2[0][3]); w2.z = cvt_pk_bf16(o2[1][0], o2[1][1]); w2.w = cvt_pk_bf16(o2[1][2], o2[1][3]);
                    bf16_t* rowp = P + (size_t)r * 4608 + pn * BM + wc * 64;
                    if (type == 2) { *(u32x4*)(rowp + 8 * fq) = w1; *(u32x4*)(rowp + 32 + 8 * fq) = w2; }
                    else { *(u32x4*)(rowp + 32 * hf + 8 * (fq & 1)) = w1; *(u32x4*)(rowp + 32 * hf + 16 + 8 * (fq & 1)) = w2; } }
        }
    }
};
struct EpiResid {
    static constexpr bool PERM = false, AFTER_DRAIN = false;
    const float* R; float* out; const float* gate; int ldc;
    __device__ __forceinline__ void operator()(const f32x4 (&acc)[2][2][4][2], const Unit& u, int wr, int wc, int fr, int fq) const {
        const int row0 = u.pm * BM + wr * 64 + fr, col0 = u.pn * BM + wc * 32 + 4 * fq;
        f32x4 gv[2][2];
#pragma unroll
        for (int bj = 0; bj < 2; ++bj)
#pragma unroll
            for (int n = 0; n < 2; ++n) gv[bj][n] = *(const f32x4*)(gate + col0 + bj * HALF + n * 16);
#pragma unroll
        for (int ai = 0; ai < 2; ++ai)
#pragma unroll
            for (int m = 0; m < 4; ++m) { const size_t off = (size_t)(row0 + ai * HALF + m * 16) * ldc + col0;
#pragma unroll
                for (int bj = 0; bj < 2; ++bj)
#pragma unroll
                    for (int n = 0; n < 2; ++n) { const f32x4 rs = *(const f32x4*)(R + off + bj * HALF + n * 16); *(f32x4*)(out + off + bj * HALF + n * 16) = rs + gv[bj][n] * acc[ai][bj][m][n]; } }
    }
};
struct EpiSwiglu {
    static constexpr bool PERM = true, AFTER_DRAIN = false;
    bf16_t* O; int ldc;
    __device__ __forceinline__ void operator()(const f32x4 (&acc)[2][2][4][2], const Unit& u, int wr, int wc, int fr, int fq) const {
        const int row0 = u.pm * BM + wr * 64 + fr, col0 = u.pn * HALF + wc * 32 + 8 * fq;
#pragma unroll
        for (int ai = 0; ai < 2; ++ai)
#pragma unroll
            for (int m = 0; m < 4; ++m) { f32x4 v[2];
#pragma unroll
                for (int n = 0; n < 2; ++n) { const f32x4 g = acc[ai][0][m][n], up = acc[ai][1][m][n];
#pragma unroll
                    for (int e = 0; e < 4; ++e) v[n][e] = silu_fast(g[e]) * up[e]; }
                u32x4 w; w.x = cvt_pk_bf16(v[0][0], v[0][1]); w.y = cvt_pk_bf16(v[0][2], v[0][3]); w.z = cvt_pk_bf16(v[1][0], v[1][1]); w.w = cvt_pk_bf16(v[1][2], v[1][3]);
                *(u32x4*)(O + (size_t)(row0 + ai * HALF + m * 16) * ldc + col0) = w; }
    }
};
}
#define GAS __attribute__((address_space(1)))
#define LAS __attribute__((address_space(3)))
typedef unsigned short bf16;
typedef unsigned v4u __attribute__((ext_vector_type(4)));
typedef float f32x4 __attribute__((ext_vector_type(4)));
typedef short bf16x8 __attribute__((ext_vector_type(8)));
typedef GAS unsigned gu32;
typedef GAS unsigned long long gu64;
#define RLX_AGENT __ATOMIC_RELAXED, __HIP_MEMORY_SCOPE_AGENT
#define LDS_WAIT() asm volatile("s_waitcnt lgkmcnt(0)" ::: "memory")
#define VM_WAIT() asm volatile("s_waitcnt vmcnt(0)" ::: "memory")
__device__ __forceinline__ unsigned long long rt() { return __builtin_amdgcn_s_memrealtime(); }
__device__ __forceinline__ unsigned f2bf(float f) { unsigned u = __builtin_bit_cast(unsigned, f); return (u + 0x7fffu + ((u >> 16) & 1u)) >> 16; }
__device__ __forceinline__ unsigned pk2(float lo, float hi) { return f2bf(lo) | (f2bf(hi) << 16); }
#define XB_TMO      128
#define XB_XCNT(j)  (256  + 64 * (j))
#define XB_XSUB(j)  (1280 + 64 * (j))
#define XB_XGEN(j)  (2304 + 64 * (j))
#define XB_TOP      3328
#define XB_TOPGEN   3392
#define XCD_BAR_WORDS 3456
#define XB_SPIN_CAP (1u << 18)

__device__ __forceinline__ unsigned xb_ld(unsigned* p)              { return __hip_atomic_load(p, __ATOMIC_RELAXED, __HIP_MEMORY_SCOPE_AGENT); }
__device__ __forceinline__ unsigned xb_add(unsigned* p, unsigned v) { return __hip_atomic_fetch_add(p, v, __ATOMIC_RELAXED, __HIP_MEMORY_SCOPE_AGENT); }
__device__ __forceinline__ unsigned xb_xcc_id() { return (unsigned)__builtin_amdgcn_s_getreg((3 << 11) | 20) & 0xFu; }
#define XB_SPIN(cond, bar) do { unsigned _sp = 0; while (cond) { __builtin_amdgcn_s_sleep(1); \
    if ((++_sp & 255u) == 0u) { if (xb_ld(&(bar)[XB_TMO])) break; if (_sp > XB_SPIN_CAP) { atomicAdd(&(bar)[XB_TMO], 1u); break; } } } } while (0)

struct XcdBarrier {
    unsigned* bar; unsigned x;
    volatile LAS unsigned* st;
};

__device__ __forceinline__ XcdBarrier xcd_barrier_post(unsigned* bar, volatile LAS unsigned* st) {
    XcdBarrier b; b.bar = bar; b.x = xb_xcc_id(); b.st = st;
    if (threadIdx.x == 0) (void)xb_add(&bar[XB_XCNT(b.x)], 1u);
    return b;
}
__device__ __forceinline__ void xcd_barrier_complete(unsigned* bar, unsigned x, unsigned& nloc, unsigned& nx) {
    const unsigned G = gridDim.x * gridDim.y * gridDim.z;
    unsigned sum, cnt, mine, sp = 0u;
    for (;;) {
        sum = 0u; cnt = 0u; mine = 0u;
#pragma unroll
        for (unsigned j = 0; j < 16; ++j) { const unsigned c = xb_ld(&bar[XB_XCNT(j)]); sum += c; cnt += (c > 0u) ? 1u : 0u; mine = (j == x) ? c : mine; }
        if (sum == G) break;
        __builtin_amdgcn_s_sleep(1);
        if ((++sp & 255u) == 0u) { if (xb_ld(&bar[XB_TMO])) break; if (sp > XB_SPIN_CAP) { atomicAdd(&bar[XB_TMO], 1u); break; } }
    }
    nloc = mine > 0u ? mine : 1u; nx = cnt > 0u ? cnt : 1u;
}

__device__ __forceinline__ void xcd_barrier(const XcdBarrier& b) {
    asm volatile("s_waitcnt vmcnt(0)" ::: "memory");
    __syncthreads();
    if (threadIdx.x == 0) {
        unsigned* bar = b.bar;
        __builtin_amdgcn_s_waitcnt(0);
        unsigned nloc = b.st[0], nx = b.st[1];
        if (nloc == 0u) { xcd_barrier_complete(bar, b.x, nloc, nx); b.st[0] = nloc; b.st[1] = nx; }
        const unsigned old = xb_add(&bar[XB_XSUB(b.x)], 1u);
        const unsigned gen = old / nloc;
        if (old + 1u == (gen + 1u) * nloc) {
            __builtin_amdgcn_fence(__ATOMIC_RELEASE, "agent");
            asm volatile("s_waitcnt vmcnt(0)" ::: "memory");
            const unsigned og = xb_add(&bar[XB_TOP], 1u);
            const unsigned tg = og / nx;
            if (og + 1u == (tg + 1u) * nx) xb_add(&bar[XB_TOPGEN], 1u);
            else XB_SPIN(xb_ld(&bar[XB_TOPGEN]) == tg, bar);
            __builtin_amdgcn_fence(__ATOMIC_ACQUIRE, "agent");
            xb_add(&bar[XB_XGEN(b.x)], 1u);
            asm volatile("s_waitcnt vmcnt(0)" ::: "memory");
        } else {
            XB_SPIN(xb_ld(&bar[XB_XGEN(b.x)]) == gen, bar);
            __builtin_amdgcn_fence(__ATOMIC_ACQUIRE, "agent");
            asm volatile("s_waitcnt vmcnt(0)" ::: "memory");
        }
    }
    __syncthreads();
}
constexpr int NWAVES = 8;
constexpr int RING_OFF = 0, RING_BYTES = 131072;
constexpr int LDSCTL_OFF = RING_BYTES, MISC_OFF = LDSCTL_OFF + 320;
constexpr int LDS_BYTES = 147456;
constexpr size_t WS_MODACC = 512 * 1024;
constexpr size_t WS_RT = 2 * MiB;
constexpr size_t WS_AXT = 4 * MiB;
constexpr size_t WS_WIN = 8 * MiB, WS_WOUT = 26 * MiB, WS_WGU = 34 * MiB, WS_WDN = 78 * MiB;
constexpr size_t WS_KVT = 241 * MiB;
constexpr size_t WS_SPT = 274 * MiB;
constexpr int CW_TMO = 0, CW_CODE = 1, CW_BAR = 4096;

typedef short s16x4 __attribute__((ext_vector_type(4)));
typedef short v4i16_t __attribute__((ext_vector_type(4)));
__device__ __forceinline__ s16x4 vtr(const LAS unsigned char* p) { return __builtin_bit_cast(s16x4, __builtin_amdgcn_ds_read_tr16_b64_v4i16((LAS v4i16_t*)p)); }
__device__ __forceinline__ bf16x8 cat8(s16x4 lo, s16x4 hi) { return (bf16x8){lo[0], lo[1], lo[2], lo[3], hi[0], hi[1], hi[2], hi[3]}; }
struct Frame {
    LAS unsigned char* lds; volatile LAS unsigned* MISC; gu32* ctl;
    int tid, lane, wave, vcu, G;
};
__device__ __forceinline__ float wave_sum(float v) {
#pragma unroll
    for (int o = 1; o < 64; o <<= 1) v += __shfl_xor(v, o);
    return v;
}
__device__ __forceinline__ int sigma_in(int p) {
    const int pn = p >> 8, q = p & 255, bj = q >> 7, wc = (q >> 5) & 3, off = q & 31;
    if (pn < 4) return pn * 256 + wc * 64 + bj * 32 + off;
    if (pn >= 12 && pn < 17) return pn * 256 + wc * 64 + (off >> 4) * 32 + bj * 16 + (off & 15);
    return p;
}
__device__ __forceinline__ void tr64_item(const float* W, int K, int N, bf16* WT, int p0, int k0, int srccol4, LAS unsigned char* scr, int lane) {
    const int fr = lane & 15, fq = lane >> 4;
    f32x4 t[16];
#pragma unroll
    for (int i = 0; i < 16; ++i) t[i] = *(const GAS f32x4*)(W + (size_t)(k0 + 4 * i + fq) * N + srccol4);
#pragma unroll
    for (int i = 0; i < 16; ++i) *(LAS unsigned long long*)(scr + (4 * i + fq) * 160 + fr * 8) = (unsigned long long)pg8::cvt_pk_bf16(t[i].x, t[i].y) | ((unsigned long long)pg8::cvt_pk_bf16(t[i].z, t[i].w) << 32);
    LDS_WAIT(); asm volatile("" ::: "memory");
#pragma unroll
    for (int ng = 0; ng < 4; ++ng)
#pragma unroll
        for (int kh = 0; kh < 2; ++kh) { const LAS unsigned char* p = scr + (32 * kh + 8 * fq + (fr >> 2)) * 160 + 32 * ng + 8 * (fr & 3);
            const bf16x8 o = cat8(vtr(p), vtr(p + 4 * 160));
            *(GAS bf16x8*)(WT + (size_t)(p0 + 16 * ng + fr) * K + k0 + 32 * kh + 8 * fq) = o; }
    LDS_WAIT(); asm volatile("" ::: "memory");
}
struct Args { const float* in[16]; float* out; unsigned char* ws; int ph_lo, ph_hi, li, pad; };

__device__ __forceinline__ void p0_prologue(Frame& F, const Args& a, bool do_atomics) {
    LAS unsigned char* scr = F.lds + RING_OFF + F.wave * 16384;
    const int gw = F.vcu * NWAVES + F.wave, NGW = F.G * NWAVES, lane = F.lane;
    const float* w_mod = a.in[4]; const float* w_in = a.in[8];
    float* modacc = (float*)(a.ws + WS_MODACC);
    constexpr int I_GEMV = 48 * 32, I_RT = 128, I_AX = 1, I_IN = 72 * 32;
    constexpr int NITEMS = I_GEMV + I_RT + I_AX + I_IN;
    for (int it = gw; it < NITEMS; it += NGW) {
        int r = it;
        if (r < I_GEMV) {
            const int strip = r % 48, ks = r / 48; const int n = strip * 256 + 4 * lane;
            f32x4 a0 = {0.f, 0.f, 0.f, 0.f}, a1 = {0.f, 0.f, 0.f, 0.f};
            const float cv = a.in[1][ks * 64 + lane], cc = a.in[3][ks * 64 + lane];
            const float s0 = cv / (1.f + __expf(-cv)), s1 = cc / (1.f + __expf(-cc));
#pragma unroll 16
            for (int k = 0; k < 64; ++k) { const f32x4 w = *(const GAS f32x4*)(w_mod + (size_t)(ks * 64 + k) * (6 * D) + n);
                const float t0 = __shfl(s0, k), t1 = __shfl(s1, k); a0 += w * t0; a1 += w * t1; }
            if (ks == 0) { const f32x4 b = *(const f32x4*)(a.in[5] + n); a0 += b; a1 += b; }
#pragma unroll
            for (int e = 0; e < 4; ++e) { if (do_atomics) { unsafeAtomicAdd(modacc + n + e, a0[e]); unsafeAtomicAdd(modacc + 6 * D + n + e, a1[e]); } else asm volatile("" :: "v"(a0[e]), "v"(a1[e])); }
            continue; }
        r -= I_GEMV;
        if (r < I_RT) {
            const int t = r * 64 + lane; float* rc = (float*)(a.ws + WS_RT); float* rs = (float*)(a.ws + WS_RT + MiB);
            for (int j = 0; j < 32; ++j) { const float inv = powf(10000.f, -(float)j / 32.f), ang = (float)t * inv; float sn, cs; sincosf(ang, &sn, &cs); rc[t * 32 + j] = cs; rs[t * 32 + j] = sn; }
            continue; }
        r -= I_RT;
        if (r < I_AX) {
            float* ac = (float*)(a.ws + WS_AXT); float* as = (float*)(a.ws + WS_AXT + 8192);
            for (int i = lane; i < 128 * 16; i += 64) { const int pos = i >> 4, j = i & 15; const float inv = powf(10000.f, -(float)j / 16.f), ang = (float)pos * inv; float sn, cs; sincosf(ang, &sn, &cs); ac[i] = cs; as[i] = sn; }
            continue; }
        r -= I_AX;
        { const int grp = r % 72, kb = r / 72; tr64_item(w_in, D, NPROJ, (bf16*)(a.ws + WS_WIN), grp * 64, kb * 64, sigma_in(grp * 64 + 4 * (lane & 15)), scr, lane); }
    }
}
__device__ __forceinline__ void p0_deferred(Frame& F, const Args& a, int which, int gwf, int ngwf) {
    LAS unsigned char* scr = F.lds + RING_OFF + F.wave * 16384; const int lane = F.lane;
    const float* w_out = a.in[11]; const float* w_gate = a.in[12]; const float* w_up = a.in[13]; const float* w_down = a.in[14];
    constexpr int I_OUT = 32 * 32, I_GU = 176 * 32, I_DN = 32 * 88;
    if (which == 0) {
        for (int it = gwf; it < I_GU + I_OUT; it += ngwf) {
            int r = it;
            if (r < I_GU) { const int grp = r % 176, kb = r / 176; const int pn = grp >> 2, gg = grp & 3;
                tr64_item((gg >> 1) ? w_up : w_gate, D, DFF, (bf16*)(a.ws + WS_WGU), grp * 64, kb * 64, pn * 128 + (gg & 1) * 64 + 4 * (lane & 15), scr, lane); continue; }
            r -= I_GU;
            { const int grp = r % 32, kb = r / 32; tr64_item(w_out, D, D, (bf16*)(a.ws + WS_WOUT), grp * 64, kb * 64, grp * 64 + 4 * (lane & 15), scr, lane); }
        }
    } else {
        for (int it = gwf; it < I_DN; it += ngwf) { const int grp = it % 32, kb = it / 32; tr64_item(w_down, DFF, D, (bf16*)(a.ws + WS_WDN), grp * 64, kb * 64, grp * 64 + 4 * (lane & 15), scr, lane); }
    }
}
__device__ __forceinline__ void modulate_row(const float* xrow, const float* g, const float* shift, const float* scale, bf16* orow, int lane) {
    const GAS f32x4* xr = (const GAS f32x4*)xrow + lane;
    f32x4 v[8]; float s = 0.f;
#pragma unroll
    for (int j = 0; j < 8; ++j) { v[j] = xr[64 * j]; s += (v[j].x * v[j].x + v[j].y * v[j].y) + (v[j].z * v[j].z + v[j].w * v[j].w); }
    const float r = rsqrtf(wave_sum(s) * (1.f / D) + EPS);
    GAS unsigned long long* o8 = (GAS unsigned long long*)orow + lane;
#pragma unroll
    for (int j = 0; j < 8; ++j) { const int c = 4 * lane + 256 * j; const f32x4 gg = *(const f32x4*)(g + c), sh = *(const f32x4*)(shift + c), sc = *(const f32x4*)(scale + c);
        const f32x4 y = v[j] * r * gg * (sc + 1.f) + sh;
        o8[64 * j] = (unsigned long long)pk2(y.x, y.y) | ((unsigned long long)pk2(y.z, y.w) << 32); }
}
__device__ __forceinline__ void modulate_row2(const float* x1, const float* x2, const float* g, const float* sh1, const float* sc1, const float* sh2, const float* sc2, bf16* o1, bf16* o2, int lane) {
    const GAS f32x4* xr1 = (const GAS f32x4*)x1 + lane; const GAS f32x4* xr2 = (const GAS f32x4*)x2 + lane;
    f32x4 v[8], u[8]; float s = 0.f, t = 0.f;
#pragma unroll
    for (int j = 0; j < 8; ++j) { v[j] = xr1[64 * j]; u[j] = xr2[64 * j]; }
#pragma unroll
    for (int j = 0; j < 8; ++j) { s += (v[j].x * v[j].x + v[j].y * v[j].y) + (v[j].z * v[j].z + v[j].w * v[j].w); t += (u[j].x * u[j].x + u[j].y * u[j].y) + (u[j].z * u[j].z + u[j].w * u[j].w); }
    const float r1 = rsqrtf(wave_sum(s) * (1.f / D) + EPS), r2 = rsqrtf(wave_sum(t) * (1.f / D) + EPS);
    GAS unsigned long long* p1 = (GAS unsigned long long*)o1 + lane; GAS unsigned long long* p2 = (GAS unsigned long long*)o2 + lane;
#pragma unroll
    for (int j = 0; j < 8; ++j) { const int c = 4 * lane + 256 * j; const f32x4 gg = *(const f32x4*)(g + c);
        const f32x4 y = v[j] * r1 * gg * (*(const f32x4*)(sc1 + c) + 1.f) + *(const f32x4*)(sh1 + c);
        const f32x4 z = u[j] * r2 * gg * (*(const f32x4*)(sc2 + c) + 1.f) + *(const f32x4*)(sh2 + c);
        p1[64 * j] = (unsigned long long)pk2(y.x, y.y) | ((unsigned long long)pk2(y.z, y.w) << 32);
        p2[64 * j] = (unsigned long long)pk2(z.x, z.y) | ((unsigned long long)pk2(z.z, z.w) << 32); }
}
__device__ __forceinline__ void final_norm_row(const float* xrow, float* orow, const float* g, int lane) {
    const GAS f32x4* xr = (const GAS f32x4*)xrow + lane; GAS f32x4* xo = (GAS f32x4*)orow + lane;
    f32x4 v[8]; float s = 0.f;
#pragma unroll
    for (int j = 0; j < 8; ++j) { v[j] = xr[64 * j]; s += (v[j].x * v[j].x + v[j].y * v[j].y) + (v[j].z * v[j].z + v[j].w * v[j].w); }
    const float r = rsqrtf(wave_sum(s) * (1.f / D) + EPS);
#pragma unroll
    for (int j = 0; j < 8; ++j) { const f32x4 gg = *(const f32x4*)(g + 4 * lane + 256 * j); xo[64 * j] = v[j] * r * gg; }
}

__device__ __forceinline__ f32x4 mfma16(bf16x8 a, bf16x8 b, f32x4 c) { return __builtin_amdgcn_mfma_f32_16x16x32_bf16(a, b, c, 0, 0, 0); }
__device__ __forceinline__ float ex2(float x) { return __builtin_amdgcn_exp2f(x); }
__device__ __forceinline__ unsigned pk2f(float lo, float hi) { return pg8::cvt_pk_bf16(lo, hi); }
constexpr int RSV = 288;
constexpr int RSK = 160;
__device__ __forceinline__ bf16x8 tr_frag(const LAS unsigned char* tile, int rs, int r0, int cb, int fr, int fq) {
    const LAS unsigned char* p = tile + (r0 + 4 * fq + (fr >> 2)) * rs + cb + 8 * (fr & 3);
    return cat8(vtr(p), vtr(p + 16 * rs));
}

__device__ __forceinline__ void ret_kv_item(Frame& F, const bf16* PROJ, float* KVT, int cc, int h, float lf2, float lb2) {
    const int lane = F.lane, fr = lane & 15, fq = lane >> 4, w = F.wave, tid = F.tid;
    const int row0 = cc < 2 ? L + 128 * cc : 128 * (cc - 2);
    LAS unsigned char* Vl = F.lds; LAS unsigned char* Kf = F.lds + 128 * RSV; LAS unsigned char* Kb = Kf + 128 * RSK;
    __syncthreads();
#pragma unroll
    for (int p = 0; p < 4; ++p) { const int idx = p * 512 + tid, row = idx >> 4, ch = idx & 15;
        const v4u v = *(const GAS v4u*)(PROJ + (size_t)(row0 + row) * NPROJ + C_RV + h * 128 + ch * 8); *(LAS v4u*)(Vl + row * RSV + ch * 16) = v; }
#pragma unroll
    for (int p = 0; p < 2; ++p) { const int idx = p * 512 + tid, row = idx >> 3, ch = idx & 7;
        const v4u v = *(const GAS v4u*)(PROJ + (size_t)(row0 + row) * NPROJ + C_RK + h * 64 + ch * 8);
        const float wf = ex2(lf2 * (float)(127 - row)), wb = ex2(lb2 * (float)row);
        v4u of, ob;
#pragma unroll
        for (int e = 0; e < 4; ++e) { const float lo = __uint_as_float(v[e] << 16), hi = __uint_as_float(v[e] & 0xffff0000u); of[e] = pk2f(lo * wf, hi * wf); ob[e] = pk2f(lo * wb, hi * wb); }
        *(LAS v4u*)(Kf + row * RSK + ch * 16) = of; *(LAS v4u*)(Kb + row * RSK + ch * 16) = ob; }
    __syncthreads();
    bf16x8 aV[4];
#pragma unroll
    for (int st = 0; st < 4; ++st) aV[st] = tr_frag(Vl, RSV, 32 * st, 32 * w, fr, fq);
#pragma unroll
    for (int dir = 0; dir < 2; ++dir) { const LAS unsigned char* Kx = dir ? Kb : Kf;
        float* outp = KVT + (((size_t)dir * 66 + cc) * 8 + h) * 8192 + (16 * w + 4 * fq) * 64 + fr;
#pragma unroll
        for (int dt = 0; dt < 4; ++dt) { f32x4 acc = {0.f, 0.f, 0.f, 0.f};
#pragma unroll
            for (int st = 0; st < 4; ++st) acc = mfma16(aV[st], tr_frag(Kx, RSK, 32 * st, 32 * dt, fr, fq), acc);
#pragma unroll
            for (int r = 0; r < 4; ++r) outp[r * 64 + 16 * dt] = acc[r]; } }
}
__device__ __forceinline__ void ret_scan_phase(Frame& F, const float* KVT, bf16* SPT, const float* ret_decay) {
    const int nthr = F.G * 512;
    for (int e = F.vcu * 512 + F.tid; e < 2 * 8 * 8192; e += nthr) {
        const int dir = e >> 16, h = (e >> 13) & 7, vd = e & 8191;
        const float g = __expf(-128.f * __expf(ret_decay[dir * 8 + h]));
        const float* kv = KVT + ((size_t)dir * 66 * 8 + h) * 8192 + vd;
        bf16* sp = SPT + ((size_t)dir * 64 * 8 + h) * 8192 + vd;
        float S = 0.f;
        if (dir == 0) { S = kv[0]; S = g * S + kv[65536];
#pragma unroll 8
            for (int c = 0; c < 64; ++c) { sp[(size_t)c * 65536] = (bf16)f2bf(S); S = g * S + kv[(size_t)(2 + c) * 65536]; } }
        else { S = kv[65536]; S = g * S + kv[0];
#pragma unroll 8
            for (int c = 63; c >= 0; --c) { sp[(size_t)c * 65536] = (bf16)f2bf(S); S = g * S + kv[(size_t)(2 + c) * 65536]; } }
    }
}
constexpr int RSA = 144;
constexpr int RO_V = 0, RO_K = 128 * RSV, RO_SF = RO_K + 128 * RSA, RO_SB = RO_SF + 128 * RSA;
__device__ __forceinline__ void ret_out_item(Frame& F, const bf16* PROJ, const bf16* SPT, bf16* Y, int c, int h, float lf2, float lb2) {
    const int lane = F.lane, fr = lane & 15, fq = lane >> 4, w = F.wave, tid = F.tid;
    const int t0 = c * 128;
    LAS unsigned char* Vl = F.lds + RO_V; LAS unsigned char* Kl = F.lds + RO_K; LAS unsigned char* Sfl = F.lds + RO_SF; LAS unsigned char* Sbl = F.lds + RO_SB;
    const int il = 16 * w + fr;
    v4u gv[4], gk[2], gf[2], gb[2];
    const bf16* Sf = SPT + ((size_t)(0 * 64 + c) * 8 + h) * 8192; const bf16* Sb = SPT + ((size_t)(1 * 64 + c) * 8 + h) * 8192;
#pragma unroll
    for (int p = 0; p < 4; ++p) { const int idx = p * 512 + tid; gv[p] = *(const GAS v4u*)(PROJ + (size_t)(t0 + (idx >> 4)) * NPROJ + C_RV + h * 128 + (idx & 15) * 8); }
#pragma unroll
    for (int p = 0; p < 2; ++p) { const int idx = p * 512 + tid; gk[p] = *(const GAS v4u*)(PROJ + (size_t)(t0 + (idx >> 3)) * NPROJ + C_RK + h * 64 + (idx & 7) * 8);
        gf[p] = *(const GAS v4u*)(Sf + idx * 8); gb[p] = *(const GAS v4u*)(Sb + idx * 8); }
    const bf16* qrow = PROJ + (size_t)(t0 + il) * NPROJ + C_RQ + h * 64 + 8 * fq;
    bf16x8 qB[2]; qB[0] = *(const GAS bf16x8*)(qrow); qB[1] = *(const GAS bf16x8*)(qrow + 32);
    __syncthreads();
#pragma unroll
    for (int p = 0; p < 4; ++p) { const int idx = p * 512 + tid; *(LAS v4u*)(Vl + (idx >> 4) * RSV + (idx & 15) * 16) = gv[p]; }
#pragma unroll
    for (int p = 0; p < 2; ++p) { const int idx = p * 512 + tid; const int o = (idx >> 3) * RSA + (idx & 7) * 16; *(LAS v4u*)(Kl + o) = gk[p]; *(LAS v4u*)(Sfl + o) = gf[p]; *(LAS v4u*)(Sbl + o) = gb[p]; }
    const float wf = ex2(lf2 * (float)(il + 1)), wb = ex2(lb2 * (float)(128 - il));
    __syncthreads();
    const bf16* grow = PROJ + (size_t)(t0 + il) * NPROJ + C_RG + h * 128 + 4 * fq;
    unsigned long long gate[8];
#pragma unroll
    for (int vt = 0; vt < 8; ++vt) gate[vt] = *(const GAS unsigned long long*)(grow + 16 * vt);
    const int fo = fr * RSA + 16 * fq;
    f32x4 O[8];
#pragma unroll
    for (int vt = 0; vt < 8; ++vt) { f32x4 xf = {0.f, 0.f, 0.f, 0.f}, xb = {0.f, 0.f, 0.f, 0.f};
#pragma unroll
        for (int s = 0; s < 2; ++s) { xf = mfma16(*(const LAS bf16x8*)(Sfl + vt * 16 * RSA + fo + 64 * s), qB[s], xf); xb = mfma16(*(const LAS bf16x8*)(Sbl + vt * 16 * RSA + fo + 64 * s), qB[s], xb); }
        O[vt] = xf * wf + xb * wb; }
    unsigned pt[8][2];
#pragma unroll
    for (int T = 0; T < 8; ++T) { f32x4 st = {0.f, 0.f, 0.f, 0.f};
#pragma unroll
        for (int s = 0; s < 2; ++s) st = mfma16(*(const LAS bf16x8*)(Kl + T * 16 * RSA + fo + 64 * s), qB[s], st);
#pragma unroll
        for (int r = 0; r < 4; ++r) { const int diff = il - (16 * T + 4 * fq + r); st[r] *= diff >= 0 ? ex2(lf2 * (float)diff) : ex2(lb2 * (float)(-diff)); }
        pt[T][0] = pk2f(st[0], st[1]); pt[T][1] = pk2f(st[2], st[3]); }
#pragma unroll
    for (int st = 0; st < 4; ++st) { const v4u pw = {pt[2 * st][0], pt[2 * st][1], pt[2 * st + 1][0], pt[2 * st + 1][1]}; const bf16x8 pb = __builtin_bit_cast(bf16x8, pw);
#pragma unroll
        for (int vt = 0; vt < 8; ++vt) O[vt] = mfma16(tr_frag(Vl, RSV, 32 * st, 32 * vt, fr, fq), pb, O[vt]); }
    float ss = 0.f;
#pragma unroll
    for (int vt = 0; vt < 8; ++vt) ss += (O[vt][0] * O[vt][0] + O[vt][1] * O[vt][1]) + (O[vt][2] * O[vt][2] + O[vt][3] * O[vt][3]);
    ss += __shfl_xor(ss, 16); ss += __shfl_xor(ss, 32);
    const float r = rsqrtf(ss * (1.f / 128.f) + EPS);
    bf16* yrow = Y + (size_t)(t0 + il) * D + h * 128 + 4 * fq;
#pragma unroll
    for (int vt = 0; vt < 8; ++vt) { const unsigned g0 = (unsigned)gate[vt], g1 = (unsigned)(gate[vt] >> 32);
        const float y0 = O[vt][0] * r * __uint_as_float(g0 << 16), y1 = O[vt][1] * r * __uint_as_float(g0 & 0xffff0000u), y2 = O[vt][2] * r * __uint_as_float(g1 << 16), y3 = O[vt][3] * r * __uint_as_float(g1 & 0xffff0000u);
        *(GAS unsigned long long*)(yrow + 16 * vt) = (unsigned long long)pk2f(y0, y1) | ((unsigned long long)pk2f(y2, y3) << 32); }
}
constexpr int ATT_ROWS = 640;
__device__ __forceinline__ void attn_item(Frame& F, const bf16* PROJ, const float* sink, bf16* Y, int b, int kvh) {
    const int lane = F.lane, fr = lane & 15, fq = lane >> 4, w = F.wave, tid = F.tid;
    LAS unsigned char* Vl = F.lds;
    __syncthreads();
#pragma unroll
    for (int p = 0; p < 10; ++p) { const int idx = p * 512 + tid, row = idx >> 3, ch = idx & 7;
        int src; bool ok = true;
        if (row < 384) { const int key = 128 * b - 128 + row; ok = key >= 0 && key < L; src = ok ? key : 0; } else src = L + (row - 384);
        v4u v = *(const GAS v4u*)(PROJ + (size_t)src * NPROJ + C_AV + kvh * 64 + ch * 8);
        if (!ok) v = (v4u){0u, 0u, 0u, 0u};
        *(LAS v4u*)(Vl + row * RSK + ch * 16) = v; }
    const int iq = 128 * b + 16 * w + fr;
    bf16x8 qB[4][2]; float m[4], l[4]; f32x4 O[4][4];
#pragma unroll
    for (int g = 0; g < 4; ++g) { const bf16* qrow = PROJ + (size_t)iq * NPROJ + C_AQ + (4 * kvh + g) * 64 + 8 * fq;
        qB[g][0] = *(const GAS bf16x8*)(qrow); qB[g][1] = *(const GAS bf16x8*)(qrow + 32);
        m[g] = sink[4 * kvh + g] * LOG2E; l[g] = fq == 0 ? 1.f : 0.f;
#pragma unroll
        for (int dt = 0; dt < 4; ++dt) O[g][dt] = (f32x4){0.f, 0.f, 0.f, 0.f}; }
    __syncthreads();
    const bf16* kbase = PROJ + C_AK + kvh * 64 + 8 * fq;
#define ATT_KLOAD(dst, stp) do { const bool il_ = (stp) < 9; const int lr_ = il_ ? 32 * ((w >> 1) + (stp)) : 384 + 32 * ((stp) - 9); \
        _Pragma("unroll") for (int tt = 0; tt < 2; ++tt) { int kr; \
            if (il_) { kr = 128 * b - 128 + lr_ + 16 * tt + fr; kr = kr < 0 ? 0 : (kr > L - 1 ? L - 1 : kr); } else kr = L + (lr_ - 384) + 16 * tt + fr; \
            const bf16* kp = kbase + (size_t)kr * NPROJ; dst[tt][0] = *(const GAS bf16x8*)(kp); dst[tt][1] = *(const GAS bf16x8*)(kp + 32); } } while (0)
    bf16x8 kA[2][2], kN[2][2];
    ATT_KLOAD(kA, 0);
    for (int step = 0; step < 17; ++step) {
        const bool isloc = step < 9;
        const int ldsrow0 = isloc ? 32 * ((w >> 1) + step) : 384 + 32 * (step - 9);
        const int key0 = 128 * b - 128 + ldsrow0;
        { const int nstep = step < 16 ? step + 1 : 16; ATT_KLOAD(kN, nstep); }
        bf16x8 vA[4];
#pragma unroll
        for (int dt = 0; dt < 4; ++dt) vA[dt] = tr_frag(Vl, RSK, ldsrow0, 32 * dt, fr, fq);
#pragma unroll
        for (int g = 0; g < 4; ++g) {
            f32x4 s0 = {0.f, 0.f, 0.f, 0.f}, s1 = {0.f, 0.f, 0.f, 0.f};
            s0 = mfma16(kA[0][0], qB[g][0], s0); s0 = mfma16(kA[0][1], qB[g][1], s0);
            s1 = mfma16(kA[1][0], qB[g][0], s1); s1 = mfma16(kA[1][1], qB[g][1], s1);
            if (isloc) {
#pragma unroll
                for (int r = 0; r < 4; ++r) { const int k0 = key0 + 4 * fq + r, k1 = k0 + 16; const int d0 = iq - k0, d1 = iq - k1;
                    if (!(k0 >= 0 && k0 < L && d0 <= WIN && d0 >= -WIN)) s0[r] = -INFINITY;
                    if (!(k1 >= 0 && k1 < L && d1 <= WIN && d1 >= -WIN)) s1[r] = -INFINITY; } }
            float mx = fmaxf(fmaxf(fmaxf(s0[0], s0[1]), fmaxf(s0[2], s0[3])), fmaxf(fmaxf(s1[0], s1[1]), fmaxf(s1[2], s1[3])));
            mx = fmaxf(mx, __shfl_xor(mx, 16)); mx = fmaxf(mx, __shfl_xor(mx, 32));
            const float mn = fmaxf(m[g], mx), alpha = ex2(m[g] - mn); m[g] = mn;
            float ps = 0.f;
#pragma unroll
            for (int r = 0; r < 4; ++r) { s0[r] = ex2(s0[r] - mn); s1[r] = ex2(s1[r] - mn); ps += s0[r] + s1[r]; }
            l[g] = l[g] * alpha + ps;
            const v4u pw = {pk2f(s0[0], s0[1]), pk2f(s0[2], s0[3]), pk2f(s1[0], s1[1]), pk2f(s1[2], s1[3])}; const bf16x8 pb = __builtin_bit_cast(bf16x8, pw);
#pragma unroll
            for (int dt = 0; dt < 4; ++dt) { O[g][dt] *= alpha; O[g][dt] = mfma16(vA[dt], pb, O[g][dt]); }
        }
#pragma unroll
        for (int tt = 0; tt < 2; ++tt) { kA[tt][0] = kN[tt][0]; kA[tt][1] = kN[tt][1]; }
    }
#undef ATT_KLOAD
#pragma unroll
    for (int g = 0; g < 4; ++g) { float lt = l[g]; lt += __shfl_xor(lt, 16); lt += __shfl_xor(lt, 32); const float inv = 1.f / lt;
        bf16* yrow = Y + (size_t)iq * D + 1024 + (4 * kvh + g) * 64 + 4 * fq;
#pragma unroll
        for (int dt = 0; dt < 4; ++dt) *(GAS unsigned long long*)(yrow + 16 * dt) = (unsigned long long)pk2f(O[g][dt][0] * inv, O[g][dt][1] * inv) | ((unsigned long long)pk2f(O[g][dt][2] * inv, O[g][dt][3] * inv) << 32); }
}
__global__ void __launch_bounds__(NWAVES * 64, 2) mk_fwd(Args args) {
    extern __shared__ __attribute__((aligned(16))) unsigned char lds[];
    Frame F;
    F.lds = (LAS unsigned char*)lds;
    F.MISC = (volatile LAS unsigned*)(F.lds + MISC_OFF);
    F.tid = threadIdx.x; F.lane = F.tid & 63; F.wave = __builtin_amdgcn_readfirstlane(F.tid >> 6);
    F.G = gridDim.x; { const int bx = blockIdx.x; F.vcu = (F.G % 8 == 0) ? (bx % 8) * (F.G / 8) + bx / 8 : bx; }
    unsigned char* ws = args.ws;
    F.ctl = (gu32*)(ws + WS_CTL);
    for (int u = F.tid; u < (LDS_BYTES - LDSCTL_OFF) / 4; u += NWAVES * 64) ((LAS unsigned*)(F.lds + LDSCTL_OFF))[u] = 0u;
    __syncthreads();
    XcdBarrier bar = xcd_barrier_post((unsigned*)(F.ctl + CW_BAR) + args.li * XCD_BAR_WORDS, F.MISC + 8);
    const int lo = args.ph_lo, hi = args.ph_hi;
#define IN(k) (lo <= (k) && (k) < hi)
#define BOTH(k) (IN(k) && IN((k) + 1))
#define REFRESH() do { int t_ = threadIdx.x; asm volatile("" : "+v"(t_)); F.tid = t_; F.lane = t_ & 63; } while (0)
#define REP(k) for (int rep_ = 0; rep_ < 1 + ((PROBE_DBL >> (k)) & 1); ++rep_)
#define DUMMY(k) (((PROBE_DBL >> (k)) & 1) && rep_ == 0)
    const float* mod = (const float*)(ws + WS_MODACC);
    bf16* HX = (bf16*)(ws + WS_HX); bf16* PROJ = (bf16*)(ws + WS_PROJ); bf16* Y = (bf16*)(ws + WS_Y); bf16* ACT = (bf16*)(ws + WS_ACT);
    const int gw = F.vcu * NWAVES + F.wave, NGW = F.G * NWAVES;

    if (IN(0)) REP(0) { REFRESH(); p0_prologue(F, args, rep_ == 0); if (BOTH(0)) xcd_barrier(bar); }
    if (IN(1)) REP(1) { REFRESH();
        for (int m = gw; m < MROWS; m += 2 * NGW) {
            const int m2 = m + NGW < MROWS ? m + NGW : m;
            const float* src = m < L ? args.in[0] + (size_t)m * D : args.in[2] + (size_t)(m - L) * D; const float* mb = m < L ? mod : mod + 6 * D;
            const float* src2 = m2 < L ? args.in[0] + (size_t)m2 * D : args.in[2] + (size_t)(m2 - L) * D; const float* mb2 = m2 < L ? mod : mod + 6 * D;
            modulate_row2(src, src2, args.in[6], mb, mb + D, mb2, mb2 + D, HX + (size_t)m * D, HX + (size_t)m2 * D, F.lane); }
        if (BOTH(1)) xcd_barrier(bar);
    }
    if (IN(2)) REP(2) { REFRESH();
        pg8::Gemm g{HX, (const bf16*)(ws + WS_WIN), MROWS, NPROJ, D}; pg8::StaticOrder S; S.init(MROWS, NPROJ, F.G, (int)blockIdx.x);
        pg8::EpiProj E{PROJ, (const float*)(ws + WS_RT), (const float*)(ws + WS_RT + MiB), (const float*)(ws + WS_AXT), (const float*)(ws + WS_AXT + 8192)};
        pg8::gemm_phase<pg8::EpiProj, pg8::StaticOrder, true, true>(F.lds + RING_OFF, g, S, E);
        { const int extra = S.nwg % F.G; const int c = (int)blockIdx.x;
            if (extra == 0) p0_deferred(F, args, 0, c * NWAVES + F.wave, F.G * NWAVES);
            else if (c >= extra) p0_deferred(F, args, 0, (c - extra) * NWAVES + F.wave, (F.G - extra) * NWAVES); }
        if (BOTH(2)) xcd_barrier(bar);
    }
    if (IN(3)) REP(3) { REFRESH();
        const float* rd = args.in[9];
        for (int it = F.vcu; it < 256; it += F.G) attn_item(F, PROJ, args.in[10], Y, it >> 2, it & 3);
        for (int it = F.vcu; it < 528; it += F.G) { const int cc = it >> 3, h = it & 7;
            ret_kv_item(F, PROJ, (float*)(ws + WS_KVT), cc, h, -__expf(rd[h]) * LOG2E, -__expf(rd[8 + h]) * LOG2E); }
        if (BOTH(3)) xcd_barrier(bar);
    }
    if (IN(4)) REP(4) { REFRESH(); ret_scan_phase(F, (const float*)(ws + WS_KVT), (bf16*)(ws + WS_SPT), args.in[9]); if (BOTH(4)) xcd_barrier(bar); }
    if (IN(5)) REP(5) { REFRESH();
        const float* rd = args.in[9];
        for (int it = F.vcu; it < 512; it += F.G) { const int c = it >> 3, h = it & 7;
            ret_out_item(F, PROJ, (const bf16*)(ws + WS_SPT), Y, c, h, -__expf(rd[h]) * LOG2E, -__expf(rd[8 + h]) * LOG2E); }
        if (BOTH(5)) xcd_barrier(bar);
    }
    if (IN(6)) REP(6) { REFRESH();
        pg8::Gemm g{Y, (const bf16*)(ws + WS_WOUT), L, D, D}; pg8::StaticOrder S; S.init(L, D, F.G, (int)blockIdx.x);
        pg8::EpiResid E{args.in[0], args.out, mod + 2 * D, D};
        pg8::gemm_phase<pg8::EpiResid, pg8::StaticOrder, true, true>(F.lds + RING_OFF, g, S, E);
        if (BOTH(6)) xcd_barrier(bar);
    }
    if (IN(7)) REP(7) { REFRESH();
        for (int m = gw; m < L; m += 2 * NGW) { const int m2 = m + NGW < L ? m + NGW : m;
            modulate_row2(args.out + (size_t)m * D, args.out + (size_t)m2 * D, args.in[7], mod + 3 * D, mod + 4 * D, mod + 3 * D, mod + 4 * D, HX + (size_t)m * D, HX + (size_t)m2 * D, F.lane); }
        if (BOTH(7)) xcd_barrier(bar);
    }
    if (IN(8)) REP(8) { REFRESH();
        pg8::Gemm g{HX, (const bf16*)(ws + WS_WGU), L, 2 * DFF, D}; pg8::StaticOrder S; S.init(L, 2 * DFF, F.G, (int)blockIdx.x);
        pg8::EpiSwiglu E{ACT, DFF};
        pg8::gemm_phase<pg8::EpiSwiglu, pg8::StaticOrder, true, true>(F.lds + RING_OFF, g, S, E);
        if (!(((PROBE_DBL >> 8) & 1) && rep_ == 1)) { const int extra = S.nwg % F.G; const int c = (int)blockIdx.x;
            if (extra == 0) p0_deferred(F, args, 1, c * NWAVES + F.wave, F.G * NWAVES);
            else if (c >= extra) p0_deferred(F, args, 1, (c - extra) * NWAVES + F.wave, (F.G - extra) * NWAVES); }
        if (BOTH(8)) xcd_barrier(bar);
    }
    if (IN(9)) REP(9) { REFRESH();
        pg8::Gemm g{ACT, (const bf16*)(ws + WS_WDN), L, D, DFF}; pg8::StaticOrder S; S.init(L, D, F.G, (int)blockIdx.x);
        pg8::EpiResid E{args.out, DUMMY(9) ? (float*)(ws + WS_PROJ) : args.out, mod + 5 * D, D};
        pg8::gemm_phase<pg8::EpiResid, pg8::StaticOrder, true, true>(F.lds + RING_OFF, g, S, E);
        if (BOTH(9)) xcd_barrier(bar);
    }
    if (IN(10)) REP(10) { REFRESH(); float* dst = DUMMY(10) ? (float*)(ws + WS_PROJ) : args.out; for (int m = gw; m < L; m += NGW) final_norm_row(args.out + (size_t)m * D, dst + (size_t)m * D, args.in[15], F.lane); }
#undef IN
#undef REP
#undef REFRESH
#undef DUMMY
#undef BOTH
}

extern "C" void kernel_launch(void* const* d_in, const int* in_sizes, int n_in, void* d_out, int out_size, void* d_ws, size_t ws_size, hipStream_t stream) {
    static int grid = 0;
    if (grid == 0) {
        if (n_in != 16 || in_sizes[0] != L * D || out_size != L * D || ws_size < WS_END) { fprintf(stderr, "kernel_launch: unexpected shapes (n_in %d, in0 %d, out %d, ws %zu)\n", n_in, n_in > 0 ? in_sizes[0] : -1, out_size, ws_size); grid = -1; return; }
        int dev = 0, cus = 0, per_cu = 0;
        if (hipGetDevice(&dev) != hipSuccess || hipDeviceGetAttribute(&cus, hipDeviceAttributeMultiprocessorCount, dev) != hipSuccess) { grid = -1; return; }
        if (hipFuncSetAttribute((const void*)mk_fwd, hipFuncAttributeMaxDynamicSharedMemorySize, LDS_BYTES) != hipSuccess) { fprintf(stderr, "kernel_launch: hipFuncSetAttribute failed\n"); grid = -1; return; }
        if (hipOccupancyMaxActiveBlocksPerMultiprocessor(&per_cu, (const void*)mk_fwd, NWAVES * 64, LDS_BYTES) != hipSuccess || per_cu < 1) { fprintf(stderr, "kernel_launch: occupancy query says %d blocks per CU\n", per_cu); grid = -1; (void)hipGetLastError(); return; }
        (void)hipGetLastError();
        grid = cus;
    }
    if (grid < 0) return;
    unsigned char* ws = (unsigned char*)d_ws;
    hipMemsetAsync(ws + WS_CTL, 0, CTL_BYTES, stream);
    Args a{};
    for (int i = 0; i < 16; ++i) a.in[i] = (const float*)d_in[i];
    a.out = (float*)d_out; a.ws = ws;
    a.ph_lo = 0; a.ph_hi = 11; a.li = 0;
    hipLaunchKernelGGL(mk_fwd, dim3(grid), dim3(NWAVES * 64), LDS_BYTES, stream, a);
}
```

```cpp
#ifndef PROBE_DBL
#define PROBE_DBL 0
#endif
#include <hip/hip_runtime.h>
#include <cstdio>
#include <cstdint>
#include <cmath>

typedef unsigned short bf16;
typedef unsigned u32x4 __attribute__((ext_vector_type(4)));
typedef float f32x4 __attribute__((ext_vector_type(4)));

constexpr int D = 2048, L = 8192, LC = 256, MROWS = L + LC;
constexpr int NPROJ = 4608, DFF = 5632;
constexpr int RH = 8, RDK = 64, RDV = 128, CH = 128, NCH = L / CH;
constexpr int AH = 16, AKV = 4, ADH = 64, WIN = 128;
constexpr float EPS = 1e-6f;
constexpr float LOG2E = 1.4426950408889634f;
constexpr int C_RQ = 0, C_RK = 512, C_RV = 1024, C_RG = 2048, C_AQ = 3072, C_AK = 4096, C_AV = 4352;

constexpr size_t MiB = 1u << 20;
constexpr size_t WS_CTL = 0, CTL_BYTES = 1 * MiB;
constexpr size_t WS_MOD = 1 * MiB;
constexpr size_t WS_HX = 100 * MiB;
constexpr size_t WS_PROJ = 134 * MiB;
constexpr size_t WS_Y = 209 * MiB;
constexpr size_t WS_ACT = 290 * MiB;
constexpr size_t WS_TMP = 209 * MiB;
constexpr size_t WS_OFB = 290 * MiB;
constexpr size_t WS_END = 384 * MiB;

__device__ __forceinline__ float bf2f(bf16 v) { return __uint_as_float((unsigned)v << 16); }
__device__ __forceinline__ bf16 f2bf_n(float f) { unsigned u = __float_as_uint(f); return (bf16)((u + 0x7fffu + ((u >> 16) & 1u)) >> 16); }
__device__ __forceinline__ float silu_f(float x) { return x / (1.f + __expf(-x)); }

__global__ __launch_bounds__(256) void nv_mod(const float* c, const float* cctx, const float* w_mod, const float* b_mod, float* mod) {
    __shared__ float s[2][D];
    for (int i = threadIdx.x; i < D; i += 256) { s[0][i] = silu_f(c[i]); s[1][i] = silu_f(cctx[i]); }
    __syncthreads();
    const int n = blockIdx.x * 256 + threadIdx.x;
    float a0 = 0.f, a1 = 0.f;
    for (int k = 0; k < D; ++k) { const float w = w_mod[(size_t)k * (6 * D) + n]; a0 += s[0][k] * w; a1 += s[1][k] * w; }
    mod[n] = a0 + b_mod[n]; mod[6 * D + n] = a1 + b_mod[n];
}
__global__ __launch_bounds__(256) void nv_modulate(const float* src, const float* g, const float* shift, const float* scale, bf16* out) {
    __shared__ float red[4];
    const int row = blockIdx.x; const float* x = src + (size_t)row * D;
    float v[8]; float ss = 0.f;
#pragma unroll
    for (int i = 0; i < 8; ++i) { v[i] = x[threadIdx.x + 256 * i]; ss += v[i] * v[i]; }
#pragma unroll
    for (int o = 1; o < 64; o <<= 1) ss += __shfl_xor(ss, o);
    if ((threadIdx.x & 63) == 0) red[threadIdx.x >> 6] = ss;
    __syncthreads();
    const float r = rsqrtf((red[0] + red[1] + red[2] + red[3]) * (1.f / D) + EPS);
#pragma unroll
    for (int i = 0; i < 8; ++i) { const int cidx = threadIdx.x + 256 * i; out[(size_t)row * D + cidx] = f2bf_n(v[i] * r * g[cidx] * (1.f + scale[cidx]) + shift[cidx]); }
}
template <int MODE> __global__ __launch_bounds__(256) void nv_gemm(const bf16* A, int lda, const float* B, const float* B2, int ldb, int K,
                                                                     float* Cf, bf16* Cb, int ldc, const float* R, const float* gate) {
    __shared__ float As[16][132]; __shared__ float Bs[16][64]; __shared__ float Bs2[16][64];
    const int tid = threadIdx.x, tx = tid & 15, ty = tid >> 4;
    const int m0 = blockIdx.y * 128, n0 = blockIdx.x * 64;
    float acc[8][4], acc2[8][4];
#pragma unroll
    for (int i = 0; i < 8; ++i)
#pragma unroll
        for (int j = 0; j < 4; ++j) { acc[i][j] = 0.f; acc2[i][j] = 0.f; }
    const int arow = tid >> 1, akh = (tid & 1) * 8, bk = tid >> 4, bn4 = (tid & 15) * 4;
    for (int k0 = 0; k0 < K; k0 += 16) {
        const u32x4 av = *(const u32x4*)(A + (size_t)(m0 + arow) * lda + k0 + akh);
        const f32x4 bv = *(const f32x4*)(B + (size_t)(k0 + bk) * ldb + n0 + bn4);
        f32x4 bv2 = bv; if (MODE == 1) bv2 = *(const f32x4*)(B2 + (size_t)(k0 + bk) * ldb + n0 + bn4);
#pragma unroll
        for (int i = 0; i < 4; ++i) { As[akh + 2 * i][arow] = __uint_as_float(av[i] << 16); As[akh + 2 * i + 1][arow] = __uint_as_float(av[i] & 0xffff0000u); }
        *(f32x4*)&Bs[bk][bn4] = bv; if (MODE == 1) *(f32x4*)&Bs2[bk][bn4] = bv2;
        __syncthreads();
#pragma unroll
        for (int k = 0; k < 16; ++k) {
            float a[8], b[4], b2[4];
#pragma unroll
            for (int i = 0; i < 8; ++i) a[i] = As[k][ty * 8 + i];
#pragma unroll
            for (int j = 0; j < 4; ++j) { b[j] = Bs[k][tx * 4 + j]; b2[j] = (MODE == 1) ? Bs2[k][tx * 4 + j] : 0.f; }
#pragma unroll
            for (int i = 0; i < 8; ++i)
#pragma unroll
                for (int j = 0; j < 4; ++j) { acc[i][j] += a[i] * b[j]; if (MODE == 1) acc2[i][j] += a[i] * b2[j]; }
        }
        __syncthreads();
    }
#pragma unroll
    for (int i = 0; i < 8; ++i)
#pragma unroll
        for (int j = 0; j < 4; ++j) {
            const size_t r = m0 + ty * 8 + i; const int cidx = n0 + tx * 4 + j;
            if (MODE == 0) Cf[r * ldc + cidx] = acc[i][j];
            if (MODE == 1) Cb[r * ldc + cidx] = f2bf_n(silu_f(acc[i][j]) * acc2[i][j]);
            if (MODE == 2) Cf[r * ldc + cidx] = R[r * ldc + cidx] + gate[cidx] * acc[i][j];
        }
}
__global__ __launch_bounds__(256) void nv_proj_epi(const float* tmp, bf16* proj) {
    const size_t idx = (size_t)blockIdx.x * 256 + threadIdx.x;
    const int row = (int)(idx / NPROJ), col = (int)(idx % NPROJ);
    const bool isctx = row >= L; const int t = row;
    const float* tr = tmp + (size_t)row * NPROJ;
    const float v = tr[col]; float o = v;
    if (col < C_RV) {
        if (!isctx) {
            const int d = col & 63, j = d & 31;
            const float inv = powf(10000.f, -(float)j / 32.f), ang = (float)t * inv; float sn, cs; sincosf(ang, &sn, &cs);
            if (d < 32) o = v * cs - tr[col + 32] * sn; else o = tr[col - 32] * sn + v * cs;
        }
        if (col >= C_RK) o *= 0.125f;
    } else if (col < C_RG) {
    } else if (col < C_AQ) { o = silu_f(v);
    } else if (col < C_AV) {
        if (!isctx) {
            const int d = (col - C_AQ) & 63, hf = d >> 5, dd = d & 31, j = dd & 15;
            const int pos = hf == 0 ? (t >> 6) : (t & 63);
            const float inv = powf(10000.f, -(float)j / 16.f), ang = (float)pos * inv; float sn, cs; sincosf(ang, &sn, &cs);
            if (dd < 16) o = v * cs - tr[col + 16] * sn; else o = tr[col - 16] * sn + v * cs;
        }
        if (col < C_AK) o *= 0.125f * LOG2E;
    }
    proj[idx] = f2bf_n(o);
}
__global__ __launch_bounds__(128) void nv_ret_scan(const bf16* proj, const float* ret_decay, float* ofb) {
    const int h = blockIdx.x & 7, dir = blockIdx.x >> 3, v = threadIdx.x;
    const float gam = __expf(-__expf(ret_decay[dir * RH + h]));
    float S[64];
#pragma unroll
    for (int d = 0; d < 64; ++d) S[d] = 0.f;
    float* out = ofb + (size_t)dir * L * 1024 + h * 128 + v;
    for (int step = 0; step < LC + L; ++step) {
        int row; bool lat;
        if (dir == 0) { lat = step >= LC; row = lat ? step - LC : L + step; }
        else { lat = step >= LC; row = lat ? (L - 1 - (step - LC)) : (L + LC - 1 - step); }
        const bf16* pr = proj + (size_t)row * NPROJ;
        const float vv = bf2f(pr[C_RV + h * 128 + v]);
        float kf[64], qf[64];
#pragma unroll
        for (int i = 0; i < 8; ++i) { const u32x4 kk = *(const u32x4*)(pr + C_RK + h * 64 + i * 8); const u32x4 qq = *(const u32x4*)(pr + C_RQ + h * 64 + i * 8);
#pragma unroll
            for (int e = 0; e < 4; ++e) { kf[i * 8 + 2 * e] = __uint_as_float(kk[e] << 16); kf[i * 8 + 2 * e + 1] = __uint_as_float(kk[e] & 0xffff0000u);
                                          qf[i * 8 + 2 * e] = __uint_as_float(qq[e] << 16); qf[i * 8 + 2 * e + 1] = __uint_as_float(qq[e] & 0xffff0000u); } }
        if (dir == 0) {
            float o = 0.f;
#pragma unroll
            for (int d = 0; d < 64; ++d) { S[d] = gam * S[d] + kf[d] * vv; o += qf[d] * S[d]; }
            if (lat) out[(size_t)row * 1024] = o;
        } else {
            float o = 0.f;
#pragma unroll
            for (int d = 0; d < 64; ++d) { o += qf[d] * S[d]; S[d] = gam * S[d] + kf[d] * vv; }
            if (lat) out[(size_t)row * 1024] = gam * o;
        }
    }
}
__global__ __launch_bounds__(128) void nv_ret_out(const float* ofb, const bf16* proj, bf16* Y) {
    __shared__ float red[2];
    const int t = blockIdx.x >> 3, h = blockIdx.x & 7, v = threadIdx.x;
    const size_t i = (size_t)t * 1024 + h * 128 + v;
    const float o = ofb[i] + ofb[(size_t)L * 1024 + i];
    float ss = o * o;
#pragma unroll
    for (int k = 1; k < 64; k <<= 1) ss += __shfl_xor(ss, k);
    if ((v & 63) == 0) red[v >> 6] = ss;
    __syncthreads();
    const float r = rsqrtf((red[0] + red[1]) * (1.f / 128.f) + EPS);
    Y[(size_t)t * D + h * 128 + v] = f2bf_n(o * r * bf2f(proj[(size_t)t * NPROJ + C_RG + h * 128 + v]));
}
__global__ __launch_bounds__(64) void nv_attn(const bf16* proj, const float* sink, bf16* Y) {
    const int idx = blockIdx.x * 64 + threadIdx.x; const int hq = idx / L, t = idx % L, kvh = hq >> 2;
    float q[64], acc[64];
    const bf16* qp = proj + (size_t)t * NPROJ + C_AQ + hq * 64;
#pragma unroll
    for (int d = 0; d < 64; ++d) { q[d] = bf2f(qp[d]); acc[d] = 0.f; }
    float m = sink[hq] * LOG2E, l = 1.f;
    const int lo = t - WIN < 0 ? 0 : t - WIN, hi = t + WIN > L - 1 ? L - 1 : t + WIN;
    const int nloc = hi - lo + 1;
    for (int s = 0; s < nloc + LC; ++s) {
        const int row = s < nloc ? lo + s : L + (s - nloc);
        const bf16* kp = proj + (size_t)row * NPROJ + C_AK + kvh * 64; const bf16* vp = proj + (size_t)row * NPROJ + C_AV + kvh * 64;
        float sc = 0.f;
#pragma unroll
        for (int d = 0; d < 64; ++d) sc += q[d] * bf2f(kp[d]);
        float p;
        if (sc > m) { const float f = exp2f(m - sc); l *= f;
#pragma unroll
            for (int d = 0; d < 64; ++d) acc[d] *= f;
            m = sc; p = 1.f; }
        else p = exp2f(sc - m);
        l += p;
#pragma unroll
        for (int d = 0; d < 64; ++d) acc[d] += p * bf2f(vp[d]);
    }
    const float rl = 1.f / l;
    bf16* yp = Y + (size_t)t * D + 1024 + hq * 64;
#pragma unroll
    for (int d = 0; d < 64; ++d) yp[d] = f2bf_n(acc[d] * rl);
}
__global__ __launch_bounds__(256) void nv_final_norm(float* xio, const float* g) {
    __shared__ float red[4];
    float* x = xio + (size_t)blockIdx.x * D;
    float v[8]; float ss = 0.f;
#pragma unroll
    for (int i = 0; i < 8; ++i) { v[i] = x[threadIdx.x + 256 * i]; ss += v[i] * v[i]; }
#pragma unroll
    for (int o = 1; o < 64; o <<= 1) ss += __shfl_xor(ss, o);
    if ((threadIdx.x & 63) == 0) red[threadIdx.x >> 6] = ss;
    __syncthreads();
    const float r = rsqrtf((red[0] + red[1] + red[2] + red[3]) * (1.f / D) + EPS);
#pragma unroll
    for (int i = 0; i < 8; ++i) { const int c = threadIdx.x + 256 * i; x[c] = v[i] * r * g[c]; }
}

namespace pg8 {
#define PG8_LAS __attribute__((address_space(3)))
typedef unsigned short bf16_t;
typedef short bf16x8 __attribute__((ext_vector_type(8)));
typedef float f32x4 __attribute__((ext_vector_type(4)));
typedef unsigned u32x4 __attribute__((ext_vector_type(4)));
constexpr int BM = 256, BK = 64, HALF = 128, HTB = HALF * BK * 2  , STAGE_BYTES = 8 * HTB, NXCD = 8, WGM = 8;

__host__ __device__ __forceinline__ int lds_byte(int r, int c) { const int st = (r >> 4) * 2 + (c >> 5), rr = r & 15, cc = c & 31, ob = rr * 64 + cc * 2; return st * 1024 + (ob ^ (((ob >> 9) & 1) << 5)); }
__host__ __device__ __forceinline__ void stage_rc(int b, int& R, int& C) { const int st = b / 1024, sb = b % 1024, swz = sb ^ (((sb >> 9) & 1) << 5); R = (st >> 1) * 16 + swz / 64; C = (st & 1) * 32 + (swz % 64) / 2; }
__host__ __device__ __forceinline__ int perm32(int rho) { const int n = rho >> 4, i = rho & 15; return 8 * (i >> 2) + 4 * n + (i & 3); }

struct Unit { int pm, pn; };
struct Gemm { const bf16_t* A; const bf16_t* Bt; int M, N, K; };

struct StaticOrder {
    int nM, nN, nwg, G, c;
    __host__ __device__ void init(int M, int N, int G_, int c_) { nM = M / BM; nN = N / BM; nwg = nM * nN; G = G_; c = c_; }
    __host__ __device__ bool next(int i, Unit& u) const {
        const long L = (long)i * G + c; if (L >= nwg) return false;
        int wgid = (int)L; { const int q = nwg / NXCD, r = nwg % NXCD, xcd = wgid % NXCD, off = wgid / NXCD; wgid = (xcd < r ? xcd * (q + 1) : r * (q + 1) + (xcd - r) * q) + off; }
        const int nig = WGM * nN, gid = wgid / nig, fm = gid * WGM, gsz = (nM - fm) < WGM ? (nM - fm) : WGM;
        u.pm = fm + ((wgid % nig) % gsz); u.pn = (wgid % nig) / gsz; return true;
    }
    __device__ __forceinline__ void a_ready(const Unit&) const {}
    __device__ __forceinline__ void done(const Unit&) const {}
};
__device__ __forceinline__ unsigned cvt_pk_bf16(float lo, float hi) { unsigned r; asm volatile("v_cvt_pk_bf16_f32 %0, %1, %2" : "=v"(r) : "v"(lo), "v"(hi)); return r; }
typedef float f32x2 __attribute__((ext_vector_type(2)));
template <class Epi, class Sched, bool ALIGN_EPI = false, bool SP2 = false>
__device__ __forceinline__ void gemm_phase(PG8_LAS unsigned char* lds, const Gemm g, const Sched& S, const Epi& E) {
    const int tid = threadIdx.x, wid = __builtin_amdgcn_readfirstlane(tid >> 6), lane = tid & 63, wr = wid >> 2, wc = wid & 3, fr = lane & 15, fq = lane >> 4;
    const int K = g.K, nt = K / BK;
    unsigned voffA[2], voffB[2];
#pragma unroll
    for (int i = 0; i < 2; ++i) { int R, C; stage_rc(tid * 16 + i * 8192, R, C); const int Rb = Epi::PERM ? ((R & ~31) + perm32(R & 31)) : R;
        voffA[i] = (unsigned)(R * K + C) * 2u; voffB[i] = (unsigned)(Rb * K + C) * 2u; }
    const size_t kstep = (size_t)(BK * 2);
    const size_t hstep = (size_t)HALF * K * 2;
    const size_t tstep = 2 * hstep;
    const unsigned ldsw = (unsigned)wid * 1024u;
    const int aoff = lds_byte(wr * 64 + fr, fq * 8), boff = lds_byte(wc * 32 + fr, fq * 8);
#define PG8_SA(b, h) (((b) * 2 + (h)) * HTB)
#define PG8_SB(b, h) ((4 + (b) * 2 + (h)) * HTB)
#define PG8_STAGE(bufoff, gbase, voff) do { _Pragma("unroll") for (int _i = 0; _i < 2; ++_i) \
        __builtin_amdgcn_global_load_lds((const unsigned*)((const char*)(gbase) + (voff)[_i]), (PG8_LAS unsigned*)(lds + (bufoff) + ldsw + _i * 8192), 16, 0, 0); } while (0)
#define PG8_LDA(dst, b, h) do { _Pragma("unroll") for (int m = 0; m < 4; ++m) _Pragma("unroll") for (int k = 0; k < 2; ++k) dst[m][k] = *(const PG8_LAS bf16x8*)(lds + PG8_SA(b, h) + aoff + m * 2048 + k * 1024); } while (0)
#define PG8_LDB(dst, b, h) do { _Pragma("unroll") for (int n = 0; n < 2; ++n) _Pragma("unroll") for (int k = 0; k < 2; ++k) dst[n][k] = *(const PG8_LAS bf16x8*)(lds + PG8_SB(b, h) + boff + n * 2048 + k * 1024); } while (0)
#define PG8_MMA(ai, bj, At, Bt) do { __builtin_amdgcn_s_setprio(1); _Pragma("unroll") for (int m = 0; m < 4; ++m) _Pragma("unroll") for (int n = 0; n < 2; ++n) _Pragma("unroll") for (int k = 0; k < 2; ++k) \
        acc[ai][bj][m][n] = __builtin_amdgcn_mfma_f32_16x16x32_bf16(Bt[n][k], At[m][k], acc[ai][bj][m][n], 0, 0, 0); __builtin_amdgcn_s_setprio(0); } while (0)
#define PG8_WAIT_V(n) asm volatile("s_waitcnt vmcnt(" #n ")" ::: "memory")
#define PG8_WAIT_L(n) asm volatile("s_waitcnt lgkmcnt(" #n ")" ::: "memory")
#define PG8_BAR __builtin_amdgcn_s_barrier()
#define PG8_SCHED __builtin_amdgcn_sched_barrier(0)
    Unit cur, nxt; int ui = 0;
    if (!S.next(0, cur)) return;
    f32x4 acc[2][2][4][2];
#pragma unroll
    for (int a = 0; a < 2; ++a)
#pragma unroll
        for (int b = 0; b < 2; ++b)
#pragma unroll
            for (int m = 0; m < 4; ++m)
#pragma unroll
                for (int n = 0; n < 2; ++n) acc[a][b][m][n] = (f32x4){0.f, 0.f, 0.f, 0.f};
    bf16x8 At[4][2], B0[2][2], B1[2][2];
    const char* cA = (const char*)g.A + (size_t)cur.pm * tstep; const char* cB = (const char*)g.Bt + (size_t)cur.pn * tstep;
    S.a_ready(cur);
    if constexpr (SP2) {
        PG8_STAGE(PG8_SB(0, 0), cB, voffB); PG8_STAGE(PG8_SB(0, 1), cB + hstep, voffB); PG8_STAGE(PG8_SA(0, 0), cA, voffA); PG8_STAGE(PG8_SA(0, 1), cA + hstep, voffA);
        if (wr == 1) PG8_BAR;
        PG8_WAIT_V(2); PG8_BAR;
        PG8_STAGE(PG8_SB(1, 0), cB + kstep, voffB); PG8_STAGE(PG8_SA(1, 0), cA + kstep, voffA); PG8_STAGE(PG8_SB(1, 1), cB + hstep + kstep, voffB);
        PG8_WAIT_V(6); PG8_BAR;
    } else {
        PG8_STAGE(PG8_SB(0, 0), cB, voffB); PG8_STAGE(PG8_SA(0, 0), cA, voffA); PG8_STAGE(PG8_SB(0, 1), cB + hstep, voffB); PG8_STAGE(PG8_SA(0, 1), cA + hstep, voffA);
        if (wr == 1) PG8_BAR;
        PG8_WAIT_V(4); PG8_BAR;
        PG8_STAGE(PG8_SB(1, 0), cB + kstep, voffB); PG8_STAGE(PG8_SA(1, 0), cA + kstep, voffA); PG8_STAGE(PG8_SB(1, 1), cB + hstep + kstep, voffB);
        PG8_WAIT_V(6); PG8_BAR;
    }
    for (;;) {
        const bool has_next = S.next(ui + 1, nxt);
        const char* nA = has_next ? (const char*)g.A + (size_t)nxt.pm * tstep : cA; const char* nB = has_next ? (const char*)g.Bt + (size_t)nxt.pn * tstep : cB;
        for (int t = 0; t < nt; t += 2) {
            const bool last = (t == nt - 2);
            const char* a1 = cA + (size_t)(t + 1) * kstep;
            const char* a2 = last ? nA : cA + (size_t)(t + 2) * kstep; const char* b2 = last ? nB : cB + (size_t)(t + 2) * kstep;
            const char* a3 = a2 + kstep; const char* b3 = b2 + kstep;
            if (last && has_next) S.a_ready(nxt);
            if constexpr (SP2) {
            PG8_LDB(B0, 0, 0); PG8_LDB(B1, 0, 1); PG8_SCHED; PG8_LDA(At, 0, 0); PG8_STAGE(PG8_SA(1, 1), a1 + hstep, voffA);
            PG8_WAIT_V(8); PG8_WAIT_L(0); PG8_BAR; PG8_MMA(0, 0, At, B0); PG8_MMA(0, 1, At, B1); PG8_BAR; PG8_SCHED;
            PG8_LDA(At, 0, 1); PG8_STAGE(PG8_SB(0, 0), b2, voffB); PG8_STAGE(PG8_SB(0, 1), b2 + hstep, voffB); PG8_STAGE(PG8_SA(0, 0), a2, voffA);
            PG8_WAIT_V(8); PG8_WAIT_L(0); PG8_BAR; PG8_MMA(1, 0, At, B0); PG8_MMA(1, 1, At, B1); PG8_BAR; PG8_SCHED;
            PG8_LDB(B0, 1, 0); PG8_LDB(B1, 1, 1); PG8_SCHED; PG8_LDA(At, 1, 0); PG8_STAGE(PG8_SA(0, 1), a2 + hstep, voffA);
            PG8_WAIT_V(8); PG8_WAIT_L(0); PG8_BAR; PG8_MMA(0, 0, At, B0); PG8_MMA(0, 1, At, B1); PG8_BAR; PG8_SCHED;
            PG8_LDA(At, 1, 1); PG8_STAGE(PG8_SB(1, 0), b3, voffB); PG8_STAGE(PG8_SB(1, 1), b3 + hstep, voffB); PG8_STAGE(PG8_SA(1, 0), a3, voffA);
            PG8_WAIT_V(8); PG8_WAIT_L(0); PG8_BAR; PG8_MMA(1, 0, At, B0); PG8_MMA(1, 1, At, B1); PG8_BAR; PG8_SCHED;
            } else {
            PG8_LDB(B0, 0, 0); PG8_SCHED; PG8_LDA(At, 0, 0); PG8_STAGE(PG8_SA(1, 1), a1 + hstep, voffA);
            PG8_WAIT_L(8); PG8_BAR; PG8_WAIT_L(0); PG8_MMA(0, 0, At, B0); PG8_BAR; PG8_SCHED;
            PG8_LDB(B1, 0, 1); PG8_STAGE(PG8_SB(0, 0), b2, voffB);
            PG8_BAR; PG8_WAIT_L(0); PG8_MMA(0, 1, At, B1); PG8_BAR;
            PG8_LDA(At, 0, 1); PG8_STAGE(PG8_SA(0, 0), a2, voffA);
            PG8_BAR; PG8_WAIT_L(0); PG8_MMA(1, 0, At, B0); PG8_BAR; PG8_SCHED;
            PG8_STAGE(PG8_SB(0, 1), b2 + hstep, voffB);
            PG8_WAIT_V(6); PG8_BAR; PG8_MMA(1, 1, At, B1); PG8_BAR;
            PG8_LDB(B0, 1, 0); PG8_SCHED; PG8_LDA(At, 1, 0); PG8_STAGE(PG8_SA(0, 1), a2 + hstep, voffA);
            PG8_WAIT_L(8); PG8_BAR; PG8_WAIT_L(0); PG8_MMA(0, 0, At, B0); PG8_BAR; PG8_SCHED;
            PG8_LDB(B1, 1, 1); PG8_STAGE(PG8_SB(1, 0), b3, voffB);
            PG8_BAR; PG8_WAIT_L(0); PG8_MMA(0, 1, At, B1); PG8_BAR;
            PG8_LDA(At, 1, 1); PG8_STAGE(PG8_SA(1, 0), a3, voffA);
            PG8_BAR; PG8_WAIT_L(0); PG8_MMA(1, 0, At, B0); PG8_BAR; PG8_SCHED;
            PG8_STAGE(PG8_SB(1, 1), b3 + hstep, voffB);
            PG8_WAIT_V(6); PG8_BAR; PG8_MMA(1, 1, At, B1); PG8_BAR;
            }
        }
        if constexpr (ALIGN_EPI) { if (wr == 0) PG8_BAR; }
        if constexpr (!Epi::AFTER_DRAIN) { E(acc, cur, wr, wc, fr, fq); S.done(cur); }
        if (!has_next) break;
#pragma unroll
        for (int a = 0; a < 2; ++a)
#pragma unroll
            for (int b = 0; b < 2; ++b)
#pragma unroll
                for (int m = 0; m < 4; ++m)
#pragma unroll
                    for (int n = 0; n < 2; ++n) acc[a][b][m][n] = (f32x4){0.f, 0.f, 0.f, 0.f};
        cur = nxt; cA = nA; cB = nB; ++ui;
        if constexpr (ALIGN_EPI) { if (wr == 1) PG8_BAR; }
    }
    PG8_WAIT_V(0);
    if constexpr (!ALIGN_EPI) { if (wr == 0) PG8_BAR; }
    PG8_BAR;
    if constexpr (Epi::AFTER_DRAIN) { E.fused(acc, cur, wr, wc, fr, fq, lds, wid, lane); S.done(cur); }
#undef PG8_SA
#undef PG8_SB
#undef PG8_STAGE
#undef PG8_LDA
#undef PG8_LDB
#undef PG8_MMA
#undef PG8_WAIT_V
#undef PG8_WAIT_L
#undef PG8_BAR
#undef PG8_SCHED
}
}
namespace pg8 {
__device__ __forceinline__ float silu_fast(float x) { return x * __builtin_amdgcn_rcpf(1.f + __expf(-x)); }
struct EpiProj {
    static constexpr bool PERM = true, AFTER_DRAIN = false;
    bf16_t* P; const float* rtc; const float* rts; const float* axc; const float* axs;
    __device__ __forceinline__ void operator()(const f32x4 (&acc)[2][2][4][2], const Unit& u, int wr, int wc, int fr, int fq) const {
        const int pn = u.pn; const bool isctx = (u.pm == 32);
        const int row0 = u.pm * BM + wr * 64 + fr;
        int type = 0; float sc = 1.f;
        if (pn < 4) { type = 2; if (pn >= 2) sc = 0.125f; }
        else if (pn < 8) type = 0;
        else if (pn < 12) type = 1;
        else if (pn < 17) { type = 3; if (pn < 16) sc = 0.125f * 1.4426950408889634f; }
        if (type < 2) {
#pragma unroll
            for (int ai = 0; ai < 2; ++ai)
#pragma unroll
                for (int m = 0; m < 4; ++m) { bf16_t* rowp = P + (size_t)(row0 + ai * HALF + m * 16) * 4608 + pn * BM + wc * 32 + 8 * fq;
#pragma unroll
                    for (int bj = 0; bj < 2; ++bj) { f32x4 v0 = acc[ai][bj][m][0], v1 = acc[ai][bj][m][1];
                        if (type == 1) {
#pragma unroll
                            for (int e = 0; e < 4; ++e) { v0[e] = silu_fast(v0[e]); v1[e] = silu_fast(v1[e]); } }
                        u32x4 w; w.x = cvt_pk_bf16(v0[0], v0[1]); w.y = cvt_pk_bf16(v0[2], v0[3]); w.z = cvt_pk_bf16(v1[0], v1[1]); w.w = cvt_pk_bf16(v1[2], v1[3]);
                        *(u32x4*)(rowp + bj * HALF) = w; } }
        } else {
            const int hf = fq >> 1;
#pragma unroll
            for (int ai = 0; ai < 2; ++ai)
#pragma unroll
                for (int m = 0; m < 4; ++m) { const int r = row0 + ai * HALF + m * 16;
                    f32x4 cs[2], sn[2];
                    if (isctx) { cs[0] = cs[1] = (f32x4){1.f, 1.f, 1.f, 1.f}; sn[0] = sn[1] = (f32x4){0.f, 0.f, 0.f, 0.f}; }
                    else if (type == 2) { const size_t o = (size_t)r * 32 + 8 * fq; cs[0] = *(const f32x4*)(rtc + o); cs[1] = *(const f32x4*)(rtc + o + 4); sn[0] = *(const f32x4*)(rts + o); sn[1] = *(const f32x4*)(rts + o + 4); }
                    else { const int pos = hf ? (r & 63) : (r >> 6); const int o = pos * 16 + 8 * (fq & 1); cs[0] = *(const f32x4*)(axc + o); cs[1] = *(const f32x4*)(axc + o + 4); sn[0] = *(const f32x4*)(axs + o); sn[1] = *(const f32x4*)(axs + o + 4); }
                    f32x4 o1[2], o2[2];
#pragma unroll
                    for (int n = 0; n < 2; ++n) { const f32x4 x1 = acc[ai][0][m][n], x2 = acc[ai][1][m][n]; o1[n] = (x1 * cs[n] - x2 * sn[n]) * sc; o2[n] = (x1 * sn[n] + x2 * cs[n]) * sc; }
                    u32x4 w1, w2; w1.x = cvt_pk_bf16(o1[0][0], o1[0][1]); w1.y = cvt_pk_bf16(o1[0][2], o1[0][3]); w1.z = cvt_pk_bf16(o1[1][0], o1[1][1]); w1.w = cvt_pk_bf16(o1[1][2], o1[1][3]);
                    w2.x = cvt_pk_bf16(o2[0][0], o2[0][1]); w2.y = cvt_pk_bf16(o2[0][2], o2[0][3]); w2.z = cvt_pk_bf16(o2[1][0], o2[1][1]); w2.w = cvt_pk_bf16(o2[1][2], o2[1][3]);
                    bf16_t* rowp = P + (size_t)r * 4608 + pn * BM + wc * 64;
                    if (type == 2) { *(u32x4*)(rowp + 8 * fq) = w1; *(u32x4*)(rowp + 32 + 8 * fq) = w2; }
                    else { *(u32x4*)(rowp + 32 * hf + 8 * (fq & 1)) = w1; *(u32x4*)(rowp + 32 * hf + 16 + 8 * (fq & 1)) = w2; } }
        }
    }
};
struct EpiResid {
    static constexpr bool PERM = false, AFTER_DRAIN = false;
    const float* R; float* out; const float* gate; int ldc;
    __device__ __forceinline__ void operator()(const f32x4 (&acc)[2][2][4][2], const Unit& u, int wr, int wc, int fr, int fq) const {
        const int row0 = u.pm * BM + wr * 64 + fr, col0 = u.pn * BM + wc * 32 + 4 * fq;
        f32x4 gv[2][2];
#pragma unroll
        for (int bj = 0; bj < 2; ++bj)
#pragma unroll
            for (int n = 0; n < 2; ++n) gv[bj][n] = *(const f32x4*)(gate + col0 + bj * HALF + n * 16);
#pragma unroll
        for (int ai = 0; ai < 2; ++ai)
#pragma unroll
            for (int m = 0; m < 4; ++m) { const size_t off = (size_t)(row0 + ai * HALF + m * 16) * ldc + col0;
#pragma unroll
                for (int bj = 0; bj < 2; ++bj)
#pragma unroll
                    for (int n = 0; n < 2; ++n) { const f32x4 rs = *(const f32x4*)(R + off + bj * HALF + n * 16); *(f32x4*)(out + off + bj * HALF + n * 16) = rs + gv[bj][n] * acc[ai][bj][m][n]; } }
    }
};
struct EpiSwiglu {
    static constexpr bool PERM = true, AFTER_DRAIN = false;
    bf16_t* O; int ldc;
    __device__ __forceinline__ void operator()(const f32x4 (&acc)[2][2][4][2], const Unit& u, int wr, int wc, int fr, int fq) const {
        const int row0 = u.pm * BM + wr * 64 + fr, col0 = u.pn * HALF + wc * 32 + 8 * fq;
#pragma unroll
        for (int ai = 0; ai < 2; ++ai)
#pragma unroll
            for (int m = 0; m < 4; ++m) { f32x4 v[2];
#pragma unroll
                for (int n = 0; n < 2; ++n) { const f32x4 g = acc[ai][0][m][n], up = acc[ai][1][m][n];
#pragma unroll
                    for (int e = 0; e < 4; ++e) v[n][e] = silu_fast(g[e]) * up[e]; }
                u32x4 w; w.x = cvt_pk_bf16(v[0][0], v[0][1]); w.y = cvt_pk_bf16(v[0][2], v[0][3]); w.z = cvt_pk_bf16(v[1][0], v[1][1]); w.w = cvt_pk_bf16(v[1][2], v[1][3]);
                *(u32x4*)(O + (size_t)(row0 + ai * HALF + m * 16) * ldc + col0) = w; }
    }
};
struct EpiX1 {
    static constexpr bool PERM = true, AFTER_DRAIN = false;
    const float* R; bf16_t* X1; const float* gate; float* rowss; int ldc;
    __device__ __forceinline__ void operator()(const f32x4 (&acc)[2][2][4][2], const Unit& u, int wr, int wc, int fr, int fq) const {
        const int row0 = u.pm * BM + wr * 64 + fr, col0 = u.pn * BM + wc * 32 + 8 * fq;
        f32x4 gv[2][2];
#pragma unroll
        for (int bj = 0; bj < 2; ++bj)
#pragma unroll
            for (int n = 0; n < 2; ++n) gv[bj][n] = *(const f32x4*)(gate + col0 + bj * HALF + n * 4);
#pragma unroll
        for (int ai = 0; ai < 2; ++ai)
#pragma unroll
            for (int m = 0; m < 4; ++m) { const int r = row0 + ai * HALF + m * 16; const size_t off = (size_t)r * ldc + col0; float ss = 0.f;
#pragma unroll
                for (int bj = 0; bj < 2; ++bj) { const f32x4 v0 = *(const f32x4*)(R + off + bj * HALF) + gv[bj][0] * acc[ai][bj][m][0], v1 = *(const f32x4*)(R + off + bj * HALF + 4) + gv[bj][1] * acc[ai][bj][m][1];
                    ss += (v0[0] * v0[0] + v0[1] * v0[1]) + (v0[2] * v0[2] + v0[3] * v0[3]) + (v1[0] * v1[0] + v1[1] * v1[1]) + (v1[2] * v1[2] + v1[3] * v1[3]);
                    u32x4 w; w.x = cvt_pk_bf16(v0[0], v0[1]); w.y = cvt_pk_bf16(v0[2], v0[3]); w.z = cvt_pk_bf16(v1[0], v1[1]); w.w = cvt_pk_bf16(v1[2], v1[3]);
                    *(u32x4*)(X1 + off + bj * HALF) = w; }
                ss += __shfl_xor(ss, 16); ss += __shfl_xor(ss, 32);
                if (fq == 0) unsafeAtomicAdd(rowss + r, ss); }
    }
};
struct EpiSwiglu2 {
    static constexpr bool PERM = true, AFTER_DRAIN = false;
    bf16_t* O; int ldc; const float* rowss; const float* biasg; const float* biasu;
    __device__ __forceinline__ void operator()(const f32x4 (&acc)[2][2][4][2], const Unit& u, int wr, int wc, int fr, int fq) const {
        const int row0 = u.pm * BM + wr * 64 + fr, col0 = u.pn * HALF + wc * 32 + 8 * fq;
        f32x4 bg[2], bu[2];
#pragma unroll
        for (int n = 0; n < 2; ++n) { bg[n] = *(const f32x4*)(biasg + col0 + 4 * n); bu[n] = *(const f32x4*)(biasu + col0 + 4 * n); }
#pragma unroll
        for (int ai = 0; ai < 2; ++ai)
#pragma unroll
            for (int m = 0; m < 4; ++m) { const int r = row0 + ai * HALF + m * 16; const float rs = rsqrtf(rowss[r] * (1.f / 2048.f) + 1e-6f); f32x4 v[2];
#pragma unroll
                for (int n = 0; n < 2; ++n) { const f32x4 g = acc[ai][0][m][n] * rs + bg[n], up = acc[ai][1][m][n] * rs + bu[n];
#pragma unroll
                    for (int e = 0; e < 4; ++e) v[n][e] = silu_fast(g[e]) * up[e]; }
                u32x4 w; w.x = cvt_pk_bf16(v[0][0], v[0][1]); w.y = cvt_pk_bf16(v[0][2], v[0][3]); w.z = cvt_pk_bf16(v[1][0], v[1][1]); w.w = cvt_pk_bf16(v[1][2], v[1][3]);
                *(u32x4*)(O + (size_t)r * ldc + col0) = w; }
    }
};
struct EpiResidB {
    static constexpr bool PERM = false, AFTER_DRAIN = false;
    const bf16_t* X1; float* out; const float* gate; int ldc;
    __device__ __forceinline__ void operator()(const f32x4 (&acc)[2][2][4][2], const Unit& u, int wr, int wc, int fr, int fq) const {
        const int row0 = u.pm * BM + wr * 64 + fr, col0 = u.pn * BM + wc * 32 + 4 * fq;
        f32x4 gv[2][2];
#pragma unroll
        for (int bj = 0; bj < 2; ++bj)
#pragma unroll
            for (int n = 0; n < 2; ++n) gv[bj][n] = *(const f32x4*)(gate + col0 + bj * HALF + n * 16);
#pragma unroll
        for (int ai = 0; ai < 2; ++ai)
#pragma unroll
            for (int m = 0; m < 4; ++m) { const size_t off = (size_t)(row0 + ai * HALF + m * 16) * ldc + col0;
#pragma unroll
                for (int bj = 0; bj < 2; ++bj)
#pragma unroll
                    for (int n = 0; n < 2; ++n) { const unsigned long long xw = *(const unsigned long long*)(X1 + off + bj * HALF + n * 16); const unsigned x0 = (unsigned)xw, x1 = (unsigned)(xw >> 32);
                        const f32x4 rs = {__uint_as_float(x0 << 16), __uint_as_float(x0 & 0xffff0000u), __uint_as_float(x1 << 16), __uint_as_float(x1 & 0xffff0000u)};
                        *(f32x4*)(out + off + bj * HALF + n * 16) = rs + gv[bj][n] * acc[ai][bj][m][n]; } }
    }
};
}
#define GAS __attribute__((address_space(1)))
#define LAS __attribute__((address_space(3)))
typedef unsigned short bf16;
typedef unsigned v4u __attribute__((ext_vector_type(4)));
typedef float f32x4 __attribute__((ext_vector_type(4)));
typedef short bf16x8 __attribute__((ext_vector_type(8)));
typedef GAS unsigned gu32;
typedef GAS unsigned long long gu64;
#define RLX_AGENT __ATOMIC_RELAXED, __HIP_MEMORY_SCOPE_AGENT
#define LDS_WAIT() asm volatile("s_waitcnt lgkmcnt(0)" ::: "memory")
#define VM_WAIT() asm volatile("s_waitcnt vmcnt(0)" ::: "memory")
__device__ __forceinline__ unsigned long long rt() { return __builtin_amdgcn_s_memrealtime(); }
__device__ __forceinline__ unsigned f2bf(float f) { unsigned u = __builtin_bit_cast(unsigned, f); return (u + 0x7fffu + ((u >> 16) & 1u)) >> 16; }
__device__ __forceinline__ unsigned pk2(float lo, float hi) { return f2bf(lo) | (f2bf(hi) << 16); }
#define XB_TMO      128
#define XB_XCNT(j)  (256  + 64 * (j))
#define XB_XSUB(j)  (1280 + 64 * (j))
#define XB_XGEN(j)  (2304 + 64 * (j))
#define XB_TOP      3328
#define XB_TOPGEN   3392
#define XCD_BAR_WORDS 3456
#define XB_SPIN_CAP (1u << 18)

__device__ __forceinline__ unsigned xb_ld(unsigned* p)              { return __hip_atomic_load(p, __ATOMIC_RELAXED, __HIP_MEMORY_SCOPE_AGENT); }
__device__ __forceinline__ unsigned xb_add(unsigned* p, unsigned v) { return __hip_atomic_fetch_add(p, v, __ATOMIC_RELAXED, __HIP_MEMORY_SCOPE_AGENT); }
__device__ __forceinline__ unsigned xb_xcc_id() { return (unsigned)__builtin_amdgcn_s_getreg((3 << 11) | 20) & 0xFu; }
#define XB_SPIN(cond, bar) do { unsigned _sp = 0; while (cond) { __builtin_amdgcn_s_sleep(1); \
    if ((++_sp & 255u) == 0u) { if (xb_ld(&(bar)[XB_TMO])) break; if (_sp > XB_SPIN_CAP) { atomicAdd(&(bar)[XB_TMO], 1u); break; } } } } while (0)

struct XcdBarrier {
    unsigned* bar; unsigned x;
    volatile LAS unsigned* st;
};

__device__ __forceinline__ XcdBarrier xcd_barrier_post(unsigned* bar, volatile LAS unsigned* st) {
    XcdBarrier b; b.bar = bar; b.x = xb_xcc_id(); b.st = st;
    if (threadIdx.x == 0) (void)xb_add(&bar[XB_XCNT(b.x)], 1u);
    return b;
}
__device__ __forceinline__ void xcd_barrier_complete(unsigned* bar, unsigned x, unsigned& nloc, unsigned& nx) {
    const unsigned G = gridDim.x * gridDim.y * gridDim.z;
    unsigned sum, cnt, mine, sp = 0u;
    for (;;) {
        sum = 0u; cnt = 0u; mine = 0u;
#pragma unroll
        for (unsigned j = 0; j < 16; ++j) { const unsigned c = xb_ld(&bar[XB_XCNT(j)]); sum += c; cnt += (c > 0u) ? 1u : 0u; mine = (j == x) ? c : mine; }
        if (sum == G) break;
        __builtin_amdgcn_s_sleep(1);
        if ((++sp & 255u) == 0u) { if (xb_ld(&bar[XB_TMO])) break; if (sp > XB_SPIN_CAP) { atomicAdd(&bar[XB_TMO], 1u); break; } }
    }
    nloc = mine > 0u ? mine : 1u; nx = cnt > 0u ? cnt : 1u;
}

__device__ __forceinline__ void xcd_barrier(const XcdBarrier& b) {
    asm volatile("s_waitcnt vmcnt(0)" ::: "memory");
    __syncthreads();
    if (threadIdx.x == 0) {
        unsigned* bar = b.bar;
        __builtin_amdgcn_s_waitcnt(0);
        unsigned nloc = b.st[0], nx = b.st[1];
        if (nloc == 0u) { xcd_barrier_complete(bar, b.x, nloc, nx); b.st[0] = nloc; b.st[1] = nx; }
        const unsigned old = xb_add(&bar[XB_XSUB(b.x)], 1u);
        const unsigned gen = old / nloc;
        if (old + 1u == (gen + 1u) * nloc) {
            __builtin_amdgcn_fence(__ATOMIC_RELEASE, "agent");
            asm volatile("s_waitcnt vmcnt(0)" ::: "memory");
            const unsigned og = xb_add(&bar[XB_TOP], 1u);
            const unsigned tg = og / nx;
            if (og + 1u == (tg + 1u) * nx) xb_add(&bar[XB_TOPGEN], 1u);
            else XB_SPIN(xb_ld(&bar[XB_TOPGEN]) == tg, bar);
            __builtin_amdgcn_fence(__ATOMIC_ACQUIRE, "agent");
            xb_add(&bar[XB_XGEN(b.x)], 1u);
            asm volatile("s_waitcnt vmcnt(0)" ::: "memory");
        } else {
            XB_SPIN(xb_ld(&bar[XB_XGEN(b.x)]) == gen, bar);
            __builtin_amdgcn_fence(__ATOMIC_ACQUIRE, "agent");
            asm volatile("s_waitcnt vmcnt(0)" ::: "memory");
        }
    }
    __syncthreads();
}
constexpr int NWAVES = 8;
constexpr int RING_OFF = 0, RING_BYTES = 131072;
constexpr int LDSCTL_OFF = RING_BYTES, MISC_OFF = LDSCTL_OFF + 320;
constexpr int LDS_BYTES = 147456;
constexpr size_t WS_MODACC = 512 * 1024;
constexpr size_t WS_ROWSS = 640 * 1024;
constexpr size_t WS_BIAS = 704 * 1024;
constexpr size_t WS_X1B = 100 * MiB;
constexpr size_t WS_RT = 2 * MiB;
constexpr size_t WS_AXT = 4 * MiB;
constexpr size_t WS_WIN = 8 * MiB, WS_WOUT = 26 * MiB, WS_WGU = 34 * MiB, WS_WDN = 78 * MiB;
constexpr size_t WS_KVT = 241 * MiB;
constexpr size_t WS_SPT = 274 * MiB;
constexpr int CW_TMO = 0, CW_CODE = 1, CW_BAR = 4096;

typedef short s16x4 __attribute__((ext_vector_type(4)));
typedef short v4i16_t __attribute__((ext_vector_type(4)));
__device__ __forceinline__ s16x4 vtr(const LAS unsigned char* p) { return __builtin_bit_cast(s16x4, __builtin_amdgcn_ds_read_tr16_b64_v4i16((LAS v4i16_t*)p)); }
__device__ __forceinline__ bf16x8 cat8(s16x4 lo, s16x4 hi) { return (bf16x8){lo[0], lo[1], lo[2], lo[3], hi[0], hi[1], hi[2], hi[3]}; }
struct Frame {
    LAS unsigned char* lds; volatile LAS unsigned* MISC; gu32* ctl;
    int tid, lane, wave, vcu, G;
};
__device__ __forceinline__ float wave_sum(float v) {
#pragma unroll
    for (int o = 1; o < 64; o <<= 1) v += __shfl_xor(v, o);
    return v;
}
__device__ __forceinline__ int sigma_in(int p) {
    const int pn = p >> 8, q = p & 255, bj = q >> 7, wc = (q >> 5) & 3, off = q & 31;
    if (pn < 4) return pn * 256 + wc * 64 + bj * 32 + off;
    if (pn >= 12 && pn < 17) return pn * 256 + wc * 64 + (off >> 4) * 32 + bj * 16 + (off & 15);
    return p;
}
__device__ __forceinline__ void tr64_item(const float* W, int K, int N, bf16* WT, int p0, int k0, int srccol4, LAS unsigned char* scr, int lane) {
    const int fr = lane & 15, fq = lane >> 4;
    f32x4 t[16];
#pragma unroll
    for (int i = 0; i < 16; ++i) t[i] = *(const GAS f32x4*)(W + (size_t)(k0 + 4 * i + fq) * N + srccol4);
#pragma unroll
    for (int i = 0; i < 16; ++i) *(LAS unsigned long long*)(scr + (4 * i + fq) * 160 + fr * 8) = (unsigned long long)pg8::cvt_pk_bf16(t[i].x, t[i].y) | ((unsigned long long)pg8::cvt_pk_bf16(t[i].z, t[i].w) << 32);
    LDS_WAIT(); asm volatile("" ::: "memory");
#pragma unroll
    for (int ng = 0; ng < 4; ++ng)
#pragma unroll
        for (int kh = 0; kh < 2; ++kh) { const LAS unsigned char* p = scr + (32 * kh + 8 * fq + (fr >> 2)) * 160 + 32 * ng + 8 * (fr & 3);
            const bf16x8 o = cat8(vtr(p), vtr(p + 4 * 160));
            *(GAS bf16x8*)(WT + (size_t)(p0 + 16 * ng + fr) * K + k0 + 32 * kh + 8 * fq) = o; }
    LDS_WAIT(); asm volatile("" ::: "memory");
}
__device__ __forceinline__ void tr64_item_ps(const float* W, int K, int N, bf16* WT, int p0, int k0, int srccol4, const float* nrm, const float* scv, const float* shv, float* bias, LAS unsigned char* scr, int lane) {
    const int fr = lane & 15, fq = lane >> 4;
    f32x4 t[16];
#pragma unroll
    for (int i = 0; i < 16; ++i) t[i] = *(const GAS f32x4*)(W + (size_t)(k0 + 4 * i + fq) * N + srccol4);
    f32x4 bsum = {0.f, 0.f, 0.f, 0.f};
#pragma unroll
    for (int i = 0; i < 16; ++i) { const int k = k0 + 4 * i + fq; const float sk = nrm[k] * (1.f + scv[k]), sh = shv[k]; bsum += t[i] * sh; const f32x4 ts = t[i] * sk;
        *(LAS unsigned long long*)(scr + (4 * i + fq) * 160 + fr * 8) = (unsigned long long)pg8::cvt_pk_bf16(ts.x, ts.y) | ((unsigned long long)pg8::cvt_pk_bf16(ts.z, ts.w) << 32); }
#pragma unroll
    for (int e = 0; e < 4; ++e) { bsum[e] += __shfl_xor(bsum[e], 16); bsum[e] += __shfl_xor(bsum[e], 32); }
    if (fq == 0) {
#pragma unroll
        for (int e = 0; e < 4; ++e) unsafeAtomicAdd(bias + srccol4 + e, bsum[e]); }
    LDS_WAIT(); asm volatile("" ::: "memory");
#pragma unroll
    for (int ng = 0; ng < 4; ++ng)
#pragma unroll
        for (int kh = 0; kh < 2; ++kh) { const LAS unsigned char* p = scr + (32 * kh + 8 * fq + (fr >> 2)) * 160 + 32 * ng + 8 * (fr & 3);
            const bf16x8 o = cat8(vtr(p), vtr(p + 4 * 160));
            *(GAS bf16x8*)(WT + (size_t)(p0 + 16 * ng + fr) * K + k0 + 32 * kh + 8 * fq) = o; }
    LDS_WAIT(); asm volatile("" ::: "memory");
}
struct Args { const float* in[16]; float* out; unsigned char* ws; int ph_lo, ph_hi, li, pad; };

__device__ __forceinline__ void p0_prologue(Frame& F, const Args& a, bool do_atomics) {
    LAS unsigned char* scr = F.lds + RING_OFF + F.wave * 16384;
    const int gw = F.vcu * NWAVES + F.wave, NGW = F.G * NWAVES, lane = F.lane;
    const float* w_mod = a.in[4]; const float* w_in = a.in[8];
    float* modacc = (float*)(a.ws + WS_MODACC);
    constexpr int I_GEMV = 48 * 32, I_RT = 128, I_AX = 1, I_IN = 72 * 32;
    constexpr int NITEMS = I_GEMV + I_RT + I_AX + I_IN;
    for (int it = gw; it < NITEMS; it += NGW) {
        int r = it;
        if (r < I_GEMV) {
            const int strip = r % 48, ks = r / 48; const int n = strip * 256 + 4 * lane;
            f32x4 a0 = {0.f, 0.f, 0.f, 0.f}, a1 = {0.f, 0.f, 0.f, 0.f};
            const float cv = a.in[1][ks * 64 + lane], cc = a.in[3][ks * 64 + lane];
            const float s0 = cv / (1.f + __expf(-cv)), s1 = cc / (1.f + __expf(-cc));
#pragma unroll 16
            for (int k = 0; k < 64; ++k) { const f32x4 w = *(const GAS f32x4*)(w_mod + (size_t)(ks * 64 + k) * (6 * D) + n);
                const float t0 = __shfl(s0, k), t1 = __shfl(s1, k); a0 += w * t0; a1 += w * t1; }
            if (ks == 0) { const f32x4 b = *(const f32x4*)(a.in[5] + n); a0 += b; a1 += b; }
#pragma unroll
            for (int e = 0; e < 4; ++e) { if (do_atomics) { unsafeAtomicAdd(modacc + n + e, a0[e]); unsafeAtomicAdd(modacc + 6 * D + n + e, a1[e]); } else asm volatile("" :: "v"(a0[e]), "v"(a1[e])); }
            continue; }
        r -= I_GEMV;
        if (r < I_RT) {
            const int t = r * 64 + lane; float* rc = (float*)(a.ws + WS_RT); float* rs = (float*)(a.ws + WS_RT + MiB);
            for (int j = 0; j < 32; ++j) { const float inv = powf(10000.f, -(float)j / 32.f), ang = (float)t * inv; float sn, cs; sincosf(ang, &sn, &cs); rc[t * 32 + j] = cs; rs[t * 32 + j] = sn; }
            continue; }
        r -= I_RT;
        if (r < I_AX) {
            float* ac = (float*)(a.ws + WS_AXT); float* as = (float*)(a.ws + WS_AXT + 8192);
            for (int i = lane; i < 128 * 16; i += 64) { const int pos = i >> 4, j = i & 15; const float inv = powf(10000.f, -(float)j / 16.f), ang = (float)pos * inv; float sn, cs; sincosf(ang, &sn, &cs); ac[i] = cs; as[i] = sn; }
            continue; }
        r -= I_AX;
        { const int grp = r % 72, kb = r / 72; tr64_item(w_in, D, NPROJ, (bf16*)(a.ws + WS_WIN), grp * 64, kb * 64, sigma_in(grp * 64 + 4 * (lane & 15)), scr, lane); }
    }
}
__device__ __forceinline__ void p0_deferred(Frame& F, const Args& a, int which, int gwf, int ngwf) {
    LAS unsigned char* scr = F.lds + RING_OFF + F.wave * 16384; const int lane = F.lane;
    const float* w_out = a.in[11]; const float* w_gate = a.in[12]; const float* w_up = a.in[13]; const float* w_down = a.in[14];
    constexpr int I_OUT = 32 * 32, I_GU = 176 * 32, I_DN = 32 * 88;
    if (which == 0) {
        for (int it = gwf; it < I_GU + I_OUT; it += ngwf) {
            int r = it;
            if (r < I_GU) { const int grp = r % 176, kb = r / 176; const int pn = grp >> 2, gg = grp & 3;
                const float* modp = (const float*)(a.ws + WS_MODACC);
                tr64_item_ps((gg >> 1) ? w_up : w_gate, D, DFF, (bf16*)(a.ws + WS_WGU), grp * 64, kb * 64, pn * 128 + (gg & 1) * 64 + 4 * (lane & 15), a.in[7], modp + 4 * D, modp + 3 * D,
                             (float*)(a.ws + WS_BIAS) + ((gg >> 1) ? DFF : 0), scr, lane); continue; }
            r -= I_GU;
            { const int grp = r % 32, kb = r / 32; tr64_item(w_out, D, D, (bf16*)(a.ws + WS_WOUT), grp * 64, kb * 64, grp * 64 + 4 * (lane & 15), scr, lane); }
        }
    } else {
        for (int it = gwf; it < I_DN; it += ngwf) { const int grp = it % 32, kb = it / 32; tr64_item(w_down, DFF, D, (bf16*)(a.ws + WS_WDN), grp * 64, kb * 64, grp * 64 + 4 * (lane & 15), scr, lane); }
    }
}
__device__ __forceinline__ void modulate_row(const float* xrow, const float* g, const float* shift, const float* scale, bf16* orow, int lane) {
    const GAS f32x4* xr = (const GAS f32x4*)xrow + lane;
    f32x4 v[8]; float s = 0.f;
#pragma unroll
    for (int j = 0; j < 8; ++j) { v[j] = xr[64 * j]; s += (v[j].x * v[j].x + v[j].y * v[j].y) + (v[j].z * v[j].z + v[j].w * v[j].w); }
    const float r = rsqrtf(wave_sum(s) * (1.f / D) + EPS);
    GAS unsigned long long* o8 = (GAS unsigned long long*)orow + lane;
#pragma unroll
    for (int j = 0; j < 8; ++j) { const int c = 4 * lane + 256 * j; const f32x4 gg = *(const f32x4*)(g + c), sh = *(const f32x4*)(shift + c), sc = *(const f32x4*)(scale + c);
        const f32x4 y = v[j] * r * gg * (sc + 1.f) + sh;
        o8[64 * j] = (unsigned long long)pk2(y.x, y.y) | ((unsigned long long)pk2(y.z, y.w) << 32); }
}
__device__ __forceinline__ void modulate_row2(const float* x1, const float* x2, const float* g, const float* sh1, const float* sc1, const float* sh2, const float* sc2, bf16* o1, bf16* o2, int lane) {
    const GAS f32x4* xr1 = (const GAS f32x4*)x1 + lane; const GAS f32x4* xr2 = (const GAS f32x4*)x2 + lane;
    f32x4 v[8], u[8]; float s = 0.f, t = 0.f;
#pragma unroll
    for (int j = 0; j < 8; ++j) { v[j] = xr1[64 * j]; u[j] = xr2[64 * j]; }
#pragma unroll
    for (int j = 0; j < 8; ++j) { s += (v[j].x * v[j].x + v[j].y * v[j].y) + (v[j].z * v[j].z + v[j].w * v[j].w); t += (u[j].x * u[j].x + u[j].y * u[j].y) + (u[j].z * u[j].z + u[j].w * u[j].w); }
    const float r1 = rsqrtf(wave_sum(s) * (1.f / D) + EPS), r2 = rsqrtf(wave_sum(t) * (1.f / D) + EPS);
    GAS unsigned long long* p1 = (GAS unsigned long long*)o1 + lane; GAS unsigned long long* p2 = (GAS unsigned long long*)o2 + lane;
#pragma unroll
    for (int j = 0; j < 8; ++j) { const int c = 4 * lane + 256 * j; const f32x4 gg = *(const f32x4*)(g + c);
        const f32x4 y = v[j] * r1 * gg * (*(const f32x4*)(sc1 + c) + 1.f) + *(const f32x4*)(sh1 + c);
        const f32x4 z = u[j] * r2 * gg * (*(const f32x4*)(sc2 + c) + 1.f) + *(const f32x4*)(sh2 + c);
        p1[64 * j] = (unsigned long long)pk2(y.x, y.y) | ((unsigned long long)pk2(y.z, y.w) << 32);
        p2[64 * j] = (unsigned long long)pk2(z.x, z.y) | ((unsigned long long)pk2(z.z, z.w) << 32); }
}
__device__ __forceinline__ void final_norm_row(const float* xrow, float* orow, const float* g, int lane) {
    const GAS f32x4* xr = (const GAS f32x4*)xrow + lane; GAS f32x4* xo = (GAS f32x4*)orow + lane;
    f32x4 v[8]; float s = 0.f;
#pragma unroll
    for (int j = 0; j < 8; ++j) { v[j] = xr[64 * j]; s += (v[j].x * v[j].x + v[j].y * v[j].y) + (v[j].z * v[j].z + v[j].w * v[j].w); }
    const float r = rsqrtf(wave_sum(s) * (1.f / D) + EPS);
#pragma unroll
    for (int j = 0; j < 8; ++j) { const f32x4 gg = *(const f32x4*)(g + 4 * lane + 256 * j); xo[64 * j] = v[j] * r * gg; }
}

__device__ __forceinline__ f32x4 mfma16(bf16x8 a, bf16x8 b, f32x4 c) { return __builtin_amdgcn_mfma_f32_16x16x32_bf16(a, b, c, 0, 0, 0); }
__device__ __forceinline__ float ex2(float x) { return __builtin_amdgcn_exp2f(x); }
__device__ __forceinline__ unsigned pk2f(float lo, float hi) { return pg8::cvt_pk_bf16(lo, hi); }
constexpr int RSV = 288;
constexpr int RSK = 160;
__device__ __forceinline__ bf16x8 tr_frag(const LAS unsigned char* tile, int rs, int r0, int cb, int fr, int fq) {
    const LAS unsigned char* p = tile + (r0 + 4 * fq + (fr >> 2)) * rs + cb + 8 * (fr & 3);
    return cat8(vtr(p), vtr(p + 16 * rs));
}

__device__ __forceinline__ void ret_kv_item(Frame& F, const bf16* PROJ, float* KVT, int cc, int h, float lf2, float lb2) {
    const int lane = F.lane, fr = lane & 15, fq = lane >> 4, w = F.wave, tid = F.tid;
    const int row0 = cc < 2 ? L + 128 * cc : 128 * (cc - 2);
    LAS unsigned char* Vl = F.lds; LAS unsigned char* Kf = F.lds + 128 * RSV; LAS unsigned char* Kb = Kf + 128 * RSK;
    __syncthreads();
#pragma unroll
    for (int p = 0; p < 4; ++p) { const int idx = p * 512 + tid, row = idx >> 4, ch = idx & 15;
        const v4u v = *(const GAS v4u*)(PROJ + (size_t)(row0 + row) * NPROJ + C_RV + h * 128 + ch * 8); *(LAS v4u*)(Vl + row * RSV + ch * 16) = v; }
#pragma unroll
    for (int p = 0; p < 2; ++p) { const int idx = p * 512 + tid, row = idx >> 3, ch = idx & 7;
        const v4u v = *(const GAS v4u*)(PROJ + (size_t)(row0 + row) * NPROJ + C_RK + h * 64 + ch * 8);
        const float wf = ex2(lf2 * (float)(127 - row)), wb = ex2(lb2 * (float)row);
        v4u of, ob;
#pragma unroll
        for (int e = 0; e < 4; ++e) { const float lo = __uint_as_float(v[e] << 16), hi = __uint_as_float(v[e] & 0xffff0000u); of[e] = pk2f(lo * wf, hi * wf); ob[e] = pk2f(lo * wb, hi * wb); }
        *(LAS v4u*)(Kf + row * RSK + ch * 16) = of; *(LAS v4u*)(Kb + row * RSK + ch * 16) = ob; }
    __syncthreads();
    bf16x8 aV[4];
#pragma unroll
    for (int st = 0; st < 4; ++st) aV[st] = tr_frag(Vl, RSV, 32 * st, 32 * w, fr, fq);
#pragma unroll
    for (int dir = 0; dir < 2; ++dir) { const LAS unsigned char* Kx = dir ? Kb : Kf;
        float* outp = KVT + (((size_t)dir * 66 + cc) * 8 + h) * 8192 + (16 * w + 4 * fq) * 64 + fr;
#pragma unroll
        for (int dt = 0; dt < 4; ++dt) { f32x4 acc = {0.f, 0.f, 0.f, 0.f};
#pragma unroll
            for (int st = 0; st < 4; ++st) acc = mfma16(aV[st], tr_frag(Kx, RSK, 32 * st, 32 * dt, fr, fq), acc);
#pragma unroll
            for (int r = 0; r < 4; ++r) outp[r * 64 + 16 * dt] = acc[r]; } }
}
__device__ __forceinline__ void ret_scan_phase(Frame& F, const float* KVT, bf16* SPT, const float* ret_decay) {
    const int nthr = F.G * 512;
    for (int e = F.vcu * 512 + F.tid; e < 2 * 8 * 8192; e += nthr) {
        const int dir = e >> 16, h = (e >> 13) & 7, vd = e & 8191;
        const float g = __expf(-128.f * __expf(ret_decay[dir * 8 + h]));
        const float* kv = KVT + ((size_t)dir * 66 * 8 + h) * 8192 + vd;
        bf16* sp = SPT + ((size_t)dir * 64 * 8 + h) * 8192 + vd;
        float S = 0.f;
        if (dir == 0) { S = kv[0]; S = g * S + kv[65536];
#pragma unroll 8
            for (int c = 0; c < 64; ++c) { sp[(size_t)c * 65536] = (bf16)f2bf(S); S = g * S + kv[(size_t)(2 + c) * 65536]; } }
        else { S = kv[65536]; S = g * S + kv[0];
#pragma unroll 8
            for (int c = 63; c >= 0; --c) { sp[(size_t)c * 65536] = (bf16)f2bf(S); S = g * S + kv[(size_t)(2 + c) * 65536]; } }
    }
}
constexpr int RSA = 144;
constexpr int RO_V = 0, RO_K = 128 * RSV, RO_SF = RO_K + 128 * RSA, RO_SB = RO_SF + 128 * RSA;
__device__ __forceinline__ void ret_out_item(Frame& F, const bf16* PROJ, const bf16* SPT, bf16* Y, int c, int h, float lf2, float lb2) {
    const int lane = F.lane, fr = lane & 15, fq = lane >> 4, w = F.wave, tid = F.tid;
    const int t0 = c * 128;
    LAS unsigned char* Vl = F.lds + RO_V; LAS unsigned char* Kl = F.lds + RO_K; LAS unsigned char* Sfl = F.lds + RO_SF; LAS unsigned char* Sbl = F.lds + RO_SB;
    const int il = 16 * w + fr;
    v4u gv[4], gk[2], gf[2], gb[2];
    const bf16* Sf = SPT + ((size_t)(0 * 64 + c) * 8 + h) * 8192; const bf16* Sb = SPT + ((size_t)(1 * 64 + c) * 8 + h) * 8192;
#pragma unroll
    for (int p = 0; p < 4; ++p) { const int idx = p * 512 + tid; gv[p] = *(const GAS v4u*)(PROJ + (size_t)(t0 + (idx >> 4)) * NPROJ + C_RV + h * 128 + (idx & 15) * 8); }
#pragma unroll
    for (int p = 0; p < 2; ++p) { const int idx = p * 512 + tid; gk[p] = *(const GAS v4u*)(PROJ + (size_t)(t0 + (idx >> 3)) * NPROJ + C_RK + h * 64 + (idx & 7) * 8);
        gf[p] = *(const GAS v4u*)(Sf + idx * 8); gb[p] = *(const GAS v4u*)(Sb + idx * 8); }
    const bf16* qrow = PROJ + (size_t)(t0 + il) * NPROJ + C_RQ + h * 64 + 8 * fq;
    bf16x8 qB[2]; qB[0] = *(const GAS bf16x8*)(qrow); qB[1] = *(const GAS bf16x8*)(qrow + 32);
    __syncthreads();
#pragma unroll
    for (int p = 0; p < 4; ++p) { const int idx = p * 512 + tid; *(LAS v4u*)(Vl + (idx >> 4) * RSV + (idx & 15) * 16) = gv[p]; }
#pragma unroll
    for (int p = 0; p < 2; ++p) { const int idx = p * 512 + tid; const int o = (idx >> 3) * RSA + (idx & 7) * 16; *(LAS v4u*)(Kl + o) = gk[p]; *(LAS v4u*)(Sfl + o) = gf[p]; *(LAS v4u*)(Sbl + o) = gb[p]; }
    const float wf = ex2(lf2 * (float)(il + 1)), wb = ex2(lb2 * (float)(128 - il));
    __syncthreads();
    const bf16* grow = PROJ + (size_t)(t0 + il) * NPROJ + C_RG + h * 128 + 4 * fq;
    unsigned long long gate[8];
#pragma unroll
    for (int vt = 0; vt < 8; ++vt) gate[vt] = *(const GAS unsigned long long*)(grow + 16 * vt);
    const int fo = fr * RSA + 16 * fq;
    f32x4 O[8];
#pragma unroll
    for (int vt = 0; vt < 8; ++vt) { f32x4 xf = {0.f, 0.f, 0.f, 0.f}, xb = {0.f, 0.f, 0.f, 0.f};
#pragma unroll
        for (int s = 0; s < 2; ++s) { xf = mfma16(*(const LAS bf16x8*)(Sfl + vt * 16 * RSA + fo + 64 * s), qB[s], xf); xb = mfma16(*(const LAS bf16x8*)(Sbl + vt * 16 * RSA + fo + 64 * s), qB[s], xb); }
        O[vt] = xf * wf + xb * wb; }
    unsigned pt[8][2];
#pragma unroll
    for (int T = 0; T < 8; ++T) { f32x4 st = {0.f, 0.f, 0.f, 0.f};
#pragma unroll
        for (int s = 0; s < 2; ++s) st = mfma16(*(const LAS bf16x8*)(Kl + T * 16 * RSA + fo + 64 * s), qB[s], st);
#pragma unroll
        for (int r = 0; r < 4; ++r) { const int diff = il - (16 * T + 4 * fq + r); st[r] *= diff >= 0 ? ex2(lf2 * (float)diff) : ex2(lb2 * (float)(-diff)); }
        pt[T][0] = pk2f(st[0], st[1]); pt[T][1] = pk2f(st[2], st[3]); }
#pragma unroll
    for (int st = 0; st < 4; ++st) { const v4u pw = {pt[2 * st][0], pt[2 * st][1], pt[2 * st + 1][0], pt[2 * st + 1][1]}; const bf16x8 pb = __builtin_bit_cast(bf16x8, pw);
#pragma unroll
        for (int vt = 0; vt < 8; ++vt) O[vt] = mfma16(tr_frag(Vl, RSV, 32 * st, 32 * vt, fr, fq), pb, O[vt]); }
    float ss = 0.f;
#pragma unroll
    for (int vt = 0; vt < 8; ++vt) ss += (O[vt][0] * O[vt][0] + O[vt][1] * O[vt][1]) + (O[vt][2] * O[vt][2] + O[vt][3] * O[vt][3]);
    ss += __shfl_xor(ss, 16); ss += __shfl_xor(ss, 32);
    const float r = rsqrtf(ss * (1.f / 128.f) + EPS);
    bf16* yrow = Y + (size_t)(t0 + il) * D + h * 128 + 4 * fq;
#pragma unroll
    for (int vt = 0; vt < 8; ++vt) { const unsigned g0 = (unsigned)gate[vt], g1 = (unsigned)(gate[vt] >> 32);
        const float y0 = O[vt][0] * r * __uint_as_float(g0 << 16), y1 = O[vt][1] * r * __uint_as_float(g0 & 0xffff0000u), y2 = O[vt][2] * r * __uint_as_float(g1 << 16), y3 = O[vt][3] * r * __uint_as_float(g1 & 0xffff0000u);
        *(GAS unsigned long long*)(yrow + 16 * vt) = (unsigned long long)pk2f(y0, y1) | ((unsigned long long)pk2f(y2, y3) << 32); }
}
constexpr int ATT_ROWS = 640;
__device__ __forceinline__ void attn_item(Frame& F, const bf16* PROJ, const float* sink, bf16* Y, int b, int kvh) {
    const int lane = F.lane, fr = lane & 15, fq = lane >> 4, w = F.wave, tid = F.tid;
    LAS unsigned char* Vl = F.lds;
    __syncthreads();
#pragma unroll
    for (int p = 0; p < 10; ++p) { const int idx = p * 512 + tid, row = idx >> 3, ch = idx & 7;
        int src; bool ok = true;
        if (row < 384) { const int key = 128 * b - 128 + row; ok = key >= 0 && key < L; src = ok ? key : 0; } else src = L + (row - 384);
        v4u v = *(const GAS v4u*)(PROJ + (size_t)src * NPROJ + C_AV + kvh * 64 + ch * 8);
        if (!ok) v = (v4u){0u, 0u, 0u, 0u};
        *(LAS v4u*)(Vl + row * RSK + ch * 16) = v; }
    const int iq = 128 * b + 16 * w + fr;
    bf16x8 qB[4][2]; float m[4], l[4]; f32x4 O[4][4];
#pragma unroll
    for (int g = 0; g < 4; ++g) { const bf16* qrow = PROJ + (size_t)iq * NPROJ + C_AQ + (4 * kvh + g) * 64 + 8 * fq;
        qB[g][0] = *(const GAS bf16x8*)(qrow); qB[g][1] = *(const GAS bf16x8*)(qrow + 32);
        m[g] = sink[4 * kvh + g] * LOG2E; l[g] = fq == 0 ? 1.f : 0.f;
#pragma unroll
        for (int dt = 0; dt < 4; ++dt) O[g][dt] = (f32x4){0.f, 0.f, 0.f, 0.f}; }
    __syncthreads();
    const bf16* kbase = PROJ + C_AK + kvh * 64 + 8 * fq;
#define ATT_KLOAD(dst, stp) do { const bool il_ = (stp) < 9; const int lr_ = il_ ? 32 * ((w >> 1) + (stp)) : 384 + 32 * ((stp) - 9); \
        _Pragma("unroll") for (int tt = 0; tt < 2; ++tt) { int kr; \
            if (il_) { kr = 128 * b - 128 + lr_ + 16 * tt + fr; kr = kr < 0 ? 0 : (kr > L - 1 ? L - 1 : kr); } else kr = L + (lr_ - 384) + 16 * tt + fr; \
            const bf16* kp = kbase + (size_t)kr * NPROJ; dst[tt][0] = *(const GAS bf16x8*)(kp); dst[tt][1] = *(const GAS bf16x8*)(kp + 32); } } while (0)
    bf16x8 kA[2][2], kN[2][2];
    ATT_KLOAD(kA, 0);
    for (int step = 0; step < 17; ++step) {
        const bool isloc = step < 9;
        const int ldsrow0 = isloc ? 32 * ((w >> 1) + step) : 384 + 32 * (step - 9);
        const int key0 = 128 * b - 128 + ldsrow0;
        { const int nstep = step < 16 ? step + 1 : 16; ATT_KLOAD(kN, nstep); }
        bf16x8 vA[4];
#pragma unroll
        for (int dt = 0; dt < 4; ++dt) vA[dt] = tr_frag(Vl, RSK, ldsrow0, 32 * dt, fr, fq);
#pragma unroll
        for (int g = 0; g < 4; ++g) {
            f32x4 s0 = {0.f, 0.f, 0.f, 0.f}, s1 = {0.f, 0.f, 0.f, 0.f};
            s0 = mfma16(kA[0][0], qB[g][0], s0); s0 = mfma16(kA[0][1], qB[g][1], s0);
            s1 = mfma16(kA[1][0], qB[g][0], s1); s1 = mfma16(kA[1][1], qB[g][1], s1);
            if (isloc) {
#pragma unroll
                for (int r = 0; r < 4; ++r) { const int k0 = key0 + 4 * fq + r, k1 = k0 + 16; const int d0 = iq - k0, d1 = iq - k1;
                    if (!(k0 >= 0 && k0 < L && d0 <= WIN && d0 >= -WIN)) s0[r] = -INFINITY;
                    if (!(k1 >= 0 && k1 < L && d1 <= WIN && d1 >= -WIN)) s1[r] = -INFINITY; } }
            float mx = fmaxf(fmaxf(fmaxf(s0[0], s0[1]), fmaxf(s0[2], s0[3])), fmaxf(fmaxf(s1[0], s1[1]), fmaxf(s1[2], s1[3])));
            mx = fmaxf(mx, __shfl_xor(mx, 16)); mx = fmaxf(mx, __shfl_xor(mx, 32));
            const float mn = fmaxf(m[g], mx), alpha = ex2(m[g] - mn); m[g] = mn;
            float ps = 0.f;
#pragma unroll
            for (int r = 0; r < 4; ++r) { s0[r] = ex2(s0[r] - mn); s1[r] = ex2(s1[r] - mn); ps += s0[r] + s1[r]; }
            l[g] = l[g] * alpha + ps;
            const v4u pw = {pk2f(s0[0], s0[1]), pk2f(s0[2], s0[3]), pk2f(s1[0], s1[1]), pk2f(s1[2], s1[3])}; const bf16x8 pb = __builtin_bit_cast(bf16x8, pw);
#pragma unroll
            for (int dt = 0; dt < 4; ++dt) { O[g][dt] *= alpha; O[g][dt] = mfma16(vA[dt], pb, O[g][dt]); }
        }
#pragma unroll
        for (int tt = 0; tt < 2; ++tt) { kA[tt][0] = kN[tt][0]; kA[tt][1] = kN[tt][1]; }
    }
#undef ATT_KLOAD
#pragma unroll
    for (int g = 0; g < 4; ++g) { float lt = l[g]; lt += __shfl_xor(lt, 16); lt += __shfl_xor(lt, 32); const float inv = 1.f / lt;
        bf16* yrow = Y + (size_t)iq * D + 1024 + (4 * kvh + g) * 64 + 4 * fq;
#pragma unroll
        for (int dt = 0; dt < 4; ++dt) *(GAS unsigned long long*)(yrow + 16 * dt) = (unsigned long long)pk2f(O[g][dt][0] * inv, O[g][dt][1] * inv) | ((unsigned long long)pk2f(O[g][dt][2] * inv, O[g][dt][3] * inv) << 32); }
}
__global__ void __launch_bounds__(NWAVES * 64, 2) mk_fwd(Args args) {
    extern __shared__ __attribute__((aligned(16))) unsigned char lds[];
    Frame F;
    F.lds = (LAS unsigned char*)lds;
    F.MISC = (volatile LAS unsigned*)(F.lds + MISC_OFF);
    F.tid = threadIdx.x; F.lane = F.tid & 63; F.wave = __builtin_amdgcn_readfirstlane(F.tid >> 6);
    F.G = gridDim.x; { const int bx = blockIdx.x; F.vcu = (F.G % 8 == 0) ? (bx % 8) * (F.G / 8) + bx / 8 : bx; }
    unsigned char* ws = args.ws;
    F.ctl = (gu32*)(ws + WS_CTL);
    for (int u = F.tid; u < (LDS_BYTES - LDSCTL_OFF) / 4; u += NWAVES * 64) ((LAS unsigned*)(F.lds + LDSCTL_OFF))[u] = 0u;
    __syncthreads();
    XcdBarrier bar = xcd_barrier_post((unsigned*)(F.ctl + CW_BAR) + args.li * XCD_BAR_WORDS, F.MISC + 8);
    const int lo = args.ph_lo, hi = args.ph_hi;
#define IN(k) (lo <= (k) && (k) < hi)
#define BOTH(k) (IN(k) && IN((k) + 1))
#define REFRESH() do { int t_ = threadIdx.x; asm volatile("" : "+v"(t_)); F.tid = t_; F.lane = t_ & 63; } while (0)
#define REP(k) for (int rep_ = 0; rep_ < 1 + ((PROBE_DBL >> (k)) & 1); ++rep_)
#define DUMMY(k) (((PROBE_DBL >> (k)) & 1) && rep_ == 0)
    const float* mod = (const float*)(ws + WS_MODACC);
    bf16* HX = (bf16*)(ws + WS_HX); bf16* PROJ = (bf16*)(ws + WS_PROJ); bf16* Y = (bf16*)(ws + WS_Y); bf16* ACT = (bf16*)(ws + WS_ACT);
    const int gw = F.vcu * NWAVES + F.wave, NGW = F.G * NWAVES;

    if (IN(0)) REP(0) { REFRESH(); p0_prologue(F, args, rep_ == 0); if (BOTH(0)) xcd_barrier(bar); }
    if (IN(1)) REP(1) { REFRESH();
        for (int m = gw; m < MROWS; m += 2 * NGW) {
            const int m2 = m + NGW < MROWS ? m + NGW : m;
            const float* src = m < L ? args.in[0] + (size_t)m * D : args.in[2] + (size_t)(m - L) * D; const float* mb = m < L ? mod : mod + 6 * D;
            const float* src2 = m2 < L ? args.in[0] + (size_t)m2 * D : args.in[2] + (size_t)(m2 - L) * D; const float* mb2 = m2 < L ? mod : mod + 6 * D;
            modulate_row2(src, src2, args.in[6], mb, mb + D, mb2, mb2 + D, HX + (size_t)m * D, HX + (size_t)m2 * D, F.lane); }
        if (BOTH(1)) xcd_barrier(bar);
    }
    if (IN(2)) REP(2) { REFRESH();
        pg8::Gemm g{HX, (const bf16*)(ws + WS_WIN), MROWS, NPROJ, D}; pg8::StaticOrder S; S.init(MROWS, NPROJ, F.G, (int)blockIdx.x);
        pg8::EpiProj E{PROJ, (const float*)(ws + WS_RT), (const float*)(ws + WS_RT + MiB), (const float*)(ws + WS_AXT), (const float*)(ws + WS_AXT + 8192)};
        pg8::gemm_phase<pg8::EpiProj, pg8::StaticOrder, true, true>(F.lds + RING_OFF, g, S, E);
        if (!(((PROBE_DBL >> 2) & 1) && rep_ == 1)) { const int extra = S.nwg % F.G; const int c = (int)blockIdx.x;
            if (extra == 0) p0_deferred(F, args, 0, c * NWAVES + F.wave, F.G * NWAVES);
            else if (c >= extra) p0_deferred(F, args, 0, (c - extra) * NWAVES + F.wave, (F.G - extra) * NWAVES); }
        if (BOTH(2)) xcd_barrier(bar);
    }
    if (IN(3)) REP(3) { REFRESH();
        const float* rd = args.in[9];
        for (int it = F.vcu; it < 256; it += F.G) attn_item(F, PROJ, args.in[10], Y, it >> 2, it & 3);
        for (int it = F.vcu; it < 528; it += F.G) { const int cc = it >> 3, h = it & 7;
            ret_kv_item(F, PROJ, (float*)(ws + WS_KVT), cc, h, -__expf(rd[h]) * LOG2E, -__expf(rd[8 + h]) * LOG2E); }
        if (BOTH(3)) xcd_barrier(bar);
    }
    if (IN(4)) REP(4) { REFRESH(); ret_scan_phase(F, (const float*)(ws + WS_KVT), (bf16*)(ws + WS_SPT), args.in[9]); if (BOTH(4)) xcd_barrier(bar); }
    if (IN(5)) REP(5) { REFRESH();
        const float* rd = args.in[9];
        for (int it = F.vcu; it < 512; it += F.G) { const int c = it >> 3, h = it & 7;
            ret_out_item(F, PROJ, (const bf16*)(ws + WS_SPT), Y, c, h, -__expf(rd[h]) * LOG2E, -__expf(rd[8 + h]) * LOG2E); }
        if (BOTH(5)) xcd_barrier(bar);
    }
    if (IN(6)) REP(6) { REFRESH();
        pg8::Gemm g{Y, (const bf16*)(ws + WS_WOUT), L, D, D}; pg8::StaticOrder S; S.init(L, D, F.G, (int)blockIdx.x);
        pg8::EpiX1 E{args.in[0], (bf16*)(ws + WS_X1B), mod + 2 * D, DUMMY(6) ? (float*)(ws + WS_PROJ) : (float*)(ws + WS_ROWSS), D};
        pg8::gemm_phase<pg8::EpiX1, pg8::StaticOrder, true, true>(F.lds + RING_OFF, g, S, E);
        if (BOTH(6)) xcd_barrier(bar);
    }
    if (IN(8)) REP(8) { REFRESH();
        pg8::Gemm g{(const bf16*)(ws + WS_X1B), (const bf16*)(ws + WS_WGU), L, 2 * DFF, D}; pg8::StaticOrder S; S.init(L, 2 * DFF, F.G, (int)blockIdx.x);
        pg8::EpiSwiglu2 E{ACT, DFF, (const float*)(ws + WS_ROWSS), (const float*)(ws + WS_BIAS), (const float*)(ws + WS_BIAS) + DFF};
        pg8::gemm_phase<pg8::EpiSwiglu2, pg8::StaticOrder, true, true>(F.lds + RING_OFF, g, S, E);
        if (!(((PROBE_DBL >> 8) & 1) && rep_ == 1)) { const int extra = S.nwg % F.G; const int c = (int)blockIdx.x;
            if (extra == 0) p0_deferred(F, args, 1, c * NWAVES + F.wave, F.G * NWAVES);
            else if (c >= extra) p0_deferred(F, args, 1, (c - extra) * NWAVES + F.wave, (F.G - extra) * NWAVES); }
        if (BOTH(8)) xcd_barrier(bar);
    }
    if (IN(9)) REP(9) { REFRESH();
        pg8::Gemm g{ACT, (const bf16*)(ws + WS_WDN), L, D, DFF}; pg8::StaticOrder S; S.init(L, D, F.G, (int)blockIdx.x);
        pg8::EpiResidB E{(const bf16*)(ws + WS_X1B), DUMMY(9) ? (float*)(ws + WS_PROJ) : args.out, mod + 5 * D, D};
        pg8::gemm_phase<pg8::EpiResidB, pg8::StaticOrder, true, true>(F.lds + RING_OFF, g, S, E);
        if (BOTH(9)) xcd_barrier(bar);
    }
    if (IN(10)) REP(10) { REFRESH(); float* dst = DUMMY(10) ? (float*)(ws + WS_PROJ) : args.out; for (int m = gw; m < L; m += NGW) final_norm_row(args.out + (size_t)m * D, dst + (size_t)m * D, args.in[15], F.lane); }
#undef IN
#undef REP
#undef REFRESH
#undef DUMMY
#undef BOTH
}

extern "C" void kernel_launch(void* const* d_in, const int* in_sizes, int n_in, void* d_out, int out_size, void* d_ws, size_t ws_size, hipStream_t stream) {
    static int grid = 0;
    if (grid == 0) {
        if (n_in != 16 || in_sizes[0] != L * D || out_size != L * D || ws_size < WS_END) { fprintf(stderr, "kernel_launch: unexpected shapes (n_in %d, in0 %d, out %d, ws %zu)\n", n_in, n_in > 0 ? in_sizes[0] : -1, out_size, ws_size); grid = -1; return; }
        int dev = 0, cus = 0, per_cu = 0;
        if (hipGetDevice(&dev) != hipSuccess || hipDeviceGetAttribute(&cus, hipDeviceAttributeMultiprocessorCount, dev) != hipSuccess) { grid = -1; return; }
        if (hipFuncSetAttribute((const void*)mk_fwd, hipFuncAttributeMaxDynamicSharedMemorySize, LDS_BYTES) != hipSuccess) { fprintf(stderr, "kernel_launch: hipFuncSetAttribute failed\n"); grid = -1; return; }
        if (hipOccupancyMaxActiveBlocksPerMultiprocessor(&per_cu, (const void*)mk_fwd, NWAVES * 64, LDS_BYTES) != hipSuccess || per_cu < 1) { fprintf(stderr, "kernel_launch: occupancy query says %d blocks per CU\n", per_cu); grid = -1; (void)hipGetLastError(); return; }
        (void)hipGetLastError();
        grid = cus;
    }
    if (grid < 0) return;
    unsigned char* ws = (unsigned char*)d_ws;
    hipMemsetAsync(ws + WS_CTL, 0, CTL_BYTES, stream);
    Args a{};
    for (int i = 0; i < 16; ++i) a.in[i] = (const float*)d_in[i];
    a.out = (float*)d_out; a.ws = ws;
    a.ph_lo = 0; a.ph_hi = 11; a.li = 0;
    hipLaunchKernelGGL(mk_fwd, dim3(grid), dim3(NWAVES * 64), LDS_BYTES, stream, a);
}
```
